# Optimizing an MI355X kernel written in HIP

```python
import math
import jax
import jax.numpy as jnp
from jax import lax
import numpy as np

D_MODEL = 1024
BATCH = 2
SEQ = 8192
DEPTH = 1
DEC_BATCH = 128
DEC_SEQ = 4
PAST_LEN = 8192
PAGE_SIZE = 128

SSD_HEADS = 8
SSD_HEAD_DIM = 64
SSD_INNER = SSD_HEADS * SSD_HEAD_DIM
SSD_GROUPS = 2
SSD_STATE = 128
CONV_WIDTH = 4
SSD_CHUNK = 128
CONV_DIM = SSD_INNER + 2 * SSD_GROUPS * SSD_STATE
MLA_HEADS = 8
QK_NOPE = 64
QK_ROPE = 32
V_DIM = 64
KV_RANK = 256
Q_RANK = 384
MLA_INNER = MLA_HEADS * V_DIM
ROPE_THETA = 10000.0
ATTN_SCALE = 1.0 / math.sqrt(QK_NOPE + QK_ROPE)
Q_BLOCK = 128
MIX_WIDTH = SSD_INNER + MLA_INNER
D_FF = 4 * D_MODEL
IN_PROJ_DIM = SSD_INNER + CONV_DIM + SSD_HEADS + Q_RANK + KV_RANK + QK_ROPE
EPS = 1e-6

kernel_name = "hymba_ssd_mla_adaln_decode_step"


def rmsnorm(x, g):
    xf = x.astype(jnp.float32)
    y = xf * lax.rsqrt(jnp.mean(xf * xf, axis=-1, keepdims=True) + EPS)
    return (y * g.astype(jnp.float32)).astype(x.dtype)


def modulate(x, g, shift, scale):
    return rmsnorm(x, g) * (1.0 + scale[:, None, :]) + shift[:, None, :]


def rope_tables(pos):
    inv = 1.0 / (ROPE_THETA ** (jnp.arange(0, QK_ROPE, 2, dtype=jnp.float32) / QK_ROPE))
    ang = pos.astype(jnp.float32)[:, None] * inv[None, :]
    return jnp.cos(ang), jnp.sin(ang)


def apply_rope(x, cos, sin):
    x1, x2 = jnp.split(x.astype(jnp.float32), 2, axis=-1)
    return jnp.concatenate([x1 * cos - x2 * sin, x1 * sin + x2 * cos], axis=-1).astype(x.dtype)


def causal_conv(xp, w, b):
    y = lax.conv_general_dilated(xp, w[:, None, :], window_strides=(1,), padding="VALID",
                                 dimension_numbers=("NWC", "WIO", "NWC"), feature_group_count=CONV_DIM)
    return y + b


def ssd_scan(xs, dt, a, bm, cm, h0, chunk):
    b, L, H, P = xs.shape
    nc = L // chunk
    rep = H // SSD_GROUPS
    f32 = jnp.float32
    xc = xs.astype(f32).reshape(b, nc, chunk, H, P)
    bc = jnp.repeat(bm.astype(f32), rep, axis=2).reshape(b, nc, chunk, H, SSD_STATE)
    cc = jnp.repeat(cm.astype(f32), rep, axis=2).reshape(b, nc, chunk, H, SSD_STATE)
    dtc = dt.reshape(b, nc, chunk, H)
    acs = jnp.cumsum(dtc * a, axis=2)
    seg = acs[:, :, :, None, :] - acs[:, :, None, :, :]
    causal = jnp.tril(jnp.ones((chunk, chunk), bool))[None, None, :, :, None]
    decay = jnp.exp(jnp.where(causal, seg, -jnp.inf))
    scores = jnp.einsum("bcihn,bcjhn->bcijh", cc, bc) * decay * dtc[:, :, None, :, :]
    y_diag = jnp.einsum("bcijh,bcjhp->bcihp", scores, xc)
    to_end = jnp.exp(acs[:, :, -1:, :] - acs) * dtc
    s_chunk = jnp.einsum("bcjhn,bcjhp->bchpn", bc, xc * to_end[..., None])
    chunk_decay = jnp.exp(acs[:, :, -1, :])

    def step(h, inp):
        dec, s = inp
        return dec[:, :, None, None] * h + s, h

    h_fin, h_prev = lax.scan(step, h0.astype(f32),
                             (jnp.moveaxis(chunk_decay, 1, 0), jnp.moveaxis(s_chunk, 1, 0)))
    h_prev = jnp.moveaxis(h_prev, 0, 1)
    y_off = jnp.einsum("bcihn,bchpn->bcihp", cc, h_prev) * jnp.exp(acs)[..., None]
    return (y_diag + y_off).reshape(b, L, H, P), h_fin


def ssd_mixer(z, xbc_pad, dt_raw, h0, lw):
    b, L, _ = z.shape
    xbc = jax.nn.silu(causal_conv(xbc_pad, lw["conv_w"], lw["conv_b"]))
    xs, bm, cm = jnp.split(xbc, [SSD_INNER, SSD_INNER + SSD_GROUPS * SSD_STATE], axis=-1)
    xs = xs.reshape(b, L, SSD_HEADS, SSD_HEAD_DIM)
    bm = bm.reshape(b, L, SSD_GROUPS, SSD_STATE)
    cm = cm.reshape(b, L, SSD_GROUPS, SSD_STATE)
    dt = jax.nn.softplus(dt_raw.astype(jnp.float32) + lw["dt_bias"].astype(jnp.float32))
    a = -jnp.exp(lw["a_log"].astype(jnp.float32))
    chunk = SSD_CHUNK if L % SSD_CHUNK == 0 else L
    y, h_fin = ssd_scan(xs, dt, a, bm, cm, h0, chunk)
    y = y + lw["d_skip"].astype(jnp.float32)[:, None] * xs.astype(jnp.float32)
    y = y.reshape(b, L, SSD_INNER) * jax.nn.silu(z.astype(jnp.float32))
    return rmsnorm(y, lw["norm_ssd_g"]).astype(z.dtype), h_fin.astype(z.dtype)


def mla_project(q_lat, kv_lat, kr_raw, pos, lw):
    b, L, _ = q_lat.shape
    q = (rmsnorm(q_lat, lw["q_norm_g"]) @ lw["w_uq"]).reshape(b, L, MLA_HEADS, QK_NOPE + QK_ROPE)
    q_nope, q_rope = jnp.split(q, [QK_NOPE], axis=-1)
    cos, sin = rope_tables(pos)
    q_rope = apply_rope(q_rope, cos[None, :, None, :], sin[None, :, None, :])
    kr = apply_rope(kr_raw, cos[None], sin[None])
    ckv = rmsnorm(kv_lat, lw["kv_norm_g"])
    q_abs = jnp.einsum("blhd,rhd->blhr", q_nope, lw["w_uk"])
    return q_abs, q_rope, ckv, kr


def mla_attend_prompt(q_abs, q_rope, ckv, kr):
    b, L = q_abs.shape[:2]
    nb = L // Q_BLOCK
    qa = jnp.moveaxis(q_abs.reshape(b, nb, Q_BLOCK, MLA_HEADS, KV_RANK), 1, 0)
    qr = jnp.moveaxis(q_rope.reshape(b, nb, Q_BLOCK, MLA_HEADS, QK_ROPE), 1, 0)
    kpos = jnp.arange(L, dtype=jnp.int32)

    def one_block(args):
        qa_b, qr_b, start = args
        s = jnp.einsum("bqhr,bkr->bhqk", qa_b, ckv) + jnp.einsum("bqhd,bkd->bhqk", qr_b, kr)
        qpos = start + jnp.arange(Q_BLOCK, dtype=jnp.int32)
        s = jnp.where(kpos[None, :] <= qpos[:, None], s.astype(jnp.float32) * ATTN_SCALE, -jnp.inf)
        p = jax.nn.softmax(s, axis=-1).astype(ckv.dtype)
        return jnp.einsum("bhqk,bkr->bqhr", p, ckv)

    o = lax.map(one_block, (qa, qr, jnp.arange(nb, dtype=jnp.int32) * Q_BLOCK))
    return jnp.moveaxis(o, 0, 1).reshape(b, L, MLA_HEADS, KV_RANK)


def mla_attend_sample(q_abs, q_rope, ckv, kr, ckv_past, kr_past):
    t = q_abs.shape[1]
    past = ckv_past.shape[1]
    s_past = jnp.einsum("bqhr,bkr->bhqk", q_abs, ckv_past) + jnp.einsum("bqhd,bkd->bhqk", q_rope, kr_past)
    s_new = jnp.einsum("bqhr,bkr->bhqk", q_abs, ckv) + jnp.einsum("bqhd,bkd->bhqk", q_rope, kr)
    causal = jnp.tril(jnp.ones((t, t), bool))
    s_new = jnp.where(causal, s_new.astype(jnp.float32) * ATTN_SCALE, -jnp.inf)
    s = jnp.concatenate([s_past.astype(jnp.float32) * ATTN_SCALE, s_new], axis=-1)
    p = jax.nn.softmax(s, axis=-1).astype(ckv.dtype)
    return (jnp.einsum("bhqk,bkr->bqhr", p[..., :past], ckv_past)
            + jnp.einsum("bhqk,bkr->bqhr", p[..., past:], ckv))


def mixer(h, pos, conv_prev, h0, ckv_past, kr_past, lw):
    b, L, _ = h.shape
    proj = h @ lw["w_in"]
    c1 = SSD_INNER
    c2 = c1 + CONV_DIM
    c3 = c2 + SSD_HEADS
    c4 = c3 + Q_RANK
    c5 = c4 + KV_RANK
    z, xbc, dt_raw, q_lat, kv_lat, kr_raw = jnp.split(proj, [c1, c2, c3, c4, c5], axis=-1)
    xbc_pad = jnp.concatenate([conv_prev.astype(xbc.dtype), xbc], axis=1)
    new_conv = xbc_pad[:, L:]
    y_ssd, h_fin = ssd_mixer(z, xbc_pad, dt_raw, h0, lw)
    q_abs, q_rope, ckv, kr = mla_project(q_lat, kv_lat, kr_raw, pos, lw)
    if ckv_past is None:
        o_lat = mla_attend_prompt(q_abs, q_rope, ckv, kr)
    else:
        o_lat = mla_attend_sample(q_abs, q_rope, ckv, kr, ckv_past, kr_past)
    o = jnp.einsum("blhr,rhd->blhd", o_lat, lw["w_uv"]).reshape(b, L, MLA_INNER)
    y_attn = rmsnorm(o, lw["norm_attn_g"])
    mix = jnp.concatenate([y_ssd, y_attn], axis=-1) @ lw["w_out"]
    return mix, ckv, kr, new_conv, h_fin


def layer_block(x, c, pos, conv_prev, h0, ckv_past, kr_past, lw):
    ada = jax.nn.silu(c) @ lw["w_ada"] + lw["b_ada"]
    sh1, sc1, g1, sh2, sc2, g2 = jnp.split(ada, 6, axis=-1)
    mix, ckv, kr, new_conv, h_fin = mixer(modulate(x, lw["norm_mix_g"], sh1, sc1), pos,
                                          conv_prev, h0, ckv_past, kr_past, lw)
    x = x + g1[:, None, :] * mix
    u = jax.nn.relu(modulate(x, lw["norm_mlp_g"], sh2, sc2) @ lw["w_up"])
    x = x + g2[:, None, :] * (jnp.square(u) @ lw["w_down"])
    return x, ckv, kr, new_conv, h_fin


def final_norm(x, c, w_ada_final, b_ada_final, norm_final_g):
    ada = jax.nn.silu(c) @ w_ada_final + b_ada_final
    shift, scale = jnp.split(ada, 2, axis=-1)
    return modulate(x, norm_final_g, shift, scale)


def setup_inputs(seed: int = 0) -> dict:
    key = jax.random.key(seed)
    ks = jax.random.split(key, 32)
    f32 = jnp.float32
    n_pages = PAST_LEN // PAGE_SIZE
    n_phys = (DEC_BATCH * n_pages * 5) // 4

    def nrm(k, shape, scale):
        return jax.random.normal(k, shape, f32) * scale

    def gain(k, n):
        return 1.0 + nrm(k, (DEPTH, n), 0.02)

    x_prompt = nrm(ks[0], (BATCH, SEQ, D_MODEL), 1.0)
    x_sample = nrm(ks[1], (DEC_BATCH, DEC_SEQ, D_MODEL), 1.0)
    cache_kv_latent = nrm(ks[2], (DEPTH, n_phys, PAGE_SIZE, KV_RANK), 1.0)
    cache_k_rope = nrm(ks[3], (DEPTH, n_phys, PAGE_SIZE, QK_ROPE), 1.0)
    state_conv = nrm(ks[4], (DEPTH, DEC_BATCH, CONV_WIDTH - 1, CONV_DIM), 1.0)
    state_ssm = nrm(ks[5], (DEPTH, DEC_BATCH, SSD_HEADS, SSD_HEAD_DIM, SSD_STATE), 0.5)
    page_table = jax.random.permutation(ks[6], n_phys)[: DEC_BATCH * n_pages].reshape(DEC_BATCH, n_pages).astype(jnp.int32)
    c_prompt = nrm(ks[7], (BATCH, D_MODEL), 1.0)
    c_sample = nrm(ks[8], (DEC_BATCH, D_MODEL), 1.0)
    w_ada = nrm(ks[9], (DEPTH, D_MODEL, 6 * D_MODEL), 0.5 * D_MODEL ** -0.5)
    b_ada = nrm(ks[10], (DEPTH, 6 * D_MODEL), 0.02)
    norm_mix_g = gain(ks[11], D_MODEL)
    w_in = nrm(ks[12], (DEPTH, D_MODEL, IN_PROJ_DIM), D_MODEL ** -0.5)
    conv_w = nrm(ks[13], (DEPTH, CONV_WIDTH, CONV_DIM), CONV_WIDTH ** -0.5)
    conv_b = nrm(ks[14], (DEPTH, CONV_DIM), 0.02)
    dt0 = jnp.exp(jax.random.uniform(ks[15], (DEPTH, SSD_HEADS), f32, math.log(1e-3), math.log(1e-1)))
    dt_bias = dt0 + jnp.log(-jnp.expm1(-dt0))
    a_log = jnp.log(jax.random.uniform(ks[16], (DEPTH, SSD_HEADS), f32, 1.0, 16.0))
    d_skip = gain(ks[17], SSD_HEADS)
    norm_ssd_g = gain(ks[18], SSD_INNER)
    q_norm_g = gain(ks[19], Q_RANK)
    kv_norm_g = gain(ks[20], KV_RANK)
    w_uq = nrm(ks[21], (DEPTH, Q_RANK, MLA_HEADS * (QK_NOPE + QK_ROPE)), Q_RANK ** -0.5)
    w_uk = nrm(ks[22], (DEPTH, KV_RANK, MLA_HEADS, QK_NOPE), KV_RANK ** -0.5)
    w_uv = nrm(ks[23], (DEPTH, KV_RANK, MLA_HEADS, V_DIM), KV_RANK ** -0.5)
    norm_attn_g = gain(ks[24], MLA_INNER)
    w_out = nrm(ks[25], (DEPTH, MIX_WIDTH, D_MODEL), MIX_WIDTH ** -0.5)
    norm_mlp_g = gain(ks[26], D_MODEL)
    w_up = nrm(ks[27], (DEPTH, D_MODEL, D_FF), D_MODEL ** -0.5)
    w_down = nrm(ks[28], (DEPTH, D_FF, D_MODEL), D_FF ** -0.5)
    w_ada_final = nrm(ks[29], (D_MODEL, 2 * D_MODEL), 0.5 * D_MODEL ** -0.5)
    b_ada_final = nrm(ks[30], (2 * D_MODEL,), 0.02)
    norm_final_g = 1.0 + nrm(ks[31], (D_MODEL,), 0.02)
    return {"x_prompt": x_prompt, "x_sample": x_sample,
            "cache_kv_latent": cache_kv_latent, "cache_k_rope": cache_k_rope,
            "state_conv": state_conv, "state_ssm": state_ssm, "page_table": page_table,
            "c_prompt": c_prompt, "c_sample": c_sample,
            "w_ada": w_ada, "b_ada": b_ada, "norm_mix_g": norm_mix_g, "w_in": w_in,
            "conv_w": conv_w, "conv_b": conv_b, "dt_bias": dt_bias, "a_log": a_log,
            "d_skip": d_skip, "norm_ssd_g": norm_ssd_g, "q_norm_g": q_norm_g,
            "kv_norm_g": kv_norm_g, "w_uq": w_uq, "w_uk": w_uk, "w_uv": w_uv,
            "norm_attn_g": norm_attn_g, "w_out": w_out, "norm_mlp_g": norm_mlp_g,
            "w_up": w_up, "w_down": w_down, "w_ada_final": w_ada_final,
            "b_ada_final": b_ada_final, "norm_final_g": norm_final_g}


def reference(x_prompt, x_sample, cache_kv_latent, cache_k_rope, state_conv, state_ssm, page_table,
              c_prompt, c_sample, w_ada, b_ada, norm_mix_g, w_in, conv_w, conv_b, dt_bias, a_log,
              d_skip, norm_ssd_g, q_norm_g, kv_norm_g, w_uq, w_uk, w_uv, norm_attn_g, w_out,
              norm_mlp_g, w_up, w_down, w_ada_final, b_ada_final, norm_final_g):
    b_p, seq = x_prompt.shape[0], x_prompt.shape[1]
    n_seq = page_table.shape[0]
    past_len = page_table.shape[1] * PAGE_SIZE
    pos_p = jnp.arange(seq, dtype=jnp.int32)
    pos_s = past_len + jnp.arange(x_sample.shape[1], dtype=jnp.int32)
    xp, xs = x_prompt, x_sample
    kvp, krp, cvp, ssp = [], [], [], []
    kvs, krs, cvs, sss = [], [], [], []
    for l in range(DEPTH):
        lw = {"w_ada": w_ada[l], "b_ada": b_ada[l], "norm_mix_g": norm_mix_g[l], "w_in": w_in[l],
              "conv_w": conv_w[l], "conv_b": conv_b[l], "dt_bias": dt_bias[l], "a_log": a_log[l],
              "d_skip": d_skip[l], "norm_ssd_g": norm_ssd_g[l], "q_norm_g": q_norm_g[l],
              "kv_norm_g": kv_norm_g[l], "w_uq": w_uq[l], "w_uk": w_uk[l], "w_uv": w_uv[l],
              "norm_attn_g": norm_attn_g[l], "w_out": w_out[l], "norm_mlp_g": norm_mlp_g[l],
              "w_up": w_up[l], "w_down": w_down[l]}
        conv0 = jnp.zeros((b_p, CONV_WIDTH - 1, CONV_DIM), x_prompt.dtype)
        h0 = jnp.zeros((b_p, SSD_HEADS, SSD_HEAD_DIM, SSD_STATE), jnp.float32)
        xp, ckv, kr, cv, hs = layer_block(xp, c_prompt, pos_p, conv0, h0, None, None, lw)
        kvp.append(ckv)
        krp.append(kr)
        cvp.append(cv)
        ssp.append(hs)
        ckv_past = cache_kv_latent[l, page_table].reshape(n_seq, past_len, KV_RANK)
        kr_past = cache_k_rope[l, page_table].reshape(n_seq, past_len, QK_ROPE)
        xs, ckv, kr, cv, hs = layer_block(xs, c_sample, pos_s, state_conv[l], state_ssm[l],
                                          ckv_past, kr_past, lw)
        kvs.append(ckv)
        krs.append(kr)
        cvs.append(cv)
        sss.append(hs)
    y_prompt = final_norm(xp, c_prompt, w_ada_final, b_ada_final, norm_final_g)
    y_sample = final_norm(xs, c_sample, w_ada_final, b_ada_final, norm_final_g)
    return (y_prompt, y_sample, jnp.stack(kvp), jnp.stack(krp), jnp.stack(cvp), jnp.stack(ssp),
            jnp.stack(kvs), jnp.stack(krs), jnp.stack(cvs), jnp.stack(sss))
```

```cpp
#include <hip/hip_runtime.h>
#include <cstdio>
#include <cstdint>

#ifndef MK_PER_PHASE
#define MK_PER_PHASE 0
#endif
namespace pg8 {
#define PG8_LAS __attribute__((address_space(3)))
typedef unsigned short bf16_t;
typedef short bf16x8 __attribute__((ext_vector_type(8)));
typedef float f32x4 __attribute__((ext_vector_type(4)));
typedef unsigned u32x4 __attribute__((ext_vector_type(4)));
constexpr int BM = 256, BK = 64, HALF = 128, HTB = HALF * BK * 2  , STAGE_BYTES = 8 * HTB, NXCD = 8, WGM = 8;

__host__ __device__ __forceinline__ int lds_byte(int r, int c) { const int st = (r >> 4) * 2 + (c >> 5), rr = r & 15, cc = c & 31, ob = rr * 64 + cc * 2; return st * 1024 + (ob ^ (((ob >> 9) & 1) << 5)); }
__host__ __device__ __forceinline__ void stage_rc(int b, int& R, int& C) { const int st = b / 1024, sb = b % 1024, swz = sb ^ (((sb >> 9) & 1) << 5); R = (st >> 1) * 16 + swz / 64; C = (st & 1) * 32 + (swz % 64) / 2; }
__host__ __device__ __forceinline__ int perm32(int rho) { const int n = rho >> 4, i = rho & 15; return 8 * (i >> 2) + 4 * n + (i & 3); }

struct Unit { int pm, pn; };
struct Gemm { const bf16_t* A; const bf16_t* Bt; int M, N, K; };

struct StaticOrder {
    int nM, nN, nwg, G, c;
    __host__ __device__ void init(int M, int N, int G_, int c_) { nM = M / BM; nN = N / BM; nwg = nM * nN; G = G_; c = c_; }
    __host__ __device__ bool next(int i, Unit& u) const {
        const long L = (long)i * G + c; if (L >= nwg) return false;
        int wgid = (int)L; { const int q = nwg / NXCD, r = nwg % NXCD, xcd = wgid % NXCD, off = wgid / NXCD; wgid = (xcd < r ? xcd * (q + 1) : r * (q + 1) + (xcd - r) * q) + off; }
        const int nig = WGM * nN, gid = wgid / nig, fm = gid * WGM, gsz = (nM - fm) < WGM ? (nM - fm) : WGM;
        u.pm = fm + ((wgid % nig) % gsz); u.pn = (wgid % nig) / gsz; return true;
    }
    __device__ __forceinline__ void a_ready(const Unit&) const {}
    __device__ __forceinline__ void done(const Unit&) const {}
};

__device__ __forceinline__ unsigned cvt_pk_bf16(float lo, float hi) { unsigned r; asm volatile("v_cvt_pk_bf16_f32 %0, %1, %2" : "=v"(r) : "v"(lo), "v"(hi)); return r; }
typedef float f32x2 __attribute__((ext_vector_type(2)));
typedef unsigned u32x2 __attribute__((ext_vector_type(2)));
struct EpiProj {
    static constexpr bool PERM = true, AFTER_DRAIN = false;
    bf16_t* O; float* dtraw;
    __device__ __forceinline__ void operator()(const f32x4 (&acc)[2][2][4][2], const Unit& u, int wr, int wc, int fr, int fq) const {
        const int row0 = u.pm * BM + wr * 64 + fr, col0 = u.pn * BM + wc * 32 + 8 * fq;
#pragma unroll
        for (int ai = 0; ai < 2; ++ai)
#pragma unroll
            for (int m = 0; m < 4; ++m) { const int row = row0 + ai * HALF + m * 16; bf16_t* rowp = O + (size_t)row * 2304 + col0;
#pragma unroll
                for (int bj = 0; bj < 2; ++bj) { const f32x4 v0 = acc[ai][bj][m][0], v1 = acc[ai][bj][m][1];
                    u32x4 w; w.x = cvt_pk_bf16(v0[0], v0[1]); w.y = cvt_pk_bf16(v0[2], v0[3]); w.z = cvt_pk_bf16(v1[0], v1[1]); w.w = cvt_pk_bf16(v1[2], v1[3]);
                    *(u32x4*)(rowp + bj * HALF) = w;
                    if (col0 + bj * HALF == 2208) { *(f32x4*)(dtraw + (size_t)row * 8) = v0; *(f32x4*)(dtraw + (size_t)row * 8 + 4) = v1; } } }
    }
};
struct EpiQ {
    static constexpr bool PERM = false, AFTER_DRAIN = false;
    bf16_t* QP; bf16_t* QSN; bf16_t* QSR; const float* CS; float scl;
    __device__ __forceinline__ void operator()(const f32x4 (&acc)[2][2][4][2], const Unit& u, int wr, int wc, int fr, int fq) const {
        const int row0 = u.pm * BM + wr * 64 + fr;
#pragma unroll
        for (int ai = 0; ai < 2; ++ai)
#pragma unroll
            for (int m = 0; m < 4; ++m) { const int row = row0 + ai * HALF + m * 16; const bool isp = row < 16384; const int b = row >> 13, t = row & 8191, rs = row - 16384, l = rs & 3;
                if (u.pn < 2) {
#pragma unroll
                    for (int bj = 0; bj < 2; ++bj)
#pragma unroll
                        for (int n = 0; n < 2; ++n) { const int col = u.pn * BM + bj * HALF + wc * 32 + n * 16 + 4 * fq, h = col >> 6, d = col & 63; const f32x4 v = acc[ai][bj][m][n];
                            if (isp) { u32x2 w; w.x = cvt_pk_bf16(v[0] * scl, v[1] * scl); w.y = cvt_pk_bf16(v[2] * scl, v[3] * scl); *(u32x2*)(QP + ((size_t)(b * 8 + h) * 8192 + t) * 96 + d) = w; }
                            else { u32x2 w; w.x = cvt_pk_bf16(v[0], v[1]); w.y = cvt_pk_bf16(v[2], v[3]); *(u32x2*)(QSN + (size_t)rs * 512 + col) = w; } }
                } else {
                    const int pos = isp ? t : 8192 + l; const int i0 = 4 * fq;
                    const f32x4 c0 = *(const f32x4*)(CS + ((size_t)pos * 16 + i0) * 2), c1 = *(const f32x4*)(CS + ((size_t)pos * 16 + i0) * 2 + 4);
                    const float cs_[4] = {c0[0], c0[2], c1[0], c1[2]}, sn_[4] = {c0[1], c0[3], c1[1], c1[3]};
#pragma unroll
                    for (int bj = 0; bj < 2; ++bj) { const int h = 4 * bj + wc; const f32x4 x1 = acc[ai][bj][m][0], x2 = acc[ai][bj][m][1]; float o1[4], o2[4];
#pragma unroll
                        for (int j = 0; j < 4; ++j) { o1[j] = (x1[j] * cs_[j] - x2[j] * sn_[j]) * scl; o2[j] = (x1[j] * sn_[j] + x2[j] * cs_[j]) * scl; }
                        u32x2 w1, w2; w1.x = cvt_pk_bf16(o1[0], o1[1]); w1.y = cvt_pk_bf16(o1[2], o1[3]); w2.x = cvt_pk_bf16(o2[0], o2[1]); w2.y = cvt_pk_bf16(o2[2], o2[3]);
                        bf16_t* dst = isp ? QP + ((size_t)(b * 8 + h) * 8192 + t) * 96 + 64 + i0 : QSR + ((size_t)rs * 8 + h) * 32 + i0;
                        *(u32x2*)dst = w1; *(u32x2*)(dst + 16) = w2; }
                } }
    }
};
struct EpiKV {
    static constexpr bool PERM = true, AFTER_DRAIN = false;
    bf16_t* KP; bf16_t* VP;
    __device__ __forceinline__ void operator()(const f32x4 (&acc)[2][2][4][2], const Unit& u, int wr, int wc, int fr, int fq) const {
        const int row0 = u.pm * BM + wr * 64 + fr, col0 = u.pn * BM + wc * 32 + 8 * fq;
#pragma unroll
        for (int ai = 0; ai < 2; ++ai)
#pragma unroll
            for (int m = 0; m < 4; ++m) { const int row = row0 + ai * HALF + m * 16; const int b = row >> 13, t = row & 8191, tile = t >> 6, key = t & 63;
#pragma unroll
                for (int bj = 0; bj < 2; ++bj) { const int col = col0 + bj * HALF; const f32x4 v0 = acc[ai][bj][m][0], v1 = acc[ai][bj][m][1];
                    u32x4 w; w.x = cvt_pk_bf16(v0[0], v0[1]); w.y = cvt_pk_bf16(v0[2], v0[3]); w.z = cvt_pk_bf16(v1[0], v1[1]); w.w = cvt_pk_bf16(v1[2], v1[3]);
                    bf16_t* dst;
                    if (col < 512) { const int h = col >> 6, d = col & 63; dst = KP + ((((size_t)(b * 8 + h)) * 128 + tile) * 12 + (d >> 3)) * 512 + key * 8; }
                    else { const int cc = col - 512, h = cc >> 6, d = cc & 63; dst = VP + ((((size_t)(b * 8 + h)) * 128 + tile) * 2 + (d >> 5)) * 2048 + (key >> 4) * 512 + (key & 15) * 32 + (d & 31); }
                    *(u32x4*)dst = w; } }
    }
};
struct EpiRes {
    static constexpr bool PERM = false, AFTER_DRAIN = false;
    const float* baseP; const float* baseS; float* out; const float* ada; int goff;
    __device__ __forceinline__ void operator()(const f32x4 (&acc)[2][2][4][2], const Unit& u, int wr, int wc, int fr, int fq) const {
        const int row0 = u.pm * BM + wr * 64 + fr;
#pragma unroll
        for (int ai = 0; ai < 2; ++ai)
#pragma unroll
            for (int m = 0; m < 4; ++m) { const int row = row0 + ai * HALF + m * 16; const bool isp = row < 16384;
                const float* brow = isp ? baseP + (size_t)row * 1024 : baseS + (size_t)(row - 16384) * 1024;
                const float* g = ada + (size_t)(isp ? (row >> 13) : 2 + ((row - 16384) >> 2)) * 6144 + goff;
#pragma unroll
                for (int bj = 0; bj < 2; ++bj)
#pragma unroll
                    for (int n = 0; n < 2; ++n) { const int col = u.pn * BM + bj * HALF + wc * 32 + n * 16 + 4 * fq;
                        const f32x4 o = *(const f32x4*)(brow + col) + *(const f32x4*)(g + col) * acc[ai][bj][m][n];
                        *(f32x4*)(out + (size_t)row * 1024 + col) = o; } }
    }
};
struct EpiUp {
    static constexpr bool PERM = true, AFTER_DRAIN = false;
    bf16_t* O;
    __device__ __forceinline__ void operator()(const f32x4 (&acc)[2][2][4][2], const Unit& u, int wr, int wc, int fr, int fq) const {
        const int row0 = u.pm * BM + wr * 64 + fr, col0 = u.pn * BM + wc * 32 + 8 * fq;
#pragma unroll
        for (int ai = 0; ai < 2; ++ai)
#pragma unroll
            for (int m = 0; m < 4; ++m) { bf16_t* rowp = O + (size_t)(row0 + ai * HALF + m * 16) * 4096 + col0;
#pragma unroll
                for (int bj = 0; bj < 2; ++bj) { f32x4 v0 = acc[ai][bj][m][0], v1 = acc[ai][bj][m][1];
#pragma unroll
                    for (int j = 0; j < 4; ++j) { const float a = v0[j] > 0.f ? v0[j] : 0.f, b = v1[j] > 0.f ? v1[j] : 0.f; v0[j] = a * a; v1[j] = b * b; }
                    u32x4 w; w.x = cvt_pk_bf16(v0[0], v0[1]); w.y = cvt_pk_bf16(v0[2], v0[3]); w.z = cvt_pk_bf16(v1[0], v1[1]); w.w = cvt_pk_bf16(v1[2], v1[3]);
                    *(u32x4*)(rowp + bj * HALF) = w; } }
    }
};
template <class Epi, class Sched, bool ALIGN_EPI = false, bool SP2 = false>
__device__ __forceinline__ void gemm_phase(PG8_LAS unsigned char* lds, const Gemm g, const Sched& S, const Epi& E) {
    const int tid = threadIdx.x, wid = __builtin_amdgcn_readfirstlane(tid >> 6), lane = tid & 63, wr = wid >> 2, wc = wid & 3, fr = lane & 15, fq = lane >> 4;
    const int K = g.K, nt = K / BK;
    unsigned voffA[2], voffB[2];
#pragma unroll
    for (int i = 0; i < 2; ++i) { int R, C; stage_rc(tid * 16 + i * 8192, R, C); const int Rb = Epi::PERM ? ((R & ~31) + perm32(R & 31)) : R;
        voffA[i] = (unsigned)(R * K + C) * 2u; voffB[i] = (unsigned)(Rb * K + C) * 2u; }
    const size_t kstep = (size_t)(BK * 2);
    const size_t hstep = (size_t)HALF * K * 2;
    const size_t tstep = 2 * hstep;
    const unsigned ldsw = (unsigned)wid * 1024u;
    const int aoff = lds_byte(wr * 64 + fr, fq * 8), boff = lds_byte(wc * 32 + fr, fq * 8);
#define PG8_SA(b, h) (((b) * 2 + (h)) * HTB)
#define PG8_SB(b, h) ((4 + (b) * 2 + (h)) * HTB)
#define PG8_STAGE(bufoff, gbase, voff) do { _Pragma("unroll") for (int _i = 0; _i < 2; ++_i) \
        __builtin_amdgcn_global_load_lds((const unsigned*)((const char*)(gbase) + (voff)[_i]), (PG8_LAS unsigned*)(lds + (bufoff) + ldsw + _i * 8192), 16, 0, 0); } while (0)
#define PG8_LDA(dst, b, h) do { _Pragma("unroll") for (int m = 0; m < 4; ++m) _Pragma("unroll") for (int k = 0; k < 2; ++k) dst[m][k] = *(const PG8_LAS bf16x8*)(lds + PG8_SA(b, h) + aoff + m * 2048 + k * 1024); } while (0)
#define PG8_LDB(dst, b, h) do { _Pragma("unroll") for (int n = 0; n < 2; ++n) _Pragma("unroll") for (int k = 0; k < 2; ++k) dst[n][k] = *(const PG8_LAS bf16x8*)(lds + PG8_SB(b, h) + boff + n * 2048 + k * 1024); } while (0)
#define PG8_MMA(ai, bj, At, Bt) do { __builtin_amdgcn_s_setprio(1); _Pragma("unroll") for (int m = 0; m < 4; ++m) _Pragma("unroll") for (int n = 0; n < 2; ++n) _Pragma("unroll") for (int k = 0; k < 2; ++k) \
        acc[ai][bj][m][n] = __builtin_amdgcn_mfma_f32_16x16x32_bf16(Bt[n][k], At[m][k], acc[ai][bj][m][n], 0, 0, 0); __builtin_amdgcn_s_setprio(0); } while (0)
#define PG8_WAIT_V(n) asm volatile("s_waitcnt vmcnt(" #n ")" ::: "memory")
#define PG8_WAIT_L(n) asm volatile("s_waitcnt lgkmcnt(" #n ")" ::: "memory")
#define PG8_BAR __builtin_amdgcn_s_barrier()
#define PG8_SCHED __builtin_amdgcn_sched_barrier(0)
    Unit cur, nxt; int ui = 0;
    if (!S.next(0, cur)) return;
    f32x4 acc[2][2][4][2];
#pragma unroll
    for (int a = 0; a < 2; ++a)
#pragma unroll
        for (int b = 0; b < 2; ++b)
#pragma unroll
            for (int m = 0; m < 4; ++m)
#pragma unroll
                for (int n = 0; n < 2; ++n) acc[a][b][m][n] = (f32x4){0.f, 0.f, 0.f, 0.f};
    bf16x8 At[4][2], B0[2][2], B1[2][2];
    const char* cA = (const char*)g.A + (size_t)cur.pm * tstep; const char* cB = (const char*)g.Bt + (size_t)cur.pn * tstep;
    S.a_ready(cur);
    if constexpr (SP2) {
        PG8_STAGE(PG8_SB(0, 0), cB, voffB); PG8_STAGE(PG8_SB(0, 1), cB + hstep, voffB); PG8_STAGE(PG8_SA(0, 0), cA, voffA); PG8_STAGE(PG8_SA(0, 1), cA + hstep, voffA);
        if (wr == 1) PG8_BAR;
        PG8_WAIT_V(2); PG8_BAR;
        PG8_STAGE(PG8_SB(1, 0), cB + kstep, voffB); PG8_STAGE(PG8_SA(1, 0), cA + kstep, voffA); PG8_STAGE(PG8_SB(1, 1), cB + hstep + kstep, voffB);
        PG8_WAIT_V(6); PG8_BAR;
    } else {
        PG8_STAGE(PG8_SB(0, 0), cB, voffB); PG8_STAGE(PG8_SA(0, 0), cA, voffA); PG8_STAGE(PG8_SB(0, 1), cB + hstep, voffB); PG8_STAGE(PG8_SA(0, 1), cA + hstep, voffA);
        if (wr == 1) PG8_BAR;
        PG8_WAIT_V(4); PG8_BAR;
        PG8_STAGE(PG8_SB(1, 0), cB + kstep, voffB); PG8_STAGE(PG8_SA(1, 0), cA + kstep, voffA); PG8_STAGE(PG8_SB(1, 1), cB + hstep + kstep, voffB);
        PG8_WAIT_V(6); PG8_BAR;
    }
    for (;;) {
        const bool has_next = S.next(ui + 1, nxt);
        const char* nA = has_next ? (const char*)g.A + (size_t)nxt.pm * tstep : cA; const char* nB = has_next ? (const char*)g.Bt + (size_t)nxt.pn * tstep : cB;
        for (int t = 0; t < nt; t += 2) {
            const bool last = (t == nt - 2);
            const char* a1 = cA + (size_t)(t + 1) * kstep;
            const char* a2 = last ? nA : cA + (size_t)(t + 2) * kstep; const char* b2 = last ? nB : cB + (size_t)(t + 2) * kstep;
            const char* a3 = a2 + kstep; const char* b3 = b2 + kstep;
            if (last && has_next) S.a_ready(nxt);
            if constexpr (SP2) {
            PG8_LDB(B0, 0, 0); PG8_LDB(B1, 0, 1); PG8_SCHED; PG8_LDA(At, 0, 0); PG8_STAGE(PG8_SA(1, 1), a1 + hstep, voffA);
            PG8_WAIT_V(8); PG8_WAIT_L(0); PG8_BAR; PG8_MMA(0, 0, At, B0); PG8_MMA(0, 1, At, B1); PG8_BAR; PG8_SCHED;
            PG8_LDA(At, 0, 1); PG8_STAGE(PG8_SB(0, 0), b2, voffB); PG8_STAGE(PG8_SB(0, 1), b2 + hstep, voffB); PG8_STAGE(PG8_SA(0, 0), a2, voffA);
            PG8_WAIT_V(8); PG8_WAIT_L(0); PG8_BAR; PG8_MMA(1, 0, At, B0); PG8_MMA(1, 1, At, B1); PG8_BAR; PG8_SCHED;
            PG8_LDB(B0, 1, 0); PG8_LDB(B1, 1, 1); PG8_SCHED; PG8_LDA(At, 1, 0); PG8_STAGE(PG8_SA(0, 1), a2 + hstep, voffA);
            PG8_WAIT_V(8); PG8_WAIT_L(0); PG8_BAR; PG8_MMA(0, 0, At, B0); PG8_MMA(0, 1, At, B1); PG8_BAR; PG8_SCHED;
            PG8_LDA(At, 1, 1); PG8_STAGE(PG8_SB(1, 0), b3, voffB); PG8_STAGE(PG8_SB(1, 1), b3 + hstep, voffB); PG8_STAGE(PG8_SA(1, 0), a3, voffA);
            PG8_WAIT_V(8); PG8_WAIT_L(0); PG8_BAR; PG8_MMA(1, 0, At, B0); PG8_MMA(1, 1, At, B1); PG8_BAR; PG8_SCHED;
            } else {
            PG8_LDB(B0, 0, 0); PG8_SCHED; PG8_LDA(At, 0, 0); PG8_STAGE(PG8_SA(1, 1), a1 + hstep, voffA);
            PG8_WAIT_L(8); PG8_BAR; PG8_WAIT_L(0); PG8_MMA(0, 0, At, B0); PG8_BAR; PG8_SCHED;
            PG8_LDB(B1, 0, 1); PG8_STAGE(PG8_SB(0, 0), b2, voffB);
            PG8_BAR; PG8_WAIT_L(0); PG8_MMA(0, 1, At, B1); PG8_BAR;
            PG8_LDA(At, 0, 1); PG8_STAGE(PG8_SA(0, 0), a2, voffA);
            PG8_BAR; PG8_WAIT_L(0); PG8_MMA(1, 0, At, B0); PG8_BAR; PG8_SCHED;
            PG8_STAGE(PG8_SB(0, 1), b2 + hstep, voffB);
            PG8_WAIT_V(6); PG8_BAR; PG8_MMA(1, 1, At, B1); PG8_BAR;
            PG8_LDB(B0, 1, 0); PG8_SCHED; PG8_LDA(At, 1, 0); PG8_STAGE(PG8_SA(0, 1), a2 + hstep, voffA);
            PG8_WAIT_L(8); PG8_BAR; PG8_WAIT_L(0); PG8_MMA(0, 0, At, B0); PG8_BAR; PG8_SCHED;
            PG8_LDB(B1, 1, 1); PG8_STAGE(PG8_SB(1, 0), b3, voffB);
            PG8_BAR; PG8_WAIT_L(0); PG8_MMA(0, 1, At, B1); PG8_BAR;
            PG8_LDA(At, 1, 1); PG8_STAGE(PG8_SA(1, 0), a3, voffA);
            PG8_BAR; PG8_WAIT_L(0); PG8_MMA(1, 0, At, B0); PG8_BAR; PG8_SCHED;
            PG8_STAGE(PG8_SB(1, 1), b3 + hstep, voffB);
            PG8_WAIT_V(6); PG8_BAR; PG8_MMA(1, 1, At, B1); PG8_BAR;
            }
        }
        if constexpr (ALIGN_EPI) { if (wr == 0) PG8_BAR; }
        if constexpr (!Epi::AFTER_DRAIN) { E(acc, cur, wr, wc, fr, fq); S.done(cur); }
        if (!has_next) break;
#pragma unroll
        for (int a = 0; a < 2; ++a)
#pragma unroll
            for (int b = 0; b < 2; ++b)
#pragma unroll
                for (int m = 0; m < 4; ++m)
#pragma unroll
                    for (int n = 0; n < 2; ++n) acc[a][b][m][n] = (f32x4){0.f, 0.f, 0.f, 0.f};
        cur = nxt; cA = nA; cB = nB; ++ui;
        if constexpr (ALIGN_EPI) { if (wr == 1) PG8_BAR; }
    }
    PG8_WAIT_V(0);
    if constexpr (!ALIGN_EPI) { if (wr == 0) PG8_BAR; }
    PG8_BAR;
    if constexpr (Epi::AFTER_DRAIN) { E.fused(acc, cur, wr, wc, fr, fq, lds, wid, lane); S.done(cur); }
#undef PG8_SA
#undef PG8_SB
#undef PG8_STAGE
#undef PG8_LDA
#undef PG8_LDB
#undef PG8_MMA
#undef PG8_WAIT_V
#undef PG8_WAIT_L
#undef PG8_BAR
#undef PG8_SCHED
}
}
constexpr int DM = 1024, SEQ = 8192, MP = 16384, NSEQ = 128, MS = 512, MT = 16896, NPROJ = 2304, DFF = 4096;
constexpr float EPS = 1e-6f;
constexpr float SCL2 = 0.1472444460259031f;
constexpr size_t MiB = 1u << 20;
constexpr size_t WS_CTL = 0, CTL_ZERO_BYTES = 1 * MiB;
constexpr size_t WS_WIN = 2 * MiB, WS_WUQ = 7 * MiB, WS_WKV = 8 * MiB, WS_WOUT = 9 * MiB, WS_WUP = 11 * MiB, WS_WDOWN = 19 * MiB;
constexpr size_t WS_ADA = 27 * MiB, WS_ADAF = 31 * MiB, WS_CS = 33 * MiB, WS_DTRAW = 35 * MiB, WS_DT = 36 * MiB, WS_QSN = 37 * MiB, WS_QSR = 38 * MiB, WS_KRS = 38 * MiB + 512 * 1024;
constexpr size_t WS_OPART = 39 * MiB, WS_ML = 47 * MiB, WS_H1 = 48 * MiB, WS_PROJ = 82 * MiB, WS_XBC = 158 * MiB, WS_QN = 192 * MiB, WS_CKV = 206 * MiB;
constexpr size_t WS_QP = 216 * MiB, WS_KP = 240 * MiB, WS_VP = 264 * MiB, WS_YSSD = 280 * MiB, WS_OATT = 314 * MiB, WS_AMIX = 332 * MiB, WS_X1 = 366 * MiB, WS_U = 432 * MiB, WS_X2 = 564 * MiB, WS_END = 632 * MiB;
constexpr int CW_BAR = 4096;
constexpr size_t O_YP = 0, O_YS = 16777216, O_KVP = 17301504, O_KRP = 21495808, O_CVP = 22020096, O_SSP = 22026240, O_KVS = 22157312, O_KRS = 22288384, O_CVS = 22304768, O_SSS = 22697984, O_END = 31086592;
constexpr int RING_BYTES = 131072, LDSCTL_OFF = RING_BYTES, MISC_OFF = LDSCTL_OFF + 320, LDS_BYTES = 147456;
constexpr int NWAVES = 8, NPHASE = 12;

#define GAS __attribute__((address_space(1)))
#define LAS __attribute__((address_space(3)))
typedef unsigned short bf16;
typedef unsigned v4u __attribute__((ext_vector_type(4)));
typedef unsigned v2u __attribute__((ext_vector_type(2)));
typedef float f32x4 __attribute__((ext_vector_type(4)));
typedef float f32x16 __attribute__((ext_vector_type(16)));
typedef short bf16x8 __attribute__((ext_vector_type(8)));
typedef short s16x4 __attribute__((ext_vector_type(4)));
#define LDS_WAIT() asm volatile("s_waitcnt lgkmcnt(0)" ::: "memory")
__device__ __forceinline__ unsigned f2bf(float f) { unsigned u = __builtin_bit_cast(unsigned, f); return (u + 0x7fffu + ((u >> 16) & 1u)) >> 16; }
__device__ __forceinline__ unsigned pk2(float lo, float hi) { return f2bf(lo) | (f2bf(hi) << 16); }
__device__ __forceinline__ float bflo(unsigned w) { return __uint_as_float(w << 16); }
__device__ __forceinline__ float bfhi(unsigned w) { return __uint_as_float(w & 0xffff0000u); }
__device__ __forceinline__ float bf2f(bf16 v) { return __uint_as_float((unsigned)v << 16); }
__device__ __forceinline__ float wave_sum(float v) {
#pragma unroll
    for (int o = 1; o < 64; o <<= 1) v += __shfl_xor(v, o);
    return v;
}
__device__ __forceinline__ float siluf(float v) { return v / (1.f + __expf(-v)); }

__constant__ double ROPE_REV[16] = {0.15915494309189535, 0.08949940160889101, 0.050329212104487035, 0.0283021958306234, 0.015915494309189534, 0.008949940160889102, 0.005032921210448704, 0.00283021958306234,
    0.0015915494309189536, 0.0008949940160889102, 0.0005032921210448703, 0.00028302195830623395, 0.00015915494309189535, 8.949940160889102e-05, 5.0329212104487035e-05, 2.8302195830623396e-05};

#define XB_TMO      128
#define XB_XCNT(j)  (256  + 64 * (j))
#define XB_XSUB(j)  (1280 + 64 * (j))
#define XB_XGEN(j)  (2304 + 64 * (j))
#define XB_TOP      3328
#define XB_TOPGEN   3392
#define XCD_BAR_WORDS 3456
#define XB_SPIN_CAP (1u << 18)

__device__ __forceinline__ unsigned xb_ld(unsigned* p)              { return __hip_atomic_load(p, __ATOMIC_RELAXED, __HIP_MEMORY_SCOPE_AGENT); }
__device__ __forceinline__ unsigned xb_add(unsigned* p, unsigned v) { return __hip_atomic_fetch_add(p, v, __ATOMIC_RELAXED, __HIP_MEMORY_SCOPE_AGENT); }
__device__ __forceinline__ unsigned xb_xcc_id() { return (unsigned)__builtin_amdgcn_s_getreg((3 << 11) | 20) & 0xFu; }
#define XB_SPIN(cond, bar) do { unsigned _sp = 0; while (cond) { __builtin_amdgcn_s_sleep(1); \
    if ((++_sp & 255u) == 0u) { if (xb_ld(&(bar)[XB_TMO])) break; if (_sp > XB_SPIN_CAP) { atomicAdd(&(bar)[XB_TMO], 1u); break; } } } } while (0)

struct XcdBarrier {
    unsigned* bar; unsigned x;
    volatile LAS unsigned* st;
};

__device__ __forceinline__ XcdBarrier xcd_barrier_post(unsigned* bar, volatile LAS unsigned* st) {
    XcdBarrier b; b.bar = bar; b.x = xb_xcc_id(); b.st = st;
    if (threadIdx.x == 0) (void)xb_add(&bar[XB_XCNT(b.x)], 1u);
    return b;
}
__device__ __forceinline__ void xcd_barrier_complete(unsigned* bar, unsigned x, unsigned& nloc, unsigned& nx) {
    const unsigned G = gridDim.x * gridDim.y * gridDim.z;
    unsigned sum, cnt, mine, sp = 0u;
    for (;;) {
        sum = 0u; cnt = 0u; mine = 0u;
#pragma unroll
        for (unsigned j = 0; j < 16; ++j) { const unsigned c = xb_ld(&bar[XB_XCNT(j)]); sum += c; cnt += (c > 0u) ? 1u : 0u; mine = (j == x) ? c : mine; }
        if (sum == G) break;
        __builtin_amdgcn_s_sleep(1);
        if ((++sp & 255u) == 0u) { if (xb_ld(&bar[XB_TMO])) break; if (sp > XB_SPIN_CAP) { atomicAdd(&bar[XB_TMO], 1u); break; } }
    }
    nloc = mine > 0u ? mine : 1u; nx = cnt > 0u ? cnt : 1u;
}

__device__ __forceinline__ void xcd_barrier(const XcdBarrier& b) {
    asm volatile("s_waitcnt vmcnt(0)" ::: "memory");
    __syncthreads();
    if (threadIdx.x == 0) {
        unsigned* bar = b.bar;
        __builtin_amdgcn_s_waitcnt(0);
        unsigned nloc = b.st[0], nx = b.st[1];
        if (nloc == 0u) { xcd_barrier_complete(bar, b.x, nloc, nx); b.st[0] = nloc; b.st[1] = nx; }
        const unsigned old = xb_add(&bar[XB_XSUB(b.x)], 1u);
        const unsigned gen = old / nloc;
        if (old + 1u == (gen + 1u) * nloc) {
            __builtin_amdgcn_fence(__ATOMIC_RELEASE, "agent");
            asm volatile("s_waitcnt vmcnt(0)" ::: "memory");
            const unsigned og = xb_add(&bar[XB_TOP], 1u);
            const unsigned tg = og / nx;
            if (og + 1u == (tg + 1u) * nx) xb_add(&bar[XB_TOPGEN], 1u);
            else XB_SPIN(xb_ld(&bar[XB_TOPGEN]) == tg, bar);
            __builtin_amdgcn_fence(__ATOMIC_ACQUIRE, "agent");
            xb_add(&bar[XB_XGEN(b.x)], 1u);
            asm volatile("s_waitcnt vmcnt(0)" ::: "memory");
        } else {
            XB_SPIN(xb_ld(&bar[XB_XGEN(b.x)]) == gen, bar);
            __builtin_amdgcn_fence(__ATOMIC_ACQUIRE, "agent");
            asm volatile("s_waitcnt vmcnt(0)" ::: "memory");
        }
    }
    __syncthreads();
}

struct Args { const void* in[32]; float* out; unsigned char* ws; int ph_lo, ph_hi; };
struct Frame {
    LAS unsigned char* lds;
    volatile LAS unsigned* MISC;
    unsigned* ctl;
    int wave, vcu, G;
    const Args* ap;
    float* out; unsigned char* ws;
    __device__ __forceinline__ const void* inp(int k) const { asm volatile("" : "+s"(k)); return ap->in[k]; }
    __device__ __forceinline__ const float* xp() const { return (const float*)inp(0); }
    __device__ __forceinline__ const float* xs() const { return (const float*)inp(1); }
    __device__ __forceinline__ const float* cache_kv() const { return (const float*)inp(2); }
    __device__ __forceinline__ const float* cache_kr() const { return (const float*)inp(3); }
    __device__ __forceinline__ const float* sconv() const { return (const float*)inp(4); }
    __device__ __forceinline__ const float* sssm() const { return (const float*)inp(5); }
    __device__ __forceinline__ const int* ptab() const { return (const int*)inp(6); }
    __device__ __forceinline__ const float* cprm() const { return (const float*)inp(7); }
    __device__ __forceinline__ const float* csmp() const { return (const float*)inp(8); }
    __device__ __forceinline__ const float* w_ada() const { return (const float*)inp(9); }
    __device__ __forceinline__ const float* b_ada() const { return (const float*)inp(10); }
    __device__ __forceinline__ const float* g_mix() const { return (const float*)inp(11); }
    __device__ __forceinline__ const float* w_in() const { return (const float*)inp(12); }
    __device__ __forceinline__ const float* conv_w() const { return (const float*)inp(13); }
    __device__ __forceinline__ const float* conv_b() const { return (const float*)inp(14); }
    __device__ __forceinline__ const float* dt_bias() const { return (const float*)inp(15); }
    __device__ __forceinline__ const float* a_log() const { return (const float*)inp(16); }
    __device__ __forceinline__ const float* d_skip() const { return (const float*)inp(17); }
    __device__ __forceinline__ const float* g_ssd() const { return (const float*)inp(18); }
    __device__ __forceinline__ const float* g_q() const { return (const float*)inp(19); }
    __device__ __forceinline__ const float* g_kv() const { return (const float*)inp(20); }
    __device__ __forceinline__ const float* w_uq() const { return (const float*)inp(21); }
    __device__ __forceinline__ const float* w_uk() const { return (const float*)inp(22); }
    __device__ __forceinline__ const float* w_uv() const { return (const float*)inp(23); }
    __device__ __forceinline__ const float* g_attn() const { return (const float*)inp(24); }
    __device__ __forceinline__ const float* w_out() const { return (const float*)inp(25); }
    __device__ __forceinline__ const float* g_mlp() const { return (const float*)inp(26); }
    __device__ __forceinline__ const float* w_up() const { return (const float*)inp(27); }
    __device__ __forceinline__ const float* w_down() const { return (const float*)inp(28); }
    __device__ __forceinline__ const float* w_adaf() const { return (const float*)inp(29); }
    __device__ __forceinline__ const float* b_adaf() const { return (const float*)inp(30); }
    __device__ __forceinline__ const float* g_fin() const { return (const float*)inp(31); }
};
#define WSP(T, off) ((T*)(F.ws + (off)))

__device__ __forceinline__ int tid_fresh() { int t = threadIdx.x; asm volatile("" : "+v"(t)); return t; }
template <int MODE> __device__ __forceinline__ int srccol(int n) {
    if (MODE == 1) { if (n < 1536) return n; if (n < 2208) return n + 8; if (n < 2216) return n - 2208 + 1536; return -1; }
    if (MODE == 2) { return n < 512 ? (n >> 6) * 96 + (n & 63) : ((n - 512) >> 5) * 96 + 64 + ((n - 512) & 31); }
    return n;
}
template <int MODE> __device__ __forceinline__ void transpose_item(const float* W, int K, int Nsrc, bf16* WT, int nblk, LAS float* scr, int item, int lane) {
    const int kb = item / nblk, nb = item % nblk, k0 = 64 * kb, n0 = 32 * nb;
    const int sc = srccol<MODE>(n0 + (lane & 31));
#pragma unroll 8
    for (int i = 0; i < 32; ++i) { const int kk = 2 * i + (lane >> 5); scr[kk * 33 + (lane & 31)] = sc >= 0 ? W[(size_t)(k0 + kk) * Nsrc + sc] : 0.f; }
    LDS_WAIT(); asm volatile("" ::: "memory");
    const int c = lane & 7;
#pragma unroll
    for (int j = 0; j < 4; ++j) { const int n = (lane >> 3) + 8 * j; const LAS float* s = scr + (8 * c) * 33 + n;
        v4u o; o.x = pk2(s[0 * 33], s[1 * 33]); o.y = pk2(s[2 * 33], s[3 * 33]); o.z = pk2(s[4 * 33], s[5 * 33]); o.w = pk2(s[6 * 33], s[7 * 33]);
        *(v4u*)(WT + (size_t)(n0 + n) * K + k0 + 8 * c) = o; }
    LDS_WAIT(); asm volatile("" ::: "memory");
}

__device__ __forceinline__ void p0_prologue(Frame& F) {
    const int tid = tid_fresh(), lane = tid & 63;
    const int gw = F.vcu * NWAVES + F.wave, NGW = F.G * NWAVES;
    {
        LAS float* S = (LAS float*)F.lds;
        for (int slab = F.vcu; slab < 256; slab += F.G) {
            const int n0 = slab * 32; const bool fin = n0 >= 6144; const float* W = fin ? F.w_adaf() : F.w_ada(); const int Nw = fin ? 2048 : 6144; const int nc = (fin ? n0 - 6144 : n0) + (tid & 31);
            const int rg = tid >> 5;
            float acc[9];
#pragma unroll
            for (int j = 0; j < 9; ++j) acc[j] = 0.f;
            for (int kc = 0; kc < 8; ++kc) {
                __syncthreads();
                for (int idx = tid; idx < 130 * 128; idx += 512) { const int r = idx >> 7, kk = idx & 127; const float v = r < 2 ? F.cprm()[r * 1024 + kc * 128 + kk] : F.csmp()[(size_t)(r - 2) * 1024 + kc * 128 + kk]; S[r * 132 + kk] = siluf(v); }
                __syncthreads();
                for (int kk = 0; kk < 128; kk += 4) {
                    const float w0 = W[(size_t)(kc * 128 + kk) * Nw + nc], w1 = W[(size_t)(kc * 128 + kk + 1) * Nw + nc], w2 = W[(size_t)(kc * 128 + kk + 2) * Nw + nc], w3 = W[(size_t)(kc * 128 + kk + 3) * Nw + nc];
#pragma unroll
                    for (int j = 0; j < 9; ++j) { const int r = rg + 16 * j; if (r < 130) { const f32x4 s = *(const LAS f32x4*)(S + r * 132 + kk); acc[j] += s[0] * w0 + s[1] * w1 + s[2] * w2 + s[3] * w3; } }
                }
            }
#pragma unroll
            for (int j = 0; j < 9; ++j) { const int r = rg + 16 * j; if (r < 130) { if (fin) WSP(float, WS_ADAF)[(size_t)r * 2048 + nc] = acc[j] + F.b_adaf()[nc]; else WSP(float, WS_ADA)[(size_t)r * 6144 + nc] = acc[j] + F.b_ada()[nc]; } }
        }
        __syncthreads();
    }
    {
        LAS float* scr = (LAS float*)(F.lds + F.wave * 16384);
        constexpr int I_IN = 16 * 72, I_UQ = 6 * 24, I_KV = 4 * 32, I_OUT = 16 * 32, I_UP = 16 * 128, I_DN = 64 * 32;
        constexpr int NITEMS = I_IN + I_UQ + I_KV + I_OUT + I_UP + I_DN;
        for (int it = gw; it < NITEMS; it += NGW) {
            int r = it;
            if (r < I_IN) { transpose_item<1>(F.w_in(), 1024, 2216, WSP(bf16, WS_WIN), 72, scr, r, lane); continue; } r -= I_IN;
            if (r < I_UQ) { transpose_item<2>(F.w_uq(), 384, 768, WSP(bf16, WS_WUQ), 24, scr, r, lane); continue; } r -= I_UQ;
            if (r < I_KV) { const int nb = r % 32, kb = r / 32;
                if (nb < 16) transpose_item<0>(F.w_uk(), 256, 512, WSP(bf16, WS_WKV), 16, scr, kb * 16 + nb, lane);
                else transpose_item<0>(F.w_uv(), 256, 512, WSP(bf16, WS_WKV) + 512 * 256, 16, scr, kb * 16 + (nb - 16), lane);
                continue; } r -= I_KV;
            if (r < I_OUT) { transpose_item<0>(F.w_out(), 1024, 1024, WSP(bf16, WS_WOUT), 32, scr, r, lane); continue; } r -= I_OUT;
            if (r < I_UP) { transpose_item<0>(F.w_up(), 1024, 4096, WSP(bf16, WS_WUP), 128, scr, r, lane); continue; } r -= I_UP;
            transpose_item<0>(F.w_down(), 4096, 1024, WSP(bf16, WS_WDOWN), 32, scr, r, lane);
        }
    }
    for (int idx = (F.vcu * 512 + tid); idx < 8196 * 16; idx += F.G * 512) {
        const int pos = idx >> 4, i = idx & 15; double rev = (double)pos * ROPE_REV[i]; rev -= __builtin_rint(rev); const float fr = (float)rev;
        WSP(float, WS_CS)[2 * idx] = __builtin_amdgcn_cosf(fr); WSP(float, WS_CS)[2 * idx + 1] = __builtin_amdgcn_sinf(fr);
    }
}

__device__ __forceinline__ const float* xrow_of(Frame& F, int m) { return m < MP ? F.xp() + (size_t)m * DM : F.xs() + (size_t)(m - MP) * DM; }
__device__ __forceinline__ int arow_of(int m) { return m < MP ? (m >> 13) : 2 + ((m - MP) >> 2); }

template <bool BF16OUT> __device__ __forceinline__ void norm_mod_row(const float* xr_, const float* g, const float* sc, const float* sh, void* orow, int lane) {
    const f32x4* xr = (const f32x4*)xr_ + lane;
    f32x4 v[4]; float s2 = 0.f;
#pragma unroll
    for (int j = 0; j < 4; ++j) { v[j] = xr[64 * j]; s2 += (v[j][0] * v[j][0] + v[j][1] * v[j][1]) + (v[j][2] * v[j][2] + v[j][3] * v[j][3]); }
    const float rstd = 1.f / sqrtf(wave_sum(s2) * (1.f / 1024.f) + EPS);
#pragma unroll
    for (int j = 0; j < 4; ++j) { const f32x4 gg = ((const f32x4*)g)[lane + 64 * j], cc = ((const f32x4*)sc)[lane + 64 * j], hh = ((const f32x4*)sh)[lane + 64 * j];
        f32x4 o;
#pragma unroll
        for (int e = 0; e < 4; ++e) o[e] = v[j][e] * rstd * gg[e] * (1.f + cc[e]) + hh[e];
        if (BF16OUT) { v2u w; w.x = pk2(o[0], o[1]); w.y = pk2(o[2], o[3]); ((v2u*)orow)[lane + 64 * j] = w; }
        else ((f32x4*)orow)[lane + 64 * j] = o; }
}

__device__ __forceinline__ void p3_row(Frame& F, int row, const int lane) {
    const bf16* PROJ = WSP(bf16, WS_PROJ); const bf16* P = PROJ + (size_t)row * NPROJ;
    const bool isp = row < MP; const int b = row >> 13, rs = row - MP, s = rs >> 2, l = rs & 3; const int t = isp ? (row & 8191) : l;
#pragma unroll
    for (int half = 0; half < 2; ++half) {
        const int c0 = half * 512 + 8 * lane;
        float acc[8], cur[8];
        { const f32x4 b0 = *(const f32x4*)(F.conv_b() + c0), b1 = *(const f32x4*)(F.conv_b() + c0 + 4);
#pragma unroll
          for (int e = 0; e < 4; ++e) { acc[e] = b0[e]; acc[4 + e] = b1[e]; } }
#pragma unroll
        for (int j = 0; j < 4; ++j) {
            const int tt = t - 3 + j; float xin[8];
            if (tt >= 0) { const v4u w = *(const v4u*)(PROJ + (size_t)(row - 3 + j) * NPROJ + 512 + c0);
                xin[0] = bflo(w.x); xin[1] = bfhi(w.x); xin[2] = bflo(w.y); xin[3] = bfhi(w.y); xin[4] = bflo(w.z); xin[5] = bfhi(w.z); xin[6] = bflo(w.w); xin[7] = bfhi(w.w); }
            else if (!isp) { const float* sp = F.sconv() + ((size_t)s * 3 + (3 + tt)) * 1024 + c0; const f32x4 a0 = *(const f32x4*)sp, a1 = *(const f32x4*)(sp + 4);
#pragma unroll
                for (int e = 0; e < 4; ++e) { xin[e] = a0[e]; xin[4 + e] = a1[e]; } }
            else {
#pragma unroll
                for (int e = 0; e < 8; ++e) xin[e] = 0.f; }
            const f32x4 w0 = *(const f32x4*)(F.conv_w() + j * 1024 + c0), w1 = *(const f32x4*)(F.conv_w() + j * 1024 + c0 + 4);
#pragma unroll
            for (int e = 0; e < 4; ++e) { acc[e] += w0[e] * xin[e]; acc[4 + e] += w1[e] * xin[4 + e]; }
            if (j == 3) {
#pragma unroll
                for (int e = 0; e < 8; ++e) cur[e] = xin[e]; }
        }
        v4u o; o.x = pk2(siluf(acc[0]), siluf(acc[1])); o.y = pk2(siluf(acc[2]), siluf(acc[3])); o.z = pk2(siluf(acc[4]), siluf(acc[5])); o.w = pk2(siluf(acc[6]), siluf(acc[7]));
        *(v4u*)(WSP(bf16, WS_XBC) + (size_t)row * 1024 + c0) = o;
        float* cdst = nullptr;
        if (isp) { if (t >= SEQ - 3) cdst = F.out + O_CVP + ((size_t)b * 3 + (t - (SEQ - 3))) * 1024 + c0; }
        else { if (l >= 1) cdst = F.out + O_CVS + ((size_t)s * 3 + (l - 1)) * 1024 + c0; }
        if (cdst) { *(f32x4*)cdst = (f32x4){cur[0], cur[1], cur[2], cur[3]}; *(f32x4*)(cdst + 4) = (f32x4){cur[4], cur[5], cur[6], cur[7]}; }
    }
    if (lane < 8) { const float x = WSP(float, WS_DTRAW)[(size_t)row * 8 + lane] + F.dt_bias()[lane]; WSP(float, WS_DT)[(size_t)row * 8 + lane] = x > 20.f ? x : log1pf(__expf(x)); }
    {
        float v[6]; float s2 = 0.f;
#pragma unroll
        for (int j = 0; j < 3; ++j) { const unsigned w = *(const unsigned*)(P + 1536 + 2 * lane + 128 * j); v[2 * j] = bflo(w); v[2 * j + 1] = bfhi(w); s2 += v[2 * j] * v[2 * j] + v[2 * j + 1] * v[2 * j + 1]; }
        const float rstd = 1.f / sqrtf(wave_sum(s2) * (1.f / 384.f) + EPS);
#pragma unroll
        for (int j = 0; j < 3; ++j) { const int c = 2 * lane + 128 * j; *(unsigned*)(WSP(bf16, WS_QN) + (size_t)row * 384 + c) = pk2(v[2 * j] * rstd * F.g_q()[c], v[2 * j + 1] * rstd * F.g_q()[c + 1]); }
    }
    {
        const v2u w = *(const v2u*)(P + 1920 + 4 * lane); float v[4] = {bflo(w.x), bfhi(w.x), bflo(w.y), bfhi(w.y)};
        const float s2 = (v[0] * v[0] + v[1] * v[1]) + (v[2] * v[2] + v[3] * v[3]);
        const float rstd = 1.f / sqrtf(wave_sum(s2) * (1.f / 256.f) + EPS);
        const f32x4 g = *(const f32x4*)(F.g_kv() + 4 * lane); f32x4 o;
#pragma unroll
        for (int e = 0; e < 4; ++e) o[e] = v[e] * rstd * g[e];
        float* od = isp ? F.out + O_KVP + (size_t)row * 256 + 4 * lane : F.out + O_KVS + (size_t)rs * 256 + 4 * lane;
        *(f32x4*)od = o;
        v2u q; q.x = pk2(o[0], o[1]); q.y = pk2(o[2], o[3]); *(v2u*)(WSP(bf16, WS_CKV) + (size_t)row * 256 + 4 * lane) = q;
    }
    if (lane < 32) {
        const int i = lane & 15; const float x1 = bf2f(P[2176 + i]), x2 = bf2f(P[2176 + 16 + i]);
        const int pos = isp ? t : SEQ + l; const float c = WSP(float, WS_CS)[((size_t)pos * 16 + i) * 2], sn = WSP(float, WS_CS)[((size_t)pos * 16 + i) * 2 + 1];
        const float val = lane < 16 ? x1 * c - x2 * sn : x1 * sn + x2 * c;
        if (isp) { F.out[O_KRP + (size_t)row * 32 + lane] = val; const bf16 vb = (bf16)f2bf(val);
#pragma unroll
            for (int h = 0; h < 8; ++h) WSP(bf16, WS_KP)[((((size_t)(b * 8 + h)) * 128 + (t >> 6)) * 12 + 8 + (lane >> 3)) * 512 + (t & 63) * 8 + (lane & 7)] = vb; }
        else { F.out[O_KRS + (size_t)rs * 32 + lane] = val; WSP(bf16, WS_KRS)[(size_t)rs * 32 + lane] = (bf16)f2bf(val); }
    }
}

__device__ __forceinline__ void ssd_prompt_task(Frame& F, int task) {
    const int b = task >> 9, h = (task >> 6) & 7, p = task & 63, g = h >> 2, lane = tid_fresh() & 63;
    const float a = -__expf(F.a_log()[h]), Dh = F.d_skip()[h];
    const bf16* XBC = WSP(bf16, WS_XBC); const float* DT = WSP(float, WS_DT); float* Y = WSP(float, WS_YSSD);
    float h0 = 0.f, h1 = 0.f;
    for (int t0 = 0; t0 < SEQ; t0 += 8) {
        float dtv[8], xv[8]; unsigned bb[8], cc[8];
#pragma unroll
        for (int i = 0; i < 8; ++i) { const size_t row = (size_t)b * SEQ + t0 + i; dtv[i] = DT[row * 8 + h]; xv[i] = bf2f(XBC[row * 1024 + h * 64 + p]);
            bb[i] = *(const unsigned*)(XBC + row * 1024 + 512 + g * 128 + 2 * lane); cc[i] = *(const unsigned*)(XBC + row * 1024 + 768 + g * 128 + 2 * lane); }
#pragma unroll
        for (int i = 0; i < 8; ++i) { const float dA = __expf(dtv[i] * a), dx = dtv[i] * xv[i];
            h0 = h0 * dA + dx * bflo(bb[i]); h1 = h1 * dA + dx * bfhi(bb[i]);
            const float y = wave_sum(h0 * bflo(cc[i]) + h1 * bfhi(cc[i]));
            if (lane == 0) Y[((size_t)b * SEQ + t0 + i) * 512 + h * 64 + p] = y + Dh * xv[i]; }
    }
    *(float2*)(F.out + O_SSP + ((size_t)(b * 8 + h) * 64 + p) * 128 + 2 * lane) = make_float2(h0, h1);
}
__device__ __forceinline__ void ssd_sample_unit(Frame& F, int u) {
    const int tid = tid_fresh(); const int s = u >> 3, h = u & 7, g = h >> 2, p = tid >> 3, nq = tid & 7;
    const float a = -__expf(F.a_log()[h]), Dh = F.d_skip()[h];
    const bf16* XBC = WSP(bf16, WS_XBC); const float* DT = WSP(float, WS_DT); float* Y = WSP(float, WS_YSSD);
    const size_t so = ((size_t)(s * 8 + h) * 64 + p) * 128 + 16 * nq;
    float st[16];
#pragma unroll
    for (int j = 0; j < 4; ++j) { const f32x4 v = *(const f32x4*)(F.sssm() + so + 4 * j); st[4 * j] = v[0]; st[4 * j + 1] = v[1]; st[4 * j + 2] = v[2]; st[4 * j + 3] = v[3]; }
#pragma unroll
    for (int t = 0; t < 4; ++t) {
        const size_t row = (size_t)MP + s * 4 + t; const float dtv = DT[row * 8 + h], xv = bf2f(XBC[row * 1024 + h * 64 + p]);
        const v4u b0 = *(const v4u*)(XBC + row * 1024 + 512 + g * 128 + 16 * nq), b1 = *(const v4u*)(XBC + row * 1024 + 512 + g * 128 + 16 * nq + 8);
        const v4u c0 = *(const v4u*)(XBC + row * 1024 + 768 + g * 128 + 16 * nq), c1 = *(const v4u*)(XBC + row * 1024 + 768 + g * 128 + 16 * nq + 8);
        const unsigned bw[8] = {b0.x, b0.y, b0.z, b0.w, b1.x, b1.y, b1.z, b1.w}, cw[8] = {c0.x, c0.y, c0.z, c0.w, c1.x, c1.y, c1.z, c1.w};
        const float dA = __expf(dtv * a), dx = dtv * xv; float part = 0.f;
#pragma unroll
        for (int j = 0; j < 8; ++j) { st[2 * j] = st[2 * j] * dA + dx * bflo(bw[j]); st[2 * j + 1] = st[2 * j + 1] * dA + dx * bfhi(bw[j]); part += st[2 * j] * bflo(cw[j]) + st[2 * j + 1] * bfhi(cw[j]); }
        part += __shfl_xor(part, 1); part += __shfl_xor(part, 2); part += __shfl_xor(part, 4);
        if (nq == 0) Y[row * 512 + h * 64 + p] = part + Dh * xv;
    }
#pragma unroll
    for (int j = 0; j < 4; ++j) *(f32x4*)(F.out + O_SSS + so + 4 * j) = (f32x4){st[4 * j], st[4 * j + 1], st[4 * j + 2], st[4 * j + 3]};
}

__device__ __forceinline__ int crow(int r, int hi) { return (r & 3) + 8 * (r >> 2) + 4 * hi; }
__device__ __forceinline__ unsigned cvtpk_s(float lo, float hi) { typedef float f2 __attribute__((ext_vector_type(2))); typedef __bf16 b2 __attribute__((ext_vector_type(2))); f2 v = {lo, hi}; b2 b = __builtin_convertvector(v, b2); return __builtin_bit_cast(unsigned, b); }
__device__ __forceinline__ float rowmax32(const f32x16& p0, const f32x16& p1) {
    float a = fmaxf(p0[0], p1[0]);
#pragma unroll
    for (int r = 1; r < 16; ++r) a = fmaxf(a, fmaxf(p0[r], p1[r]));
    return fmaxf(a, __shfl_xor(a, 32));
}
__device__ __forceinline__ void pv_block(f32x16& o, unsigned vb, bf16x8 pa0, bf16x8 pa1, bf16x8 pa2, bf16x8 pa3) {
    s16x4 lo[4], hi[4];
#pragma unroll
    for (int ks = 0; ks < 4; ++ks) {
        asm volatile("ds_read_b64_tr_b16 %0,%1 offset:%c2" : "=&v"(lo[ks]) : "v"(vb), "i"(ks * 1024) : "memory");
        asm volatile("ds_read_b64_tr_b16 %0,%1 offset:%c2" : "=&v"(hi[ks]) : "v"(vb), "i"(ks * 1024 + 512) : "memory"); }
    asm volatile("s_waitcnt lgkmcnt(0)" ::: "memory"); __builtin_amdgcn_sched_barrier(0);
#define PKV(k) (bf16x8){lo[k][0], lo[k][1], lo[k][2], lo[k][3], hi[k][0], hi[k][1], hi[k][2], hi[k][3]}
    o = __builtin_amdgcn_mfma_f32_32x32x16_bf16(pa0, PKV(0), o, 0, 0, 0);
    o = __builtin_amdgcn_mfma_f32_32x32x16_bf16(pa1, PKV(1), o, 0, 0, 0);
    o = __builtin_amdgcn_mfma_f32_32x32x16_bf16(pa2, PKV(2), o, 0, 0, 0);
    o = __builtin_amdgcn_mfma_f32_32x32x16_bf16(pa3, PKV(3), o, 0, 0, 0);
#undef PKV
}
__device__ __forceinline__ void softmax_step(f32x16& p0, f32x16& p1, float& m, float& l, float& alpha, bf16x8& pa0, bf16x8& pa1, bf16x8& pa2, bf16x8& pa3) {
    const float rm = rowmax32(p0, p1); const float mn = fmaxf(m, rm);
    alpha = __builtin_amdgcn_exp2f(m - mn); m = mn; float sum = 0.f;
#pragma unroll
    for (int r = 0; r < 16; ++r) { p0[r] = __builtin_amdgcn_exp2f(p0[r] - mn); p1[r] = __builtin_amdgcn_exp2f(p1[r] - mn); sum += p0[r] + p1[r]; }
    l = l * alpha + sum;
    v4u w0, w1, w2, w3;
    w0.x = cvtpk_s(p0[0], p0[1]); w0.y = cvtpk_s(p0[2], p0[3]); w0.z = cvtpk_s(p0[4], p0[5]); w0.w = cvtpk_s(p0[6], p0[7]);
    w1.x = cvtpk_s(p0[8], p0[9]); w1.y = cvtpk_s(p0[10], p0[11]); w1.z = cvtpk_s(p0[12], p0[13]); w1.w = cvtpk_s(p0[14], p0[15]);
    w2.x = cvtpk_s(p1[0], p1[1]); w2.y = cvtpk_s(p1[2], p1[3]); w2.z = cvtpk_s(p1[4], p1[5]); w2.w = cvtpk_s(p1[6], p1[7]);
    w3.x = cvtpk_s(p1[8], p1[9]); w3.y = cvtpk_s(p1[10], p1[11]); w3.z = cvtpk_s(p1[12], p1[13]); w3.w = cvtpk_s(p1[14], p1[15]);
    pa0 = __builtin_bit_cast(bf16x8, w0); pa1 = __builtin_bit_cast(bf16x8, w1); pa2 = __builtin_bit_cast(bf16x8, w2); pa3 = __builtin_bit_cast(bf16x8, w3);
}

constexpr int AP_K = 0, AP_V = 24576, AP_WS = 40960;
__device__ __forceinline__ void attn_prompt_unit(Frame& F, int bh, int qb) {
    const int tid = tid_fresh(), lane = tid & 63, wid = F.wave, r32 = lane & 31, hi = lane >> 5;
    const int b = bh >> 3, h = bh & 7, q0 = qb * 256, NT = 4 * (qb + 1), qrel = wid * 32 + r32;
    const bf16* Qw = WSP(bf16, WS_QP) + ((size_t)bh * SEQ + q0 + wid * 32 + r32) * 96 + hi * 8;
    bf16x8 qr[6];
#pragma unroll
    for (int d0 = 0; d0 < 6; ++d0) qr[d0] = *(const bf16x8*)(Qw + d0 * 16);
    const v4u* Kg = (const v4u*)(WSP(bf16, WS_KP) + (size_t)bh * 128 * 6144);
    const v4u* Vg = (const v4u*)(WSP(bf16, WS_VP) + (size_t)bh * 128 * 4096);
    LAS unsigned char* L = F.lds;
    LAS float* wsf = (LAS float*)(L + AP_WS) + wid * 64;
    const unsigned vb0 = (unsigned)(size_t)(L + AP_V) + ((lane >> 4) & 1) * 32 + (lane & 3) * 8 + (4 * hi + ((lane & 15) >> 2)) * 64;
    v4u k0r = Kg[tid], k1r = (tid < 256) ? Kg[512 + tid] : (v4u){0u, 0u, 0u, 0u}, v0r = Vg[tid];
    float m = -1e30f, l = 0.f; f32x16 o0 = {}, o1 = {};
    for (int t = 0; t < NT; ++t) {
        const int buf = t & 1;
        LAS v4u* Kb = (LAS v4u*)(L + AP_K + buf * 12288); LAS v4u* Vb = (LAS v4u*)(L + AP_V + buf * 8192);
        Kb[tid] = k0r; if (tid < 256) Kb[512 + tid] = k1r; Vb[tid] = v0r;
        __syncthreads();
        if (t + 1 < NT) { k0r = Kg[(size_t)(t + 1) * 768 + tid]; if (tid < 256) k1r = Kg[(size_t)(t + 1) * 768 + 512 + tid]; v0r = Vg[(size_t)(t + 1) * 512 + tid]; }
        const int jb = t - (NT - 4);
        if (jb >= 0 && wid * 32 + 31 < 64 * jb) continue;
        const LAS unsigned char* kp = L + AP_K + buf * 12288 + hi * 1024 + r32 * 16;
        f32x16 p0 = {}, p1 = {};
#pragma unroll
        for (int d0 = 0; d0 < 6; ++d0) { const bf16x8 a0 = *(const LAS bf16x8*)(kp + d0 * 2048), a1 = *(const LAS bf16x8*)(kp + d0 * 2048 + 512);
            p0 = __builtin_amdgcn_mfma_f32_32x32x16_bf16(a0, qr[d0], p0, 0, 0, 0); p1 = __builtin_amdgcn_mfma_f32_32x32x16_bf16(a1, qr[d0], p1, 0, 0, 0); }
        if (jb >= 0) {
#pragma unroll
            for (int r = 0; r < 16; ++r) { const int kv = 64 * jb + crow(r, hi); if (kv > qrel) p0[r] = -INFINITY; if (kv + 32 > qrel) p1[r] = -INFINITY; } }
        float alpha; bf16x8 pa0, pa1, pa2, pa3;
        softmax_step(p0, p1, m, l, alpha, pa0, pa1, pa2, pa3);
        if (hi == 0) wsf[r32] = alpha;
        LDS_WAIT();
#pragma unroll
        for (int r = 0; r < 16; ++r) { const float f = wsf[crow(r, hi)]; o0[r] *= f; o1[r] *= f; }
        LDS_WAIT();
        const unsigned vb = vb0 + buf * 8192;
        pv_block(o0, vb, pa0, pa1, pa2, pa3);
        pv_block(o1, vb + 4096, pa0, pa1, pa2, pa3);
    }
    l += __shfl_xor(l, 32);
    if (hi == 0) wsf[32 + r32] = 1.f / l;
    LDS_WAIT();
    bf16* Ow = WSP(bf16, WS_OATT) + ((size_t)b * SEQ + q0 + wid * 32) * 512 + h * 64 + r32;
#pragma unroll
    for (int r = 0; r < 16; ++r) { const int qrow = crow(r, hi); const float f = wsf[32 + qrow]; Ow[(size_t)qrow * 512] = (bf16)f2bf(o0[r] * f); Ow[(size_t)qrow * 512 + 32] = (bf16)f2bf(o1[r] * f); }
    LDS_WAIT();
    __syncthreads();
}

constexpr int AD_KCS = 1040, AD_VDS = 4160, AD_QRS = 592;
constexpr int AD_K = 0, AD_V = 36 * AD_KCS  , AD_Q = AD_V + 8 * AD_VDS  , AD_WS = AD_Q + 32 * AD_QRS  , AD_QN = AD_WS + 8 * 256  ;
__device__ __forceinline__ void attn_decode_unit(Frame& F, int s, int split) {
    const int tid = tid_fresh(), lane = tid & 63, wid = F.wave, r32 = lane & 31, hi = lane >> 5;
    LAS unsigned char* L = F.lds;
    LAS float* wsf = (LAS float*)(L + AD_WS) + wid * 64;
    {
        LAS float* qn = (LAS float*)(L + AD_QN);
        for (int i = tid; i < 2048; i += 512) qn[i] = bf2f(WSP(bf16, WS_QSN)[(size_t)s * 2048 + i]);
        __syncthreads();
        const int r = tid & 255, lh = tid >> 8; const bf16* WK = WSP(bf16, WS_WKV);
        for (int h = 0; h < 8; ++h) { float a0 = 0.f, a1 = 0.f;
#pragma unroll 8
            for (int d = 0; d < 64; ++d) { const float w = bf2f(WK[(size_t)(h * 64 + d) * 256 + r]); a0 += w * qn[(2 * lh) * 512 + h * 64 + d]; a1 += w * qn[(2 * lh + 1) * 512 + h * 64 + d]; }
            *(LAS bf16*)(L + AD_Q + ((2 * lh) * 8 + h) * AD_QRS + r * 2) = (bf16)f2bf(a0 * SCL2); *(LAS bf16*)(L + AD_Q + ((2 * lh + 1) * 8 + h) * AD_QRS + r * 2) = (bf16)f2bf(a1 * SCL2); }
        for (int i = tid; i < 1024; i += 512) { const int row = i >> 5, j = i & 31; *(LAS bf16*)(L + AD_Q + row * AD_QRS + (256 + j) * 2) = WSP(bf16, WS_QSR)[((size_t)s * 32 + row) * 32 + j]; }
        __syncthreads();
    }
    const unsigned vb0 = (unsigned)(size_t)(L + AD_V) + wid * AD_VDS + ((lane >> 4) & 1) * 32 + (lane & 3) * 8 + (4 * hi + ((lane & 15) >> 2)) * 64;
    const LAS unsigned char* kp = L + AD_K + hi * AD_KCS + r32 * 16;
    const LAS unsigned char* qp = L + AD_Q + r32 * AD_QRS + hi * 16;
    float m = -1e30f, l = 0.f; f32x16 o = {};
    const int NTL = 64 + (split == 1 ? 1 : 0);
    f32x4 kreg[8], rreg;
#define AD_LOAD(tile) do { const int pg_ = F.ptab()[s * 64 + split * 32 + ((tile) >> 1)]; const size_t rb_ = (size_t)pg_ * 128 + ((tile) & 1) * 64; \
        _Pragma("unroll") for (int j = 0; j < 8; ++j) { const int g_ = j * 512 + tid; kreg[j] = *(const f32x4*)(F.cache_kv() + (rb_ + (g_ >> 6)) * 256 + (g_ & 63) * 4); } \
        rreg = *(const f32x4*)(F.cache_kr() + (rb_ + (tid >> 3)) * 32 + (tid & 7) * 4); } while (0)
    AD_LOAD(0);
    for (int t = 0; t < NTL; ++t) {
        __syncthreads();
        if (t < 64) {
#pragma unroll
            for (int j = 0; j < 8; ++j) { const int g = j * 512 + tid, key = g >> 6, i = g & 63; v2u w; w.x = pk2(kreg[j][0], kreg[j][1]); w.y = pk2(kreg[j][2], kreg[j][3]);
                *(LAS v2u*)(L + AD_K + (i >> 1) * AD_KCS + key * 16 + (i & 1) * 8) = w;
                *(LAS v2u*)(L + AD_V + (i >> 3) * AD_VDS + (key >> 4) * 1024 + (key & 15) * 64 + (i & 7) * 8) = w; }
            { const int key = tid >> 3, i = tid & 7; v2u w; w.x = pk2(rreg[0], rreg[1]); w.y = pk2(rreg[2], rreg[3]); *(LAS v2u*)(L + AD_K + (32 + (i >> 1)) * AD_KCS + key * 16 + (i & 1) * 8) = w; }
        } else {
#pragma unroll
            for (int j = 0; j < 8; ++j) { const int g = j * 512 + tid, key = g >> 6, i = g & 63; v2u w = {0u, 0u}; if (key < 4) w = *(const v2u*)(WSP(bf16, WS_CKV) + ((size_t)MP + s * 4 + key) * 256 + 4 * i);
                *(LAS v2u*)(L + AD_K + (i >> 1) * AD_KCS + key * 16 + (i & 1) * 8) = w;
                *(LAS v2u*)(L + AD_V + (i >> 3) * AD_VDS + (key >> 4) * 1024 + (key & 15) * 64 + (i & 7) * 8) = w; }
            { const int key = tid >> 3, i = tid & 7; v2u w = {0u, 0u}; if (key < 4) w = *(const v2u*)(WSP(bf16, WS_KRS) + ((size_t)s * 4 + key) * 32 + 4 * i); *(LAS v2u*)(L + AD_K + (32 + (i >> 1)) * AD_KCS + key * 16 + (i & 1) * 8) = w; }
        }
        __syncthreads();
        if (t + 1 < 64) AD_LOAD(t + 1);
        f32x16 p0 = {}, p1 = {};
#pragma unroll 6
        for (int d0 = 0; d0 < 18; ++d0) { const bf16x8 a0 = *(const LAS bf16x8*)(kp + d0 * 2 * AD_KCS), a1 = *(const LAS bf16x8*)(kp + d0 * 2 * AD_KCS + 512), bq = *(const LAS bf16x8*)(qp + d0 * 32);
            p0 = __builtin_amdgcn_mfma_f32_32x32x16_bf16(a0, bq, p0, 0, 0, 0); p1 = __builtin_amdgcn_mfma_f32_32x32x16_bf16(a1, bq, p1, 0, 0, 0); }
        if (t == 64) {
#pragma unroll
            for (int r = 0; r < 16; ++r) { if (crow(r, hi) > (r32 >> 3)) p0[r] = -INFINITY; p1[r] = -INFINITY; } }
        float alpha; bf16x8 pa0, pa1, pa2, pa3;
        softmax_step(p0, p1, m, l, alpha, pa0, pa1, pa2, pa3);
        if (hi == 0) wsf[r32] = alpha;
        LDS_WAIT();
#pragma unroll
        for (int r = 0; r < 16; ++r) o[r] *= wsf[crow(r, hi)];
        LDS_WAIT();
        pv_block(o, vb0, pa0, pa1, pa2, pa3);
    }
#undef AD_LOAD
    l += __shfl_xor(l, 32);
    float* OP = WSP(float, WS_OPART) + ((size_t)(s * 2 + split) * 32) * 256 + wid * 32 + r32;
#pragma unroll
    for (int r = 0; r < 16; ++r) OP[(size_t)crow(r, hi) * 256] = o[r];
    if (wid == 0 && hi == 0) { float* ML = WSP(float, WS_ML) + ((size_t)(s * 2 + split) * 32 + r32) * 2; ML[0] = m; ML[1] = l; }
    __syncthreads();
}

__device__ __forceinline__ void p6_row(Frame& F, int row, const int lane) {
    bf16* A = WSP(bf16, WS_AMIX) + (size_t)row * 1024;
    {
        const float* y = WSP(float, WS_YSSD) + (size_t)row * 512; const bf16* z = WSP(bf16, WS_PROJ) + (size_t)row * NPROJ;
        float v[8]; float s2 = 0.f;
#pragma unroll
        for (int j = 0; j < 2; ++j) { const f32x4 yy = *(const f32x4*)(y + 4 * lane + 256 * j); const v2u zz = *(const v2u*)(z + 4 * lane + 256 * j);
            v[4 * j] = yy[0] * siluf(bflo(zz.x)); v[4 * j + 1] = yy[1] * siluf(bfhi(zz.x)); v[4 * j + 2] = yy[2] * siluf(bflo(zz.y)); v[4 * j + 3] = yy[3] * siluf(bfhi(zz.y)); }
#pragma unroll
        for (int e = 0; e < 8; ++e) s2 += v[e] * v[e];
        const float rstd = 1.f / sqrtf(wave_sum(s2) * (1.f / 512.f) + EPS);
#pragma unroll
        for (int j = 0; j < 2; ++j) { const f32x4 g = *(const f32x4*)(F.g_ssd() + 4 * lane + 256 * j); v2u w; w.x = pk2(v[4 * j] * rstd * g[0], v[4 * j + 1] * rstd * g[1]); w.y = pk2(v[4 * j + 2] * rstd * g[2], v[4 * j + 3] * rstd * g[3]);
            *(v2u*)(A + 4 * lane + 256 * j) = w; }
    }
    float v[8];
    if (row < MP) {
        const bf16* o = WSP(bf16, WS_OATT) + (size_t)row * 512;
#pragma unroll
        for (int j = 0; j < 2; ++j) { const v2u w = *(const v2u*)(o + 4 * lane + 256 * j); v[4 * j] = bflo(w.x); v[4 * j + 1] = bfhi(w.x); v[4 * j + 2] = bflo(w.y); v[4 * j + 3] = bfhi(w.y); }
    } else {
        const int rs = row - MP, s = rs >> 2, l = rs & 3;
        LAS float* ol = (LAS float*)(F.lds + F.wave * 16384);
        for (int h = 0; h < 8; ++h) { const int q = l * 8 + h;
            const float* ml0 = WSP(float, WS_ML) + ((size_t)(s * 2 + 0) * 32 + q) * 2; const float* ml1 = WSP(float, WS_ML) + ((size_t)(s * 2 + 1) * 32 + q) * 2;
            const float m0 = ml0[0], l0 = ml0[1], m1 = ml1[0], l1 = ml1[1], M = fmaxf(m0, m1), w0 = __builtin_amdgcn_exp2f(m0 - M), w1 = __builtin_amdgcn_exp2f(m1 - M), inv = 1.f / (w0 * l0 + w1 * l1);
            const f32x4 a = *(const f32x4*)(WSP(float, WS_OPART) + ((size_t)(s * 2 + 0) * 32 + q) * 256 + 4 * lane), bq = *(const f32x4*)(WSP(float, WS_OPART) + ((size_t)(s * 2 + 1) * 32 + q) * 256 + 4 * lane);
            *(LAS f32x4*)(ol + h * 256 + 4 * lane) = (a * w0 + bq * w1) * inv; }
        LDS_WAIT();
#pragma unroll
        for (int h = 0; h < 8; ++h) { float acc = 0.f;
#pragma unroll 8
            for (int r = 0; r < 256; ++r) acc += ol[h * 256 + r] * F.w_uv()[(size_t)r * 512 + h * 64 + lane];
            v[h] = acc; }
        LDS_WAIT();
    }
    float s2 = 0.f;
#pragma unroll
    for (int e = 0; e < 8; ++e) s2 += v[e] * v[e];
    const float rstd = 1.f / sqrtf(wave_sum(s2) * (1.f / 512.f) + EPS);
    if (row < MP) {
#pragma unroll
        for (int j = 0; j < 2; ++j) { const f32x4 g = *(const f32x4*)(F.g_attn() + 4 * lane + 256 * j); v2u w; w.x = pk2(v[4 * j] * rstd * g[0], v[4 * j + 1] * rstd * g[1]); w.y = pk2(v[4 * j + 2] * rstd * g[2], v[4 * j + 3] * rstd * g[3]);
            *(v2u*)(A + 512 + 4 * lane + 256 * j) = w; }
    } else {
#pragma unroll
        for (int h = 0; h < 8; ++h) A[512 + h * 64 + lane] = (bf16)f2bf(v[h] * rstd * F.g_attn()[h * 64 + lane]);
    }
}

__global__ void __launch_bounds__(NWAVES * 64, 2) hymba_fwd(Args args) {
    extern __shared__ __attribute__((aligned(16))) unsigned char lds[];
    Frame F;
    F.lds = (LAS unsigned char*)lds;
    F.MISC = (volatile LAS unsigned*)(F.lds + MISC_OFF);
    F.wave = __builtin_amdgcn_readfirstlane((int)threadIdx.x >> 6);
    F.G = gridDim.x; { const int bx = blockIdx.x; F.vcu = (F.G % 8 == 0) ? (bx % 8) * (F.G / 8) + bx / 8 : bx; }
    F.ws = args.ws; F.out = args.out; F.ctl = (unsigned*)(args.ws + WS_CTL);
    F.ap = &args;
    for (int u = threadIdx.x; u < (LDS_BYTES - LDSCTL_OFF) / 4; u += NWAVES * 64) ((LAS unsigned*)(F.lds + LDSCTL_OFF))[u] = 0u;
    __syncthreads();
    XcdBarrier bar; bar.bar = F.ctl + CW_BAR; bar.x = 0; bar.st = nullptr;
#if !MK_PER_PHASE
    bar = xcd_barrier_post(F.ctl + CW_BAR, F.MISC + 8);
#endif
    const int lo = args.ph_lo, hi = args.ph_hi;
#define IN(k) (lo <= (k) && (k) < hi)
#if MK_PER_PHASE
#define SEAM(k) do { } while (0)
#else
#define SEAM(k) do { if (IN(k) && IN((k) + 1)) xcd_barrier(bar); } while (0)
#endif
    const int gw = F.vcu * NWAVES + F.wave, NGW = F.G * NWAVES;
    const float* ADA = WSP(float, WS_ADA);

    if (IN(0)) { p0_prologue(F); }
    SEAM(0);
    if (IN(1)) { const int lane = tid_fresh() & 63; for (int m = gw; m < MT; m += NGW) { const float* a = ADA + (size_t)arow_of(m) * 6144; norm_mod_row<true>(xrow_of(F, m), F.g_mix(), a + 1024, a, WSP(bf16, WS_H1) + (size_t)m * 1024, lane); } }
    SEAM(1);
    if (IN(2)) { pg8::Gemm g{WSP(bf16, WS_H1), WSP(bf16, WS_WIN), MT, NPROJ, 1024}; pg8::StaticOrder S; S.init(MT, NPROJ, F.G, (int)blockIdx.x);
        pg8::EpiProj E{WSP(bf16, WS_PROJ), WSP(float, WS_DTRAW)};
        pg8::gemm_phase<pg8::EpiProj, pg8::StaticOrder, true, true>(F.lds, g, S, E); }
    SEAM(2);
    if (IN(3)) { const int lane = tid_fresh() & 63; for (int m = gw; m < MT; m += NGW) p3_row(F, m, lane); }
    SEAM(3);
    if (IN(4)) {
        { int Kk = 256; asm volatile("" : "+s"(Kk)); pg8::Gemm g{WSP(bf16, WS_CKV), WSP(bf16, WS_WKV), MP, 1024, Kk}; pg8::StaticOrder S; S.init(MP, 1024, F.G, (int)blockIdx.x);
          pg8::EpiKV E{WSP(bf16, WS_KP), WSP(bf16, WS_VP)};
          pg8::gemm_phase<pg8::EpiKV, pg8::StaticOrder, true, true>(F.lds, g, S, E); }
        __syncthreads();
        { int Kq = 384; asm volatile("" : "+s"(Kq)); pg8::Gemm g{WSP(bf16, WS_QN), WSP(bf16, WS_WUQ), MT, 768, Kq}; pg8::StaticOrder S; S.init(MT, 768, F.G, (int)blockIdx.x);
          pg8::EpiQ E{WSP(bf16, WS_QP), WSP(bf16, WS_QSN), WSP(bf16, WS_QSR), WSP(float, WS_CS), SCL2};
          pg8::gemm_phase<pg8::EpiQ, pg8::StaticOrder, true, true>(F.lds, g, S, E); }
    }
    SEAM(4);
    if (IN(5)) {
        for (int u = F.vcu; u < 1024; u += F.G) ssd_sample_unit(F, u);
        for (int task = F.wave * F.G + F.vcu; task < 1024; task += NWAVES * F.G) ssd_prompt_task(F, task);
        __syncthreads();
        for (int u = F.vcu; u < 256; u += F.G) attn_decode_unit(F, u >> 1, u & 1);
        for (int v = F.vcu; v < 256; v += F.G) { attn_prompt_unit(F, v >> 4, v & 15); attn_prompt_unit(F, v >> 4, 31 - (v & 15)); }
    }
    SEAM(5);
    if (IN(6)) { const int lane = tid_fresh() & 63; for (int m = gw; m < MT; m += NGW) p6_row(F, m, lane); }
    SEAM(6);
    if (IN(7)) { pg8::Gemm g{WSP(bf16, WS_AMIX), WSP(bf16, WS_WOUT), MT, 1024, 1024}; pg8::StaticOrder S; S.init(MT, 1024, F.G, (int)blockIdx.x);
        pg8::EpiRes E{F.xp(), F.xs(), WSP(float, WS_X1), ADA, 2048};
        pg8::gemm_phase<pg8::EpiRes, pg8::StaticOrder, true, true>(F.lds, g, S, E); }
    SEAM(7);
    if (IN(8)) { const int lane = tid_fresh() & 63; for (int m = gw; m < MT; m += NGW) { const float* a = ADA + (size_t)arow_of(m) * 6144; norm_mod_row<true>(WSP(float, WS_X1) + (size_t)m * 1024, F.g_mlp(), a + 4096, a + 3072, WSP(bf16, WS_H1) + (size_t)m * 1024, lane); } }
    SEAM(8);
    if (IN(9)) { pg8::Gemm g{WSP(bf16, WS_H1), WSP(bf16, WS_WUP), MT, DFF, 1024}; pg8::StaticOrder S; S.init(MT, DFF, F.G, (int)blockIdx.x);
        pg8::EpiUp E{WSP(bf16, WS_U)};
        pg8::gemm_phase<pg8::EpiUp, pg8::StaticOrder, true, true>(F.lds, g, S, E); }
    SEAM(9);
    if (IN(10)) { pg8::Gemm g{WSP(bf16, WS_U), WSP(bf16, WS_WDOWN), MT, 1024, DFF}; pg8::StaticOrder S; S.init(MT, 1024, F.G, (int)blockIdx.x);
        pg8::EpiRes E{WSP(float, WS_X1), WSP(float, WS_X1) + (size_t)MP * 1024, WSP(float, WS_X2), ADA, 5120};
        pg8::gemm_phase<pg8::EpiRes, pg8::StaticOrder, true, true>(F.lds, g, S, E); }
    SEAM(10);
    if (IN(11)) { const int lane = tid_fresh() & 63; const float* AF = WSP(float, WS_ADAF);
        for (int m = gw; m < MT; m += NGW) { const float* a = AF + (size_t)arow_of(m) * 2048; float* o = m < MP ? F.out + O_YP + (size_t)m * 1024 : F.out + O_YS + (size_t)(m - MP) * 1024;
            norm_mod_row<false>(WSP(float, WS_X2) + (size_t)m * 1024, F.g_fin(), a + 1024, a, o, lane); } }
#undef IN
#undef SEAM
}

extern "C" void kernel_launch(void* const* d_in, const int* in_sizes, int n_in, void* d_out, int out_size, void* d_ws, size_t ws_size, hipStream_t stream) {
    static int grid = 0;
    if (grid == 0) {
        if (n_in != 32 || (size_t)out_size != O_END || ws_size < WS_END) { fprintf(stderr, "kernel_launch: unexpected shapes (n_in %d, out %d, ws %zu); nothing launched\n", n_in, out_size, ws_size); grid = -1; return; }
        int dev = 0, cus = 0, per_cu = 0;
        if (hipGetDevice(&dev) != hipSuccess || hipDeviceGetAttribute(&cus, hipDeviceAttributeMultiprocessorCount, dev) != hipSuccess) { fprintf(stderr, "kernel_launch: device query failed\n"); grid = -1; return; }
        if (hipFuncSetAttribute((const void*)hymba_fwd, hipFuncAttributeMaxDynamicSharedMemorySize, LDS_BYTES) != hipSuccess) { fprintf(stderr, "kernel_launch: hipFuncSetAttribute failed\n"); grid = -1; return; }
        if (hipOccupancyMaxActiveBlocksPerMultiprocessor(&per_cu, (const void*)hymba_fwd, NWAVES * 64, LDS_BYTES) != hipSuccess || per_cu < 1) fprintf(stderr, "kernel_launch: note: occupancy query reports %d workgroups per CU\n", per_cu);
        (void)hipGetLastError();
        grid = cus;
    }
    if (grid < 0) return;
    if (hipMemsetAsync((char*)d_ws + WS_CTL, 0, CTL_ZERO_BYTES, stream) != hipSuccess) { fprintf(stderr, "kernel_launch: memset failed\n"); return; }
    Args a{};
    for (int i = 0; i < 32; ++i) a.in[i] = d_in[i];
    a.out = (float*)d_out; a.ws = (unsigned char*)d_ws;
#if MK_PER_PHASE
    for (int p = 0; p < NPHASE; ++p) { a.ph_lo = p; a.ph_hi = p + 1; hipLaunchKernelGGL(hymba_fwd, dim3(grid), dim3(NWAVES * 64), LDS_BYTES, stream, a); }
#else
    a.ph_lo = 0; a.ph_hi = NPHASE;
    hipLaunchKernelGGL(hymba_fwd, dim3(grid), dim3(NWAVES * 64), LDS_BYTES, stream, a);
#endif
    const hipError_t le = hipPeekAtLastError();
    if (le != hipSuccess) fprintf(stderr, "kernel_launch: launch failed: %s\n", hipGetErrorName(le));
}
```

```cpp
#include <hip/hip_runtime.h>
#include <cstdio>
#include <cstdint>

#ifndef MK_PER_PHASE
#define MK_PER_PHASE 0
#endif
namespace pg8 {
#define PG8_LAS __attribute__((address_space(3)))
typedef unsigned short bf16_t;
typedef short bf16x8 __attribute__((ext_vector_type(8)));
typedef float f32x4 __attribute__((ext_vector_type(4)));
typedef unsigned u32x4 __attribute__((ext_vector_type(4)));
constexpr int BM = 256, BK = 64, HALF = 128, HTB = HALF * BK * 2  , STAGE_BYTES = 8 * HTB, NXCD = 8, WGM = 8;

__host__ __device__ __forceinline__ int lds_byte(int r, int c) { const int st = (r >> 4) * 2 + (c >> 5), rr = r & 15, cc = c & 31, ob = rr * 64 + cc * 2; return st * 1024 + (ob ^ (((ob >> 9) & 1) << 5)); }
__host__ __device__ __forceinline__ void stage_rc(int b, int& R, int& C) { const int st = b / 1024, sb = b % 1024, swz = sb ^ (((sb >> 9) & 1) << 5); R = (st >> 1) * 16 + swz / 64; C = (st & 1) * 32 + (swz % 64) / 2; }
__host__ __device__ __forceinline__ int perm32(int rho) { const int n = rho >> 4, i = rho & 15; return 8 * (i >> 2) + 4 * n + (i & 3); }

struct Unit { int pm, pn; };
struct Gemm { const bf16_t* A; const bf16_t* Bt; int M, N, K; };

struct StaticOrder {
    int nM, nN, nwg, G, c;
    __host__ __device__ void init(int M, int N, int G_, int c_) { nM = M / BM; nN = N / BM; nwg = nM * nN; G = G_; c = c_; }
    __host__ __device__ bool next(int i, Unit& u) const {
        const long L = (long)i * G + c; if (L >= nwg) return false;
        int wgid = (int)L; { const int q = nwg / NXCD, r = nwg % NXCD, xcd = wgid % NXCD, off = wgid / NXCD; wgid = (xcd < r ? xcd * (q + 1) : r * (q + 1) + (xcd - r) * q) + off; }
        const int nig = WGM * nN, gid = wgid / nig, fm = gid * WGM, gsz = (nM - fm) < WGM ? (nM - fm) : WGM;
        u.pm = fm + ((wgid % nig) % gsz); u.pn = (wgid % nig) / gsz; return true;
    }
    __device__ __forceinline__ void a_ready(const Unit&) const {}
    __device__ __forceinline__ void done(const Unit&) const {}
};

__device__ __forceinline__ unsigned cvt_pk_bf16(float lo, float hi) { unsigned r; asm volatile("v_cvt_pk_bf16_f32 %0, %1, %2" : "=v"(r) : "v"(lo), "v"(hi)); return r; }
typedef float f32x2 __attribute__((ext_vector_type(2)));
typedef unsigned u32x2 __attribute__((ext_vector_type(2)));
struct EpiProj {
    static constexpr bool PERM = true, AFTER_DRAIN = false;
    bf16_t* O; float* dtraw;
    __device__ __forceinline__ void operator()(const f32x4 (&acc)[2][2][4][2], const Unit& u, int wr, int wc, int fr, int fq) const {
        const int row0 = u.pm * BM + wr * 64 + fr, col0 = u.pn * BM + wc * 32 + 8 * fq;
#pragma unroll
        for (int ai = 0; ai < 2; ++ai)
#pragma unroll
            for (int m = 0; m < 4; ++m) { const int row = row0 + ai * HALF + m * 16; bf16_t* rowp = O + (size_t)row * 2304 + col0;
#pragma unroll
                for (int bj = 0; bj < 2; ++bj) { const f32x4 v0 = acc[ai][bj][m][0], v1 = acc[ai][bj][m][1];
                    u32x4 w; w.x = cvt_pk_bf16(v0[0], v0[1]); w.y = cvt_pk_bf16(v0[2], v0[3]); w.z = cvt_pk_bf16(v1[0], v1[1]); w.w = cvt_pk_bf16(v1[2], v1[3]);
                    *(u32x4*)(rowp + bj * HALF) = w;
                    if (col0 + bj * HALF == 2208) { *(f32x4*)(dtraw + (size_t)row * 8) = v0; *(f32x4*)(dtraw + (size_t)row * 8 + 4) = v1; } } }
    }
};
struct EpiQ {
    static constexpr bool PERM = false, AFTER_DRAIN = false;
    bf16_t* QP; bf16_t* QSN; bf16_t* QSR; const float* CS; float scl;
    __device__ __forceinline__ void operator()(const f32x4 (&acc)[2][2][4][2], const Unit& u, int wr, int wc, int fr, int fq) const {
        const int row0 = u.pm * BM + wr * 64 + fr;
#pragma unroll
        for (int ai = 0; ai < 2; ++ai)
#pragma unroll
            for (int m = 0; m < 4; ++m) { const int row = row0 + ai * HALF + m * 16; const bool isp = row < 16384; const int b = row >> 13, t = row & 8191, rs = row - 16384, l = rs & 3;
                if (u.pn < 2) {
#pragma unroll
                    for (int bj = 0; bj < 2; ++bj)
#pragma unroll
                        for (int n = 0; n < 2; ++n) { const int col = u.pn * BM + bj * HALF + wc * 32 + n * 16 + 4 * fq, h = col >> 6, d = col & 63; const f32x4 v = acc[ai][bj][m][n];
                            if (isp) { u32x2 w; w.x = cvt_pk_bf16(v[0] * scl, v[1] * scl); w.y = cvt_pk_bf16(v[2] * scl, v[3] * scl); *(u32x2*)(QP + ((size_t)(b * 8 + h) * 8192 + t) * 96 + d) = w; }
                            else { u32x2 w; w.x = cvt_pk_bf16(v[0], v[1]); w.y = cvt_pk_bf16(v[2], v[3]); *(u32x2*)(QSN + (size_t)rs * 512 + col) = w; } }
                } else {
                    const int pos = isp ? t : 8192 + l; const int i0 = 4 * fq;
                    const f32x4 c0 = *(const f32x4*)(CS + ((size_t)pos * 16 + i0) * 2), c1 = *(const f32x4*)(CS + ((size_t)pos * 16 + i0) * 2 + 4);
                    const float cs_[4] = {c0[0], c0[2], c1[0], c1[2]}, sn_[4] = {c0[1], c0[3], c1[1], c1[3]};
#pragma unroll
                    for (int bj = 0; bj < 2; ++bj) { const int h = 4 * bj + wc; const f32x4 x1 = acc[ai][bj][m][0], x2 = acc[ai][bj][m][1]; float o1[4], o2[4];
#pragma unroll
                        for (int j = 0; j < 4; ++j) { o1[j] = (x1[j] * cs_[j] - x2[j] * sn_[j]) * scl; o2[j] = (x1[j] * sn_[j] + x2[j] * cs_[j]) * scl; }
                        u32x2 w1, w2; w1.x = cvt_pk_bf16(o1[0], o1[1]); w1.y = cvt_pk_bf16(o1[2], o1[3]); w2.x = cvt_pk_bf16(o2[0], o2[1]); w2.y = cvt_pk_bf16(o2[2], o2[3]);
                        bf16_t* dst = isp ? QP + ((size_t)(b * 8 + h) * 8192 + t) * 96 + 64 + i0 : QSR + ((size_t)rs * 8 + h) * 32 + i0;
                        *(u32x2*)dst = w1; *(u32x2*)(dst + 16) = w2; }
                } }
    }
};
struct EpiKV {
    static constexpr bool PERM = true, AFTER_DRAIN = false;
    bf16_t* KP; bf16_t* VP;
    __device__ __forceinline__ void operator()(const f32x4 (&acc)[2][2][4][2], const Unit& u, int wr, int wc, int fr, int fq) const {
        const int row0 = u.pm * BM + wr * 64 + fr, col0 = u.pn * BM + wc * 32 + 8 * fq;
#pragma unroll
        for (int ai = 0; ai < 2; ++ai)
#pragma unroll
            for (int m = 0; m < 4; ++m) { const int row = row0 + ai * HALF + m * 16; const int b = row >> 13, t = row & 8191, tile = t >> 6, key = t & 63;
#pragma unroll
                for (int bj = 0; bj < 2; ++bj) { const int col = col0 + bj * HALF; const f32x4 v0 = acc[ai][bj][m][0], v1 = acc[ai][bj][m][1];
                    u32x4 w; w.x = cvt_pk_bf16(v0[0], v0[1]); w.y = cvt_pk_bf16(v0[2], v0[3]); w.z = cvt_pk_bf16(v1[0], v1[1]); w.w = cvt_pk_bf16(v1[2], v1[3]);
                    bf16_t* dst;
                    if (col < 512) { const int h = col >> 6, d = col & 63; dst = KP + ((((size_t)(b * 8 + h)) * 128 + tile) * 12 + (d >> 3)) * 512 + key * 8; }
                    else { const int cc = col - 512, h = cc >> 6, d = cc & 63; dst = VP + ((((size_t)(b * 8 + h)) * 128 + tile) * 2 + (d >> 5)) * 2048 + (key >> 4) * 512 + (key & 15) * 32 + (d & 31); }
                    *(u32x4*)dst = w; } }
    }
};
struct EpiRes {
    static constexpr bool PERM = false, AFTER_DRAIN = false;
    const float* baseP; const float* baseS; float* out; const float* ada; int goff;
    __device__ __forceinline__ void operator()(const f32x4 (&acc)[2][2][4][2], const Unit& u, int wr, int wc, int fr, int fq) const {
        const int row0 = u.pm * BM + wr * 64 + fr;
#pragma unroll
        for (int ai = 0; ai < 2; ++ai)
#pragma unroll
            for (int m = 0; m < 4; ++m) { const int row = row0 + ai * HALF + m * 16; const bool isp = row < 16384;
                const float* brow = isp ? baseP + (size_t)row * 1024 : baseS + (size_t)(row - 16384) * 1024;
                const float* g = ada + (size_t)(isp ? (row >> 13) : 2 + ((row - 16384) >> 2)) * 6144 + goff;
#pragma unroll
                for (int bj = 0; bj < 2; ++bj)
#pragma unroll
                    for (int n = 0; n < 2; ++n) { const int col = u.pn * BM + bj * HALF + wc * 32 + n * 16 + 4 * fq;
                        const f32x4 o = *(const f32x4*)(brow + col) + *(const f32x4*)(g + col) * acc[ai][bj][m][n];
                        *(f32x4*)(out + (size_t)row * 1024 + col) = o; } }
    }
};
struct EpiUp {
    static constexpr bool PERM = true, AFTER_DRAIN = false;
    bf16_t* O;
    __device__ __forceinline__ void operator()(const f32x4 (&acc)[2][2][4][2], const Unit& u, int wr, int wc, int fr, int fq) const {
        const int row0 = u.pm * BM + wr * 64 + fr, col0 = u.pn * BM + wc * 32 + 8 * fq;
#pragma unroll
        for (int ai = 0; ai < 2; ++ai)
#pragma unroll
            for (int m = 0; m < 4; ++m) { bf16_t* rowp = O + (size_t)(row0 + ai * HALF + m * 16) * 4096 + col0;
#pragma unroll
                for (int bj = 0; bj < 2; ++bj) { f32x4 v0 = acc[ai][bj][m][0], v1 = acc[ai][bj][m][1];
#pragma unroll
                    for (int j = 0; j < 4; ++j) { const float a = v0[j] > 0.f ? v0[j] : 0.f, b = v1[j] > 0.f ? v1[j] : 0.f; v0[j] = a * a; v1[j] = b * b; }
                    u32x4 w; w.x = cvt_pk_bf16(v0[0], v0[1]); w.y = cvt_pk_bf16(v0[2], v0[3]); w.z = cvt_pk_bf16(v1[0], v1[1]); w.w = cvt_pk_bf16(v1[2], v1[3]);
                    *(u32x4*)(rowp + bj * HALF) = w; } }
    }
};
template <class Epi, class Sched, bool ALIGN_EPI = false, bool SP2 = false>
__device__ __forceinline__ void gemm_phase(PG8_LAS unsigned char* lds, const Gemm g, const Sched& S, const Epi& E) {
    const int tid = threadIdx.x, wid = __builtin_amdgcn_readfirstlane(tid >> 6), lane = tid & 63, wr = wid >> 2, wc = wid & 3, fr = lane & 15, fq = lane >> 4;
    const int K = g.K, nt = K / BK;
    unsigned voffA[2], voffB[2];
#pragma unroll
    for (int i = 0; i < 2; ++i) { int R, C; stage_rc(tid * 16 + i * 8192, R, C); const int Rb = Epi::PERM ? ((R & ~31) + perm32(R & 31)) : R;
        voffA[i] = (unsigned)(R * K + C) * 2u; voffB[i] = (unsigned)(Rb * K + C) * 2u; }
    const size_t kstep = (size_t)(BK * 2);
    const size_t hstep = (size_t)HALF * K * 2;
    const size_t tstep = 2 * hstep;
    const unsigned ldsw = (unsigned)wid * 1024u;
    const int aoff = lds_byte(wr * 64 + fr, fq * 8), boff = lds_byte(wc * 32 + fr, fq * 8);
#define PG8_SA(b, h) (((b) * 2 + (h)) * HTB)
#define PG8_SB(b, h) ((4 + (b) * 2 + (h)) * HTB)
#define PG8_STAGE(bufoff, gbase, voff) do { _Pragma("unroll") for (int _i = 0; _i < 2; ++_i) \
        __builtin_amdgcn_global_load_lds((const unsigned*)((const char*)(gbase) + (voff)[_i]), (PG8_LAS unsigned*)(lds + (bufoff) + ldsw + _i * 8192), 16, 0, 0); } while (0)
#define PG8_LDA(dst, b, h) do { _Pragma("unroll") for (int m = 0; m < 4; ++m) _Pragma("unroll") for (int k = 0; k < 2; ++k) dst[m][k] = *(const PG8_LAS bf16x8*)(lds + PG8_SA(b, h) + aoff + m * 2048 + k * 1024); } while (0)
#define PG8_LDB(dst, b, h) do { _Pragma("unroll") for (int n = 0; n < 2; ++n) _Pragma("unroll") for (int k = 0; k < 2; ++k) dst[n][k] = *(const PG8_LAS bf16x8*)(lds + PG8_SB(b, h) + boff + n * 2048 + k * 1024); } while (0)
#define PG8_MMA(ai, bj, At, Bt) do { __builtin_amdgcn_s_setprio(1); _Pragma("unroll") for (int m = 0; m < 4; ++m) _Pragma("unroll") for (int n = 0; n < 2; ++n) _Pragma("unroll") for (int k = 0; k < 2; ++k) \
        acc[ai][bj][m][n] = __builtin_amdgcn_mfma_f32_16x16x32_bf16(Bt[n][k], At[m][k], acc[ai][bj][m][n], 0, 0, 0); __builtin_amdgcn_s_setprio(0); } while (0)
#define PG8_WAIT_V(n) asm volatile("s_waitcnt vmcnt(" #n ")" ::: "memory")
#define PG8_WAIT_L(n) asm volatile("s_waitcnt lgkmcnt(" #n ")" ::: "memory")
#define PG8_BAR __builtin_amdgcn_s_barrier()
#define PG8_SCHED __builtin_amdgcn_sched_barrier(0)
    Unit cur, nxt; int ui = 0;
    if (!S.next(0, cur)) return;
    f32x4 acc[2][2][4][2];
#pragma unroll
    for (int a = 0; a < 2; ++a)
#pragma unroll
        for (int b = 0; b < 2; ++b)
#pragma unroll
            for (int m = 0; m < 4; ++m)
#pragma unroll
                for (int n = 0; n < 2; ++n) acc[a][b][m][n] = (f32x4){0.f, 0.f, 0.f, 0.f};
    bf16x8 At[4][2], B0[2][2], B1[2][2];
    const char* cA = (const char*)g.A + (size_t)cur.pm * tstep; const char* cB = (const char*)g.Bt + (size_t)cur.pn * tstep;
    S.a_ready(cur);
    if constexpr (SP2) {
        PG8_STAGE(PG8_SB(0, 0), cB, voffB); PG8_STAGE(PG8_SB(0, 1), cB + hstep, voffB); PG8_STAGE(PG8_SA(0, 0), cA, voffA); PG8_STAGE(PG8_SA(0, 1), cA + hstep, voffA);
        if (wr == 1) PG8_BAR;
        PG8_WAIT_V(2); PG8_BAR;
        PG8_STAGE(PG8_SB(1, 0), cB + kstep, voffB); PG8_STAGE(PG8_SA(1, 0), cA + kstep, voffA); PG8_STAGE(PG8_SB(1, 1), cB + hstep + kstep, voffB);
        PG8_WAIT_V(6); PG8_BAR;
    } else {
        PG8_STAGE(PG8_SB(0, 0), cB, voffB); PG8_STAGE(PG8_SA(0, 0), cA, voffA); PG8_STAGE(PG8_SB(0, 1), cB + hstep, voffB); PG8_STAGE(PG8_SA(0, 1), cA + hstep, voffA);
        if (wr == 1) PG8_BAR;
        PG8_WAIT_V(4); PG8_BAR;
        PG8_STAGE(PG8_SB(1, 0), cB + kstep, voffB); PG8_STAGE(PG8_SA(1, 0), cA + kstep, voffA); PG8_STAGE(PG8_SB(1, 1), cB + hstep + kstep, voffB);
        PG8_WAIT_V(6); PG8_BAR;
    }
    for (;;) {
        const bool has_next = S.next(ui + 1, nxt);
        const char* nA = has_next ? (const char*)g.A + (size_t)nxt.pm * tstep : cA; const char* nB = has_next ? (const char*)g.Bt + (size_t)nxt.pn * tstep : cB;
        for (int t = 0; t < nt; t += 2) {
            const bool last = (t == nt - 2);
            const char* a1 = cA + (size_t)(t + 1) * kstep;
            const char* a2 = last ? nA : cA + (size_t)(t + 2) * kstep; const char* b2 = last ? nB : cB + (size_t)(t + 2) * kstep;
            const char* a3 = a2 + kstep; const char* b3 = b2 + kstep;
            if (last && has_next) S.a_ready(nxt);
            if constexpr (SP2) {
            PG8_LDB(B0, 0, 0); PG8_LDB(B1, 0, 1); PG8_SCHED; PG8_LDA(At, 0, 0); PG8_STAGE(PG8_SA(1, 1), a1 + hstep, voffA);
            PG8_WAIT_V(8); PG8_WAIT_L(0); PG8_BAR; PG8_MMA(0, 0, At, B0); PG8_MMA(0, 1, At, B1); PG8_BAR; PG8_SCHED;
            PG8_LDA(At, 0, 1); PG8_STAGE(PG8_SB(0, 0), b2, voffB); PG8_STAGE(PG8_SB(0, 1), b2 + hstep, voffB); PG8_STAGE(PG8_SA(0, 0), a2, voffA);
            PG8_WAIT_V(8); PG8_WAIT_L(0); PG8_BAR; PG8_MMA(1, 0, At, B0); PG8_MMA(1, 1, At, B1); PG8_BAR; PG8_SCHED;
            PG8_LDB(B0, 1, 0); PG8_LDB(B1, 1, 1); PG8_SCHED; PG8_LDA(At, 1, 0); PG8_STAGE(PG8_SA(0, 1), a2 + hstep, voffA);
            PG8_WAIT_V(8); PG8_WAIT_L(0); PG8_BAR; PG8_MMA(0, 0, At, B0); PG8_MMA(0, 1, At, B1); PG8_BAR; PG8_SCHED;
            PG8_LDA(At, 1, 1); PG8_STAGE(PG8_SB(1, 0), b3, voffB); PG8_STAGE(PG8_SB(1, 1), b3 + hstep, voffB); PG8_STAGE(PG8_SA(1, 0), a3, voffA);
            PG8_WAIT_V(8); PG8_WAIT_L(0); PG8_BAR; PG8_MMA(1, 0, At, B0); PG8_MMA(1, 1, At, B1); PG8_BAR; PG8_SCHED;
            } else {
            PG8_LDB(B0, 0, 0); PG8_SCHED; PG8_LDA(At, 0, 0); PG8_STAGE(PG8_SA(1, 1), a1 + hstep, voffA);
            PG8_WAIT_L(8); PG8_BAR; PG8_WAIT_L(0); PG8_MMA(0, 0, At, B0); PG8_BAR; PG8_SCHED;
            PG8_LDB(B1, 0, 1); PG8_STAGE(PG8_SB(0, 0), b2, voffB);
            PG8_BAR; PG8_WAIT_L(0); PG8_MMA(0, 1, At, B1); PG8_BAR;
            PG8_LDA(At, 0, 1); PG8_STAGE(PG8_SA(0, 0), a2, voffA);
            PG8_BAR; PG8_WAIT_L(0); PG8_MMA(1, 0, At, B0); PG8_BAR; PG8_SCHED;
            PG8_STAGE(PG8_SB(0, 1), b2 + hstep, voffB);
            PG8_WAIT_V(6); PG8_BAR; PG8_MMA(1, 1, At, B1); PG8_BAR;
            PG8_LDB(B0, 1, 0); PG8_SCHED; PG8_LDA(At, 1, 0); PG8_STAGE(PG8_SA(0, 1), a2 + hstep, voffA);
            PG8_WAIT_L(8); PG8_BAR; PG8_WAIT_L(0); PG8_MMA(0, 0, At, B0); PG8_BAR; PG8_SCHED;
            PG8_LDB(B1, 1, 1); PG8_STAGE(PG8_SB(1, 0), b3, voffB);
            PG8_BAR; PG8_WAIT_L(0); PG8_MMA(0, 1, At, B1); PG8_BAR;
            PG8_LDA(At, 1, 1); PG8_STAGE(PG8_SA(1, 0), a3, voffA);
            PG8_BAR; PG8_WAIT_L(0); PG8_MMA(1, 0, At, B0); PG8_BAR; PG8_SCHED;
            PG8_STAGE(PG8_SB(1, 1), b3 + hstep, voffB);
            PG8_WAIT_V(6); PG8_BAR; PG8_MMA(1, 1, At, B1); PG8_BAR;
            }
        }
        if constexpr (ALIGN_EPI) { if (wr == 0) PG8_BAR; }
        if constexpr (!Epi::AFTER_DRAIN) { E(acc, cur, wr, wc, fr, fq); S.done(cur); }
        if (!has_next) break;
#pragma unroll
        for (int a = 0; a < 2; ++a)
#pragma unroll
            for (int b = 0; b < 2; ++b)
#pragma unroll
                for (int m = 0; m < 4; ++m)
#pragma unroll
                    for (int n = 0; n < 2; ++n) acc[a][b][m][n] = (f32x4){0.f, 0.f, 0.f, 0.f};
        cur = nxt; cA = nA; cB = nB; ++ui;
        if constexpr (ALIGN_EPI) { if (wr == 1) PG8_BAR; }
    }
    PG8_WAIT_V(0);
    if constexpr (!ALIGN_EPI) { if (wr == 0) PG8_BAR; }
    PG8_BAR;
    if constexpr (Epi::AFTER_DRAIN) { E.fused(acc, cur, wr, wc, fr, fq, lds, wid, lane); S.done(cur); }
#undef PG8_SA
#undef PG8_SB
#undef PG8_STAGE
#undef PG8_LDA
#undef PG8_LDB
#undef PG8_MMA
#undef PG8_WAIT_V
#undef PG8_WAIT_L
#undef PG8_BAR
#undef PG8_SCHED
}
}
constexpr int DM = 1024, SEQ = 8192, MP = 16384, NSEQ = 128, MS = 512, MT = 16896, NPROJ = 2304, DFF = 4096;
constexpr float EPS = 1e-6f;
constexpr float SCL2 = 0.1472444460259031f;
constexpr size_t MiB = 1u << 20;
constexpr size_t WS_CTL = 0, CTL_ZERO_BYTES = 1 * MiB;
constexpr size_t WS_WIN = 2 * MiB, WS_WUQ = 7 * MiB, WS_WKV = 8 * MiB, WS_WOUT = 9 * MiB, WS_WUP = 11 * MiB, WS_WDOWN = 19 * MiB;
constexpr size_t WS_ADA = 27 * MiB, WS_ADAF = 31 * MiB, WS_CS = 33 * MiB, WS_DTRAW = 35 * MiB, WS_DT = 36 * MiB, WS_QSN = 37 * MiB, WS_QSR = 38 * MiB, WS_KRS = 38 * MiB + 512 * 1024;
constexpr size_t WS_OPART = 39 * MiB, WS_ML = 47 * MiB, WS_H1 = 48 * MiB, WS_PROJ = 82 * MiB, WS_XBC = 158 * MiB, WS_QN = 192 * MiB, WS_CKV = 206 * MiB;
constexpr size_t WS_QP = 216 * MiB, WS_KP = 240 * MiB, WS_VP = 264 * MiB, WS_YSSD = 280 * MiB, WS_OATT = 314 * MiB, WS_AMIX = 332 * MiB, WS_X1 = 366 * MiB, WS_U = 432 * MiB, WS_X2 = 564 * MiB, WS_SCH = 632 * MiB, WS_HP = 664 * MiB, WS_CD = 680 * MiB, WS_EACS = 681 * MiB, WS_END = 682 * MiB;
constexpr int CW_BAR = 4096;
constexpr size_t O_YP = 0, O_YS = 16777216, O_KVP = 17301504, O_KRP = 21495808, O_CVP = 22020096, O_SSP = 22026240, O_KVS = 22157312, O_KRS = 22288384, O_CVS = 22304768, O_SSS = 22697984, O_END = 31086592;
constexpr int PHASE_LDS = 143360, LDSCTL_OFF = PHASE_LDS, MISC_OFF = LDSCTL_OFF + 320, LDS_BYTES = 147456;
constexpr int NWAVES = 8, NPHASE = 13;

#define GAS __attribute__((address_space(1)))
#define LAS __attribute__((address_space(3)))
typedef unsigned short bf16;
typedef unsigned v4u __attribute__((ext_vector_type(4)));
typedef unsigned v2u __attribute__((ext_vector_type(2)));
typedef float f32x4 __attribute__((ext_vector_type(4)));
typedef float f32x16 __attribute__((ext_vector_type(16)));
typedef short bf16x8 __attribute__((ext_vector_type(8)));
typedef short s16x4 __attribute__((ext_vector_type(4)));
#define LDS_WAIT() asm volatile("s_waitcnt lgkmcnt(0)" ::: "memory")
__device__ __forceinline__ unsigned f2bf(float f) { unsigned u = __builtin_bit_cast(unsigned, f); return (u + 0x7fffu + ((u >> 16) & 1u)) >> 16; }
__device__ __forceinline__ unsigned pk2(float lo, float hi) { return f2bf(lo) | (f2bf(hi) << 16); }
__device__ __forceinline__ float bflo(unsigned w) { return __uint_as_float(w << 16); }
__device__ __forceinline__ float bfhi(unsigned w) { return __uint_as_float(w & 0xffff0000u); }
__device__ __forceinline__ float bf2f(bf16 v) { return __uint_as_float((unsigned)v << 16); }
__device__ __forceinline__ float wave_sum(float v) {
#pragma unroll
    for (int o = 1; o < 64; o <<= 1) v += __shfl_xor(v, o);
    return v;
}
__device__ __forceinline__ float siluf(float v) { return v / (1.f + __expf(-v)); }

__constant__ double ROPE_REV[16] = {0.15915494309189535, 0.08949940160889101, 0.050329212104487035, 0.0283021958306234, 0.015915494309189534, 0.008949940160889102, 0.005032921210448704, 0.00283021958306234,
    0.0015915494309189536, 0.0008949940160889102, 0.0005032921210448703, 0.00028302195830623395, 0.00015915494309189535, 8.949940160889102e-05, 5.0329212104487035e-05, 2.8302195830623396e-05};

#define XB_TMO      128
#define XB_XCNT(j)  (256  + 64 * (j))
#define XB_XSUB(j)  (1280 + 64 * (j))
#define XB_XGEN(j)  (2304 + 64 * (j))
#define XB_TOP      3328
#define XB_TOPGEN   3392
#define XCD_BAR_WORDS 3456
#define XB_SPIN_CAP (1u << 18)

__device__ __forceinline__ unsigned xb_ld(unsigned* p)              { return __hip_atomic_load(p, __ATOMIC_RELAXED, __HIP_MEMORY_SCOPE_AGENT); }
__device__ __forceinline__ unsigned xb_add(unsigned* p, unsigned v) { return __hip_atomic_fetch_add(p, v, __ATOMIC_RELAXED, __HIP_MEMORY_SCOPE_AGENT); }
__device__ __forceinline__ unsigned xb_xcc_id() { return (unsigned)__builtin_amdgcn_s_getreg((3 << 11) | 20) & 0xFu; }
#define XB_SPIN(cond, bar) do { unsigned _sp = 0; while (cond) { __builtin_amdgcn_s_sleep(1); \
    if ((++_sp & 255u) == 0u) { if (xb_ld(&(bar)[XB_TMO])) break; if (_sp > XB_SPIN_CAP) { atomicAdd(&(bar)[XB_TMO], 1u); break; } } } } while (0)

struct XcdBarrier {
    unsigned* bar; unsigned x;
    volatile LAS unsigned* st;
};

__device__ __forceinline__ XcdBarrier xcd_barrier_post(unsigned* bar, volatile LAS unsigned* st) {
    XcdBarrier b; b.bar = bar; b.x = xb_xcc_id(); b.st = st;
    if (threadIdx.x == 0) (void)xb_add(&bar[XB_XCNT(b.x)], 1u);
    return b;
}
__device__ __forceinline__ void xcd_barrier_complete(unsigned* bar, unsigned x, unsigned& nloc, unsigned& nx) {
    const unsigned G = gridDim.x * gridDim.y * gridDim.z;
    unsigned sum, cnt, mine, sp = 0u;
    for (;;) {
        sum = 0u; cnt = 0u; mine = 0u;
#pragma unroll
        for (unsigned j = 0; j < 16; ++j) { const unsigned c = xb_ld(&bar[XB_XCNT(j)]); sum += c; cnt += (c > 0u) ? 1u : 0u; mine = (j == x) ? c : mine; }
        if (sum == G) break;
        __builtin_amdgcn_s_sleep(1);
        if ((++sp & 255u) == 0u) { if (xb_ld(&bar[XB_TMO])) break; if (sp > XB_SPIN_CAP) { atomicAdd(&bar[XB_TMO], 1u); break; } }
    }
    nloc = mine > 0u ? mine : 1u; nx = cnt > 0u ? cnt : 1u;
}

__device__ __forceinline__ void xcd_barrier(const XcdBarrier& b) {
    asm volatile("s_waitcnt vmcnt(0)" ::: "memory");
    __syncthreads();
    if (threadIdx.x == 0) {
        unsigned* bar = b.bar;
        __builtin_amdgcn_s_waitcnt(0);
        unsigned nloc = b.st[0], nx = b.st[1];
        if (nloc == 0u) { xcd_barrier_complete(bar, b.x, nloc, nx); b.st[0] = nloc; b.st[1] = nx; }
        const unsigned old = xb_add(&bar[XB_XSUB(b.x)], 1u);
        const unsigned gen = old / nloc;
        if (old + 1u == (gen + 1u) * nloc) {
            __builtin_amdgcn_fence(__ATOMIC_RELEASE, "agent");
            asm volatile("s_waitcnt vmcnt(0)" ::: "memory");
            const unsigned og = xb_add(&bar[XB_TOP], 1u);
            const unsigned tg = og / nx;
            if (og + 1u == (tg + 1u) * nx) xb_add(&bar[XB_TOPGEN], 1u);
            else XB_SPIN(xb_ld(&bar[XB_TOPGEN]) == tg, bar);
            __builtin_amdgcn_fence(__ATOMIC_ACQUIRE, "agent");
            xb_add(&bar[XB_XGEN(b.x)], 1u);
            asm volatile("s_waitcnt vmcnt(0)" ::: "memory");
        } else {
            XB_SPIN(xb_ld(&bar[XB_XGEN(b.x)]) == gen, bar);
            __builtin_amdgcn_fence(__ATOMIC_ACQUIRE, "agent");
            asm volatile("s_waitcnt vmcnt(0)" ::: "memory");
        }
    }
    __syncthreads();
}

struct Args { const void* in[32]; float* out; unsigned char* ws; int ph_lo, ph_hi; };
struct Frame {
    LAS unsigned char* lds;
    volatile LAS unsigned* MISC;
    unsigned* ctl;
    int wave, vcu, G;
    const Args* ap;
    float* out; unsigned char* ws;
    __device__ __forceinline__ const void* inp(int k) const { asm volatile("" : "+s"(k)); return ap->in[k]; }
    __device__ __forceinline__ const float* xp() const { return (const float*)inp(0); }
    __device__ __forceinline__ const float* xs() const { return (const float*)inp(1); }
    __device__ __forceinline__ const float* cache_kv() const { return (const float*)inp(2); }
    __device__ __forceinline__ const float* cache_kr() const { return (const float*)inp(3); }
    __device__ __forceinline__ const float* sconv() const { return (const float*)inp(4); }
    __device__ __forceinline__ const float* sssm() const { return (const float*)inp(5); }
    __device__ __forceinline__ const int* ptab() const { return (const int*)inp(6); }
    __device__ __forceinline__ const float* cprm() const { return (const float*)inp(7); }
    __device__ __forceinline__ const float* csmp() const { return (const float*)inp(8); }
    __device__ __forceinline__ const float* w_ada() const { return (const float*)inp(9); }
    __device__ __forceinline__ const float* b_ada() const { return (const float*)inp(10); }
    __device__ __forceinline__ const float* g_mix() const { return (const float*)inp(11); }
    __device__ __forceinline__ const float* w_in() const { return (const float*)inp(12); }
    __device__ __forceinline__ const float* conv_w() const { return (const float*)inp(13); }
    __device__ __forceinline__ const float* conv_b() const { return (const float*)inp(14); }
    __device__ __forceinline__ const float* dt_bias() const { return (const float*)inp(15); }
    __device__ __forceinline__ const float* a_log() const { return (const float*)inp(16); }
    __device__ __forceinline__ const float* d_skip() const { return (const float*)inp(17); }
    __device__ __forceinline__ const float* g_ssd() const { return (const float*)inp(18); }
    __device__ __forceinline__ const float* g_q() const { return (const float*)inp(19); }
    __device__ __forceinline__ const float* g_kv() const { return (const float*)inp(20); }
    __device__ __forceinline__ const float* w_uq() const { return (const float*)inp(21); }
    __device__ __forceinline__ const float* w_uk() const { return (const float*)inp(22); }
    __device__ __forceinline__ const float* w_uv() const { return (const float*)inp(23); }
    __device__ __forceinline__ const float* g_attn() const { return (const float*)inp(24); }
    __device__ __forceinline__ const float* w_out() const { return (const float*)inp(25); }
    __device__ __forceinline__ const float* g_mlp() const { return (const float*)inp(26); }
    __device__ __forceinline__ const float* w_up() const { return (const float*)inp(27); }
    __device__ __forceinline__ const float* w_down() const { return (const float*)inp(28); }
    __device__ __forceinline__ const float* w_adaf() const { return (const float*)inp(29); }
    __device__ __forceinline__ const float* b_adaf() const { return (const float*)inp(30); }
    __device__ __forceinline__ const float* g_fin() const { return (const float*)inp(31); }
};
#define WSP(T, off) ((T*)(F.ws + (off)))

__device__ __forceinline__ int tid_fresh() { int t = threadIdx.x; asm volatile("" : "+v"(t)); return t; }
__device__ __forceinline__ int crow(int r, int hi) { return (r & 3) + 8 * (r >> 2) + 4 * hi; }
template <int MODE> __device__ __forceinline__ int srccol(int n) {
    if (MODE == 1) { if (n < 1536) return n; if (n < 2208) return n + 8; if (n < 2216) return n - 2208 + 1536; return -1; }
    if (MODE == 2) { return n < 512 ? (n >> 6) * 96 + (n & 63) : ((n - 512) >> 5) * 96 + 64 + ((n - 512) & 31); }
    return n;
}
template <int MODE> __device__ __forceinline__ void transpose_item(const float* W, int K, int Nsrc, bf16* WT, int nblk, LAS float* scr, int item, int lane) {
    const int kb = item / nblk, nb = item % nblk, k0 = 64 * kb, n0 = 32 * nb;
    const int sc = srccol<MODE>(n0 + (lane & 31));
#pragma unroll 8
    for (int i = 0; i < 32; ++i) { const int kk = 2 * i + (lane >> 5); scr[kk * 33 + (lane & 31)] = sc >= 0 ? W[(size_t)(k0 + kk) * Nsrc + sc] : 0.f; }
    LDS_WAIT(); asm volatile("" ::: "memory");
    const int c = lane & 7;
#pragma unroll
    for (int j = 0; j < 4; ++j) { const int n = (lane >> 3) + 8 * j; const LAS float* s = scr + (8 * c) * 33 + n;
        v4u o; o.x = pk2(s[0 * 33], s[1 * 33]); o.y = pk2(s[2 * 33], s[3 * 33]); o.z = pk2(s[4 * 33], s[5 * 33]); o.w = pk2(s[6 * 33], s[7 * 33]);
        *(v4u*)(WT + (size_t)(n0 + n) * K + k0 + 8 * c) = o; }
    LDS_WAIT(); asm volatile("" ::: "memory");
}

__device__ __forceinline__ void p0_prologue(Frame& F) {
    const int tid = tid_fresh(), lane = tid & 63;
    const int gw = F.vcu * NWAVES + F.wave, NGW = F.G * NWAVES;
    {
        constexpr int KST = 2064;
        for (int slab = F.vcu; slab < 256; slab += F.G) {
            const int n0 = slab * 32; const bool fin = n0 >= 6144; const float* W = fin ? F.w_adaf() : F.w_ada(); const int Nw = fin ? 2048 : 6144; const int nb = fin ? n0 - 6144 : n0;
            __syncthreads();
            { const int c = tid & 31, kp = tid >> 5;
#pragma unroll 8
              for (int p = 0; p < 32; ++p) { const int k = 2 * (p * 16 + kp); const float w0 = W[(size_t)k * Nw + nb + c], w1 = W[(size_t)(k + 1) * Nw + nb + c]; *(LAS unsigned*)(F.lds + c * KST + k * 2) = pk2(w0, w1); } }
            __syncthreads();
            if (F.wave < 5) {
                const int r32 = lane & 31, hi = lane >> 5, m = 32 * F.wave + r32;
                const float* cp = m < 2 ? F.cprm() + m * 1024 : F.csmp() + (size_t)(m < 130 ? m - 2 : 0) * 1024; const bool valid = m < 130;
                f32x16 acc = {};
#pragma unroll 4
                for (int d0 = 0; d0 < 64; ++d0) {
                    const f32x4 a0 = *(const f32x4*)(cp + 16 * d0 + 8 * hi), a1 = *(const f32x4*)(cp + 16 * d0 + 8 * hi + 4);
                    v4u w; w.x = pk2(siluf(a0[0]), siluf(a0[1])); w.y = pk2(siluf(a0[2]), siluf(a0[3])); w.z = pk2(siluf(a1[0]), siluf(a1[1])); w.w = pk2(siluf(a1[2]), siluf(a1[3]));
                    if (!valid) w = (v4u){0u, 0u, 0u, 0u};
                    const bf16x8 bq = *(const LAS bf16x8*)(F.lds + r32 * KST + (16 * d0 + 8 * hi) * 2);
                    acc = __builtin_amdgcn_mfma_f32_32x32x16_bf16(__builtin_bit_cast(bf16x8, w), bq, acc, 0, 0, 0);
                }
                const float bias = fin ? F.b_adaf()[nb + r32] : F.b_ada()[nb + r32];
                float* O = fin ? WSP(float, WS_ADAF) : WSP(float, WS_ADA); const int No = fin ? 2048 : 6144;
#pragma unroll
                for (int r = 0; r < 16; ++r) { const int mm = 32 * F.wave + crow(r, hi); if (mm < 130) O[(size_t)mm * No + nb + r32] = acc[r] + bias; }
            }
        }
        __syncthreads();
    }
    {
        LAS float* scr = (LAS float*)(F.lds + F.wave * 16384);
        constexpr int I_IN = 16 * 72, I_UQ = 6 * 24, I_KV = 4 * 32, I_OUT = 16 * 32, I_UP = 16 * 128, I_DN = 64 * 32;
        constexpr int NITEMS = I_IN + I_UQ + I_KV + I_OUT + I_UP + I_DN;
        for (int it = gw; it < NITEMS; it += NGW) {
            int r = it;
            if (r < I_IN) { transpose_item<1>(F.w_in(), 1024, 2216, WSP(bf16, WS_WIN), 72, scr, r, lane); continue; } r -= I_IN;
            if (r < I_UQ) { transpose_item<2>(F.w_uq(), 384, 768, WSP(bf16, WS_WUQ), 24, scr, r, lane); continue; } r -= I_UQ;
            if (r < I_KV) { const int nb = r % 32, kb = r / 32;
                if (nb < 16) transpose_item<0>(F.w_uk(), 256, 512, WSP(bf16, WS_WKV), 16, scr, kb * 16 + nb, lane);
                else transpose_item<0>(F.w_uv(), 256, 512, WSP(bf16, WS_WKV) + 512 * 256, 16, scr, kb * 16 + (nb - 16), lane);
                continue; } r -= I_KV;
            if (r < I_OUT) { transpose_item<0>(F.w_out(), 1024, 1024, WSP(bf16, WS_WOUT), 32, scr, r, lane); continue; } r -= I_OUT;
            if (r < I_UP) { transpose_item<0>(F.w_up(), 1024, 4096, WSP(bf16, WS_WUP), 128, scr, r, lane); continue; } r -= I_UP;
            transpose_item<0>(F.w_down(), 4096, 1024, WSP(bf16, WS_WDOWN), 32, scr, r, lane);
        }
    }
    for (int idx = (F.vcu * 512 + tid); idx < 8196 * 16; idx += F.G * 512) {
        const int pos = idx >> 4, i = idx & 15; double rev = (double)pos * ROPE_REV[i]; rev -= __builtin_rint(rev); const float fr = (float)rev;
        WSP(float, WS_CS)[2 * idx] = __builtin_amdgcn_cosf(fr); WSP(float, WS_CS)[2 * idx + 1] = __builtin_amdgcn_sinf(fr);
    }
}

__device__ __forceinline__ const float* xrow_of(Frame& F, int m) { return m < MP ? F.xp() + (size_t)m * DM : F.xs() + (size_t)(m - MP) * DM; }
__device__ __forceinline__ int arow_of(int m) { return m < MP ? (m >> 13) : 2 + ((m - MP) >> 2); }

template <bool BF16OUT> __device__ __forceinline__ void norm_mod_row(const float* xr_, const float* g, const float* sc, const float* sh, void* orow, int lane) {
    const f32x4* xr = (const f32x4*)xr_ + lane;
    f32x4 v[4]; float s2 = 0.f;
#pragma unroll
    for (int j = 0; j < 4; ++j) { v[j] = xr[64 * j]; s2 += (v[j][0] * v[j][0] + v[j][1] * v[j][1]) + (v[j][2] * v[j][2] + v[j][3] * v[j][3]); }
    const float rstd = 1.f / sqrtf(wave_sum(s2) * (1.f / 1024.f) + EPS);
#pragma unroll
    for (int j = 0; j < 4; ++j) { const f32x4 gg = ((const f32x4*)g)[lane + 64 * j], cc = ((const f32x4*)sc)[lane + 64 * j], hh = ((const f32x4*)sh)[lane + 64 * j];
        f32x4 o;
#pragma unroll
        for (int e = 0; e < 4; ++e) o[e] = v[j][e] * rstd * gg[e] * (1.f + cc[e]) + hh[e];
        if (BF16OUT) { v2u w; w.x = pk2(o[0], o[1]); w.y = pk2(o[2], o[3]); ((v2u*)orow)[lane + 64 * j] = w; }
        else ((f32x4*)orow)[lane + 64 * j] = o; }
}

__device__ __forceinline__ void p3_row(Frame& F, int row, const int lane) {
    const bf16* PROJ = WSP(bf16, WS_PROJ); const bf16* P = PROJ + (size_t)row * NPROJ;
    const bool isp = row < MP; const int b = row >> 13, rs = row - MP, s = rs >> 2, l = rs & 3; const int t = isp ? (row & 8191) : l;
#pragma unroll
    for (int half = 0; half < 2; ++half) {
        const int c0 = half * 512 + 8 * lane;
        float acc[8], cur[8];
        { const f32x4 b0 = *(const f32x4*)(F.conv_b() + c0), b1 = *(const f32x4*)(F.conv_b() + c0 + 4);
#pragma unroll
          for (int e = 0; e < 4; ++e) { acc[e] = b0[e]; acc[4 + e] = b1[e]; } }
#pragma unroll
        for (int j = 0; j < 4; ++j) {
            const int tt = t - 3 + j; float xin[8];
            if (tt >= 0) { const v4u w = *(const v4u*)(PROJ + (size_t)(row - 3 + j) * NPROJ + 512 + c0);
                xin[0] = bflo(w.x); xin[1] = bfhi(w.x); xin[2] = bflo(w.y); xin[3] = bfhi(w.y); xin[4] = bflo(w.z); xin[5] = bfhi(w.z); xin[6] = bflo(w.w); xin[7] = bfhi(w.w); }
            else if (!isp) { const float* sp = F.sconv() + ((size_t)s * 3 + (3 + tt)) * 1024 + c0; const f32x4 a0 = *(const f32x4*)sp, a1 = *(const f32x4*)(sp + 4);
#pragma unroll
                for (int e = 0; e < 4; ++e) { xin[e] = a0[e]; xin[4 + e] = a1[e]; } }
            else {
#pragma unroll
                for (int e = 0; e < 8; ++e) xin[e] = 0.f; }
            const f32x4 w0 = *(const f32x4*)(F.conv_w() + j * 1024 + c0), w1 = *(const f32x4*)(F.conv_w() + j * 1024 + c0 + 4);
#pragma unroll
            for (int e = 0; e < 4; ++e) { acc[e] += w0[e] * xin[e]; acc[4 + e] += w1[e] * xin[4 + e]; }
            if (j == 3) {
#pragma unroll
                for (int e = 0; e < 8; ++e) cur[e] = xin[e]; }
        }
        v4u o; o.x = pk2(siluf(acc[0]), siluf(acc[1])); o.y = pk2(siluf(acc[2]), siluf(acc[3])); o.z = pk2(siluf(acc[4]), siluf(acc[5])); o.w = pk2(siluf(acc[6]), siluf(acc[7]));
        *(v4u*)(WSP(bf16, WS_XBC) + (size_t)row * 1024 + c0) = o;
        float* cdst = nullptr;
        if (isp) { if (t >= SEQ - 3) cdst = F.out + O_CVP + ((size_t)b * 3 + (t - (SEQ - 3))) * 1024 + c0; }
        else { if (l >= 1) cdst = F.out + O_CVS + ((size_t)s * 3 + (l - 1)) * 1024 + c0; }
        if (cdst) { *(f32x4*)cdst = (f32x4){cur[0], cur[1], cur[2], cur[3]}; *(f32x4*)(cdst + 4) = (f32x4){cur[4], cur[5], cur[6], cur[7]}; }
    }
    if (lane < 8) { const float x = WSP(float, WS_DTRAW)[(size_t)row * 8 + lane] + F.dt_bias()[lane]; WSP(float, WS_DT)[(size_t)row * 8 + lane] = x > 20.f ? x : log1pf(__expf(x)); }
    {
        float v[6]; float s2 = 0.f;
#pragma unroll
        for (int j = 0; j < 3; ++j) { const unsigned w = *(const unsigned*)(P + 1536 + 2 * lane + 128 * j); v[2 * j] = bflo(w); v[2 * j + 1] = bfhi(w); s2 += v[2 * j] * v[2 * j] + v[2 * j + 1] * v[2 * j + 1]; }
        const float rstd = 1.f / sqrtf(wave_sum(s2) * (1.f / 384.f) + EPS);
#pragma unroll
        for (int j = 0; j < 3; ++j) { const int c = 2 * lane + 128 * j; *(unsigned*)(WSP(bf16, WS_QN) + (size_t)row * 384 + c) = pk2(v[2 * j] * rstd * F.g_q()[c], v[2 * j + 1] * rstd * F.g_q()[c + 1]); }
    }
    {
        const v2u w = *(const v2u*)(P + 1920 + 4 * lane); float v[4] = {bflo(w.x), bfhi(w.x), bflo(w.y), bfhi(w.y)};
        const float s2 = (v[0] * v[0] + v[1] * v[1]) + (v[2] * v[2] + v[3] * v[3]);
        const float rstd = 1.f / sqrtf(wave_sum(s2) * (1.f / 256.f) + EPS);
        const f32x4 g = *(const f32x4*)(F.g_kv() + 4 * lane); f32x4 o;
#pragma unroll
        for (int e = 0; e < 4; ++e) o[e] = v[e] * rstd * g[e];
        float* od = isp ? F.out + O_KVP + (size_t)row * 256 + 4 * lane : F.out + O_KVS + (size_t)rs * 256 + 4 * lane;
        *(f32x4*)od = o;
        v2u q; q.x = pk2(o[0], o[1]); q.y = pk2(o[2], o[3]); *(v2u*)(WSP(bf16, WS_CKV) + (size_t)row * 256 + 4 * lane) = q;
    }
    if (lane < 32) {
        const int i = lane & 15; const float x1 = bf2f(P[2176 + i]), x2 = bf2f(P[2176 + 16 + i]);
        const int pos = isp ? t : SEQ + l; const float c = WSP(float, WS_CS)[((size_t)pos * 16 + i) * 2], sn = WSP(float, WS_CS)[((size_t)pos * 16 + i) * 2 + 1];
        const float val = lane < 16 ? x1 * c - x2 * sn : x1 * sn + x2 * c;
        if (isp) { F.out[O_KRP + (size_t)row * 32 + lane] = val; const bf16 vb = (bf16)f2bf(val);
#pragma unroll
            for (int h = 0; h < 8; ++h) WSP(bf16, WS_KP)[((((size_t)(b * 8 + h)) * 128 + (t >> 6)) * 12 + 8 + (lane >> 3)) * 512 + (t & 63) * 8 + (lane & 7)] = vb; }
        else { F.out[O_KRS + (size_t)rs * 32 + lane] = val; WSP(bf16, WS_KRS)[(size_t)rs * 32 + lane] = (bf16)f2bf(val); }
    }
}

__device__ __forceinline__ void ssd_sample_unit(Frame& F, int u) {
    const int tid = tid_fresh(); const int s = u >> 3, h = u & 7, g = h >> 2, p = tid >> 3, nq = tid & 7;
    const float a = -__expf(F.a_log()[h]);
    const bf16* XBC = WSP(bf16, WS_XBC); const float* DT = WSP(float, WS_DT); float* Y = WSP(float, WS_YSSD);
    const size_t so = ((size_t)(s * 8 + h) * 64 + p) * 128 + 16 * nq;
    float st[16];
#pragma unroll
    for (int j = 0; j < 4; ++j) { const f32x4 v = *(const f32x4*)(F.sssm() + so + 4 * j); st[4 * j] = v[0]; st[4 * j + 1] = v[1]; st[4 * j + 2] = v[2]; st[4 * j + 3] = v[3]; }
#pragma unroll
    for (int t = 0; t < 4; ++t) {
        const size_t row = (size_t)MP + s * 4 + t; const float dtv = DT[row * 8 + h], xv = bf2f(XBC[row * 1024 + h * 64 + p]);
        const v4u b0 = *(const v4u*)(XBC + row * 1024 + 512 + g * 128 + 16 * nq), b1 = *(const v4u*)(XBC + row * 1024 + 512 + g * 128 + 16 * nq + 8);
        const v4u c0 = *(const v4u*)(XBC + row * 1024 + 768 + g * 128 + 16 * nq), c1 = *(const v4u*)(XBC + row * 1024 + 768 + g * 128 + 16 * nq + 8);
        const unsigned bw[8] = {b0.x, b0.y, b0.z, b0.w, b1.x, b1.y, b1.z, b1.w}, cw[8] = {c0.x, c0.y, c0.z, c0.w, c1.x, c1.y, c1.z, c1.w};
        const float dA = __expf(dtv * a), dx = dtv * xv; float part = 0.f;
#pragma unroll
        for (int j = 0; j < 8; ++j) { st[2 * j] = st[2 * j] * dA + dx * bflo(bw[j]); st[2 * j + 1] = st[2 * j + 1] * dA + dx * bfhi(bw[j]); part += st[2 * j] * bflo(cw[j]) + st[2 * j + 1] * bfhi(cw[j]); }
        part += __shfl_xor(part, 1); part += __shfl_xor(part, 2); part += __shfl_xor(part, 4);
        if (nq == 0) Y[row * 512 + h * 64 + p] = part;
    }
#pragma unroll
    for (int j = 0; j < 4; ++j) *(f32x4*)(F.out + O_SSS + so + 4 * j) = (f32x4){st[4 * j], st[4 * j + 1], st[4 * j + 2], st[4 * j + 3]};
}

__device__ __forceinline__ unsigned cvtpk_s(float lo, float hi) { typedef float f2 __attribute__((ext_vector_type(2))); typedef __bf16 b2 __attribute__((ext_vector_type(2))); f2 v = {lo, hi}; b2 b = __builtin_convertvector(v, b2); return __builtin_bit_cast(unsigned, b); }
__device__ __forceinline__ float rowmax32(const f32x16& p0, const f32x16& p1) {
    float a = fmaxf(p0[0], p1[0]);
#pragma unroll
    for (int r = 1; r < 16; ++r) a = fmaxf(a, fmaxf(p0[r], p1[r]));
    return fmaxf(a, __shfl_xor(a, 32));
}
__device__ __forceinline__ void pv_block(f32x16& o, unsigned vb, bf16x8 pa0, bf16x8 pa1, bf16x8 pa2, bf16x8 pa3) {
    s16x4 lo[4], hi[4];
#pragma unroll
    for (int ks = 0; ks < 4; ++ks) {
        asm volatile("ds_read_b64_tr_b16 %0,%1 offset:%c2" : "=&v"(lo[ks]) : "v"(vb), "i"(ks * 1024) : "memory");
        asm volatile("ds_read_b64_tr_b16 %0,%1 offset:%c2" : "=&v"(hi[ks]) : "v"(vb), "i"(ks * 1024 + 512) : "memory"); }
    asm volatile("s_waitcnt lgkmcnt(0)" ::: "memory"); __builtin_amdgcn_sched_barrier(0);
#define PKV(k) (bf16x8){lo[k][0], lo[k][1], lo[k][2], lo[k][3], hi[k][0], hi[k][1], hi[k][2], hi[k][3]}
    o = __builtin_amdgcn_mfma_f32_32x32x16_bf16(pa0, PKV(0), o, 0, 0, 0);
    o = __builtin_amdgcn_mfma_f32_32x32x16_bf16(pa1, PKV(1), o, 0, 0, 0);
    o = __builtin_amdgcn_mfma_f32_32x32x16_bf16(pa2, PKV(2), o, 0, 0, 0);
    o = __builtin_amdgcn_mfma_f32_32x32x16_bf16(pa3, PKV(3), o, 0, 0, 0);
#undef PKV
}
__device__ __forceinline__ void softmax_step(f32x16& p0, f32x16& p1, float& m, float& l, float& alpha, bf16x8& pa0, bf16x8& pa1, bf16x8& pa2, bf16x8& pa3) {
    const float rm = rowmax32(p0, p1); const float mn = fmaxf(m, rm);
    alpha = __builtin_amdgcn_exp2f(m - mn); m = mn; float sum = 0.f;
#pragma unroll
    for (int r = 0; r < 16; ++r) { p0[r] = __builtin_amdgcn_exp2f(p0[r] - mn); p1[r] = __builtin_amdgcn_exp2f(p1[r] - mn); sum += p0[r] + p1[r]; }
    l = l * alpha + sum;
    v4u w0, w1, w2, w3;
    w0.x = cvtpk_s(p0[0], p0[1]); w0.y = cvtpk_s(p0[2], p0[3]); w0.z = cvtpk_s(p0[4], p0[5]); w0.w = cvtpk_s(p0[6], p0[7]);
    w1.x = cvtpk_s(p0[8], p0[9]); w1.y = cvtpk_s(p0[10], p0[11]); w1.z = cvtpk_s(p0[12], p0[13]); w1.w = cvtpk_s(p0[14], p0[15]);
    w2.x = cvtpk_s(p1[0], p1[1]); w2.y = cvtpk_s(p1[2], p1[3]); w2.z = cvtpk_s(p1[4], p1[5]); w2.w = cvtpk_s(p1[6], p1[7]);
    w3.x = cvtpk_s(p1[8], p1[9]); w3.y = cvtpk_s(p1[10], p1[11]); w3.z = cvtpk_s(p1[12], p1[13]); w3.w = cvtpk_s(p1[14], p1[15]);
    pa0 = __builtin_bit_cast(bf16x8, w0); pa1 = __builtin_bit_cast(bf16x8, w1); pa2 = __builtin_bit_cast(bf16x8, w2); pa3 = __builtin_bit_cast(bf16x8, w3);
}

constexpr int AP_K = 0, AP_V = 24576, AP_WS = 40960;
__device__ __forceinline__ void attn_prompt_unit(Frame& F, int bh, int qb) {
    const int tid = tid_fresh(), lane = tid & 63, wid = F.wave, r32 = lane & 31, hi = lane >> 5;
    const int b = bh >> 3, h = bh & 7, q0 = qb * 256, NT = 4 * (qb + 1), qrel = wid * 32 + r32;
    const bf16* Qw = WSP(bf16, WS_QP) + ((size_t)bh * SEQ + q0 + wid * 32 + r32) * 96 + hi * 8;
    bf16x8 qr[6];
#pragma unroll
    for (int d0 = 0; d0 < 6; ++d0) qr[d0] = *(const bf16x8*)(Qw + d0 * 16);
    const v4u* Kg = (const v4u*)(WSP(bf16, WS_KP) + (size_t)bh * 128 * 6144);
    const v4u* Vg = (const v4u*)(WSP(bf16, WS_VP) + (size_t)bh * 128 * 4096);
    LAS unsigned char* L = F.lds;
    LAS float* wsf = (LAS float*)(L + AP_WS) + wid * 64;
    const unsigned vb0 = (unsigned)(size_t)(L + AP_V) + ((lane >> 4) & 1) * 32 + (lane & 3) * 8 + (4 * hi + ((lane & 15) >> 2)) * 64;
    v4u k0r = Kg[tid], k1r = (tid < 256) ? Kg[512 + tid] : (v4u){0u, 0u, 0u, 0u}, v0r = Vg[tid];
    float m = -1e30f, l = 0.f; f32x16 o0 = {}, o1 = {};
    for (int t = 0; t < NT; ++t) {
        const int buf = t & 1;
        LAS v4u* Kb = (LAS v4u*)(L + AP_K + buf * 12288); LAS v4u* Vb = (LAS v4u*)(L + AP_V + buf * 8192);
        Kb[tid] = k0r; if (tid < 256) Kb[512 + tid] = k1r; Vb[tid] = v0r;
        __syncthreads();
        if (t + 1 < NT) { k0r = Kg[(size_t)(t + 1) * 768 + tid]; if (tid < 256) k1r = Kg[(size_t)(t + 1) * 768 + 512 + tid]; v0r = Vg[(size_t)(t + 1) * 512 + tid]; }
        const int jb = t - (NT - 4);
        if (jb >= 0 && wid * 32 + 31 < 64 * jb) continue;
        const LAS unsigned char* kp = L + AP_K + buf * 12288 + hi * 1024 + r32 * 16;
        f32x16 p0 = {}, p1 = {};
#pragma unroll
        for (int d0 = 0; d0 < 6; ++d0) { const bf16x8 a0 = *(const LAS bf16x8*)(kp + d0 * 2048), a1 = *(const LAS bf16x8*)(kp + d0 * 2048 + 512);
            p0 = __builtin_amdgcn_mfma_f32_32x32x16_bf16(a0, qr[d0], p0, 0, 0, 0); p1 = __builtin_amdgcn_mfma_f32_32x32x16_bf16(a1, qr[d0], p1, 0, 0, 0); }
        if (jb >= 0) {
#pragma unroll
            for (int r = 0; r < 16; ++r) { const int kv = 64 * jb + crow(r, hi); if (kv > qrel) p0[r] = -INFINITY; if (kv + 32 > qrel) p1[r] = -INFINITY; } }
        float alpha; bf16x8 pa0, pa1, pa2, pa3;
        softmax_step(p0, p1, m, l, alpha, pa0, pa1, pa2, pa3);
        if (hi == 0) wsf[r32] = alpha;
        LDS_WAIT();
#pragma unroll
        for (int r = 0; r < 16; ++r) { const float f = wsf[crow(r, hi)]; o0[r] *= f; o1[r] *= f; }
        LDS_WAIT();
        const unsigned vb = vb0 + buf * 8192;
        pv_block(o0, vb, pa0, pa1, pa2, pa3);
        pv_block(o1, vb + 4096, pa0, pa1, pa2, pa3);
    }
    l += __shfl_xor(l, 32);
    if (hi == 0) wsf[32 + r32] = 1.f / l;
    LDS_WAIT();
    bf16* Ow = WSP(bf16, WS_OATT) + ((size_t)b * SEQ + q0 + wid * 32) * 512 + h * 64 + r32;
#pragma unroll
    for (int r = 0; r < 16; ++r) { const int qrow = crow(r, hi); const float f = wsf[32 + qrow]; Ow[(size_t)qrow * 512] = (bf16)f2bf(o0[r] * f); Ow[(size_t)qrow * 512 + 32] = (bf16)f2bf(o1[r] * f); }
    LDS_WAIT();
    __syncthreads();
}

constexpr int AD_KCS = 1040, AD_VDS = 4160, AD_QRS = 592;
constexpr int AD_K = 0, AD_V = 36 * AD_KCS  , AD_Q = AD_V + 8 * AD_VDS  , AD_WS = AD_Q + 32 * AD_QRS  , AD_QN = AD_WS + 8 * 256  ;
__device__ __forceinline__ void attn_decode_unit(Frame& F, int s, int split) {
    const int tid = tid_fresh(), lane = tid & 63, wid = F.wave, r32 = lane & 31, hi = lane >> 5;
    LAS unsigned char* L = F.lds;
    LAS float* wsf = (LAS float*)(L + AD_WS) + wid * 64;
    {
        LAS float* qn = (LAS float*)(L + AD_QN);
        for (int i = tid; i < 2048; i += 512) qn[i] = bf2f(WSP(bf16, WS_QSN)[(size_t)s * 2048 + i]);
        __syncthreads();
        const int r = tid & 255, lh = tid >> 8; const bf16* WK = WSP(bf16, WS_WKV);
        for (int h = 0; h < 8; ++h) { float a0 = 0.f, a1 = 0.f;
#pragma unroll 8
            for (int d = 0; d < 64; ++d) { const float w = bf2f(WK[(size_t)(h * 64 + d) * 256 + r]); a0 += w * qn[(2 * lh) * 512 + h * 64 + d]; a1 += w * qn[(2 * lh + 1) * 512 + h * 64 + d]; }
            *(LAS bf16*)(L + AD_Q + ((2 * lh) * 8 + h) * AD_QRS + r * 2) = (bf16)f2bf(a0 * SCL2); *(LAS bf16*)(L + AD_Q + ((2 * lh + 1) * 8 + h) * AD_QRS + r * 2) = (bf16)f2bf(a1 * SCL2); }
        for (int i = tid; i < 1024; i += 512) { const int row = i >> 5, j = i & 31; *(LAS bf16*)(L + AD_Q + row * AD_QRS + (256 + j) * 2) = WSP(bf16, WS_QSR)[((size_t)s * 32 + row) * 32 + j]; }
        __syncthreads();
    }
    const unsigned vb0 = (unsigned)(size_t)(L + AD_V) + wid * AD_VDS + ((lane >> 4) & 1) * 32 + (lane & 3) * 8 + (4 * hi + ((lane & 15) >> 2)) * 64;
    const LAS unsigned char* kp = L + AD_K + hi * AD_KCS + r32 * 16;
    const LAS unsigned char* qp = L + AD_Q + r32 * AD_QRS + hi * 16;
    float m = -1e30f, l = 0.f; f32x16 o = {};
    const int NTL = 64 + (split == 1 ? 1 : 0);
    f32x4 kreg[8], rreg;
#define AD_LOAD(tile) do { const int pg_ = F.ptab()[s * 64 + split * 32 + ((tile) >> 1)]; const size_t rb_ = (size_t)pg_ * 128 + ((tile) & 1) * 64; \
        _Pragma("unroll") for (int j = 0; j < 8; ++j) { const int g_ = j * 512 + tid; kreg[j] = *(const f32x4*)(F.cache_kv() + (rb_ + (g_ >> 6)) * 256 + (g_ & 63) * 4); } \
        rreg = *(const f32x4*)(F.cache_kr() + (rb_ + (tid >> 3)) * 32 + (tid & 7) * 4); } while (0)
    AD_LOAD(0);
    for (int t = 0; t < NTL; ++t) {
        __syncthreads();
        if (t < 64) {
#pragma unroll
            for (int j = 0; j < 8; ++j) { const int g = j * 512 + tid, key = g >> 6, i = g & 63; v2u w; w.x = pk2(kreg[j][0], kreg[j][1]); w.y = pk2(kreg[j][2], kreg[j][3]);
                *(LAS v2u*)(L + AD_K + (i >> 1) * AD_KCS + key * 16 + (i & 1) * 8) = w;
                *(LAS v2u*)(L + AD_V + (i >> 3) * AD_VDS + (key >> 4) * 1024 + (key & 15) * 64 + (i & 7) * 8) = w; }
            { const int key = tid >> 3, i = tid & 7; v2u w; w.x = pk2(rreg[0], rreg[1]); w.y = pk2(rreg[2], rreg[3]); *(LAS v2u*)(L + AD_K + (32 + (i >> 1)) * AD_KCS + key * 16 + (i & 1) * 8) = w; }
        } else {
#pragma unroll
            for (int j = 0; j < 8; ++j) { const int g = j * 512 + tid, key = g >> 6, i = g & 63; v2u w = {0u, 0u}; if (key < 4) w = *(const v2u*)(WSP(bf16, WS_CKV) + ((size_t)MP + s * 4 + key) * 256 + 4 * i);
                *(LAS v2u*)(L + AD_K + (i >> 1) * AD_KCS + key * 16 + (i & 1) * 8) = w;
                *(LAS v2u*)(L + AD_V + (i >> 3) * AD_VDS + (key >> 4) * 1024 + (key & 15) * 64 + (i & 7) * 8) = w; }
            { const int key = tid >> 3, i = tid & 7; v2u w = {0u, 0u}; if (key < 4) w = *(const v2u*)(WSP(bf16, WS_KRS) + ((size_t)s * 4 + key) * 32 + 4 * i); *(LAS v2u*)(L + AD_K + (32 + (i >> 1)) * AD_KCS + key * 16 + (i & 1) * 8) = w; }
        }
        __syncthreads();
        if (t + 1 < 64) AD_LOAD(t + 1);
        f32x16 p0 = {}, p1 = {};
#pragma unroll 6
        for (int d0 = 0; d0 < 18; ++d0) { const bf16x8 a0 = *(const LAS bf16x8*)(kp + d0 * 2 * AD_KCS), a1 = *(const LAS bf16x8*)(kp + d0 * 2 * AD_KCS + 512), bq = *(const LAS bf16x8*)(qp + d0 * 32);
            p0 = __builtin_amdgcn_mfma_f32_32x32x16_bf16(a0, bq, p0, 0, 0, 0); p1 = __builtin_amdgcn_mfma_f32_32x32x16_bf16(a1, bq, p1, 0, 0, 0); }
        if (t == 64) {
#pragma unroll
            for (int r = 0; r < 16; ++r) { if (crow(r, hi) > (r32 >> 3)) p0[r] = -INFINITY; p1[r] = -INFINITY; } }
        float alpha; bf16x8 pa0, pa1, pa2, pa3;
        softmax_step(p0, p1, m, l, alpha, pa0, pa1, pa2, pa3);
        if (hi == 0) wsf[r32] = alpha;
        LDS_WAIT();
#pragma unroll
        for (int r = 0; r < 16; ++r) o[r] *= wsf[crow(r, hi)];
        LDS_WAIT();
        pv_block(o, vb0, pa0, pa1, pa2, pa3);
    }
#undef AD_LOAD
    l += __shfl_xor(l, 32);
    float* OP = WSP(float, WS_OPART) + ((size_t)(s * 2 + split) * 32) * 256 + wid * 32 + r32;
#pragma unroll
    for (int r = 0; r < 16; ++r) OP[(size_t)crow(r, hi) * 256] = o[r];
    if (wid == 0 && hi == 0) { float* ML = WSP(float, WS_ML) + ((size_t)(s * 2 + split) * 32 + r32) * 2; ML[0] = m; ML[1] = l; }
    __syncthreads();
}

__device__ __forceinline__ void p6_row(Frame& F, int row, const int lane) {
    bf16* A = WSP(bf16, WS_AMIX) + (size_t)row * 1024;
    {
        const float* y = WSP(float, WS_YSSD) + (size_t)row * 512; const bf16* z = WSP(bf16, WS_PROJ) + (size_t)row * NPROJ;
        float v[8]; float s2 = 0.f;
#pragma unroll
        for (int j = 0; j < 2; ++j) { f32x4 yy = *(const f32x4*)(y + 4 * lane + 256 * j); const v2u zz = *(const v2u*)(z + 4 * lane + 256 * j);
            const v2u xx = *(const v2u*)(WSP(bf16, WS_XBC) + (size_t)row * 1024 + 4 * lane + 256 * j); const float Dh = F.d_skip()[(4 * lane + 256 * j) >> 6];
            yy[0] += Dh * bflo(xx.x); yy[1] += Dh * bfhi(xx.x); yy[2] += Dh * bflo(xx.y); yy[3] += Dh * bfhi(xx.y);
            v[4 * j] = yy[0] * siluf(bflo(zz.x)); v[4 * j + 1] = yy[1] * siluf(bfhi(zz.x)); v[4 * j + 2] = yy[2] * siluf(bflo(zz.y)); v[4 * j + 3] = yy[3] * siluf(bfhi(zz.y)); }
#pragma unroll
        for (int e = 0; e < 8; ++e) s2 += v[e] * v[e];
        const float rstd = 1.f / sqrtf(wave_sum(s2) * (1.f / 512.f) + EPS);
#pragma unroll
        for (int j = 0; j < 2; ++j) { const f32x4 g = *(const f32x4*)(F.g_ssd() + 4 * lane + 256 * j); v2u w; w.x = pk2(v[4 * j] * rstd * g[0], v[4 * j + 1] * rstd * g[1]); w.y = pk2(v[4 * j + 2] * rstd * g[2], v[4 * j + 3] * rstd * g[3]);
            *(v2u*)(A + 4 * lane + 256 * j) = w; }
    }
    float v[8];
    { const bf16* o = WSP(bf16, WS_OATT) + (size_t)row * 512;
#pragma unroll
      for (int j = 0; j < 2; ++j) { const v2u w = *(const v2u*)(o + 4 * lane + 256 * j); v[4 * j] = bflo(w.x); v[4 * j + 1] = bfhi(w.x); v[4 * j + 2] = bflo(w.y); v[4 * j + 3] = bfhi(w.y); } }
    float s2 = 0.f;
#pragma unroll
    for (int e = 0; e < 8; ++e) s2 += v[e] * v[e];
    const float rstd = 1.f / sqrtf(wave_sum(s2) * (1.f / 512.f) + EPS);
#pragma unroll
    for (int j = 0; j < 2; ++j) { const f32x4 g = *(const f32x4*)(F.g_attn() + 4 * lane + 256 * j); v2u w; w.x = pk2(v[4 * j] * rstd * g[0], v[4 * j + 1] * rstd * g[1]); w.y = pk2(v[4 * j + 2] * rstd * g[2], v[4 * j + 3] * rstd * g[3]);
        *(v2u*)(A + 512 + 4 * lane + 256 * j) = w; }
}

__device__ __forceinline__ void sample_ov_tile(Frame& F, int tile, const int lane) {
    const int r32 = lane & 31, hi = lane >> 5, rb = tile >> 4, h = (tile >> 1) & 7, cb = tile & 1;
    const int rs = 32 * rb + r32, s = rs >> 2, q = (rs & 3) * 8 + h;
    const float* ml0 = WSP(float, WS_ML) + ((size_t)(s * 2 + 0) * 32 + q) * 2; const float* ml1 = WSP(float, WS_ML) + ((size_t)(s * 2 + 1) * 32 + q) * 2;
    const float m0 = ml0[0], l0 = ml0[1], m1 = ml1[0], l1 = ml1[1], M = fmaxf(m0, m1), e0 = __builtin_amdgcn_exp2f(m0 - M), e1 = __builtin_amdgcn_exp2f(m1 - M), inv = 1.f / (e0 * l0 + e1 * l1), w0 = e0 * inv, w1 = e1 * inv;
    const float* P0 = WSP(float, WS_OPART) + ((size_t)(s * 2 + 0) * 32 + q) * 256 + 8 * hi; const float* P1 = WSP(float, WS_OPART) + ((size_t)(s * 2 + 1) * 32 + q) * 256 + 8 * hi;
    const bf16* Bw = WSP(bf16, WS_WKV) + (size_t)(512 + h * 64 + 32 * cb + r32) * 256 + 8 * hi;
    f32x16 acc = {};
#pragma unroll 4
    for (int d0 = 0; d0 < 16; ++d0) {
        const f32x4 a0 = *(const f32x4*)(P0 + 16 * d0), a1 = *(const f32x4*)(P0 + 16 * d0 + 4), b0 = *(const f32x4*)(P1 + 16 * d0), b1 = *(const f32x4*)(P1 + 16 * d0 + 4);
        v4u w; w.x = pk2(a0[0] * w0 + b0[0] * w1, a0[1] * w0 + b0[1] * w1); w.y = pk2(a0[2] * w0 + b0[2] * w1, a0[3] * w0 + b0[3] * w1);
        w.z = pk2(a1[0] * w0 + b1[0] * w1, a1[1] * w0 + b1[1] * w1); w.w = pk2(a1[2] * w0 + b1[2] * w1, a1[3] * w0 + b1[3] * w1);
        const bf16x8 bq = *(const bf16x8*)(Bw + 16 * d0);
        acc = __builtin_amdgcn_mfma_f32_32x32x16_bf16(__builtin_bit_cast(bf16x8, w), bq, acc, 0, 0, 0);
    }
    bf16* O = WSP(bf16, WS_OATT) + ((size_t)MP + 32 * rb) * 512 + h * 64 + 32 * cb + r32;
#pragma unroll
    for (int r = 0; r < 16; ++r) O[(size_t)crow(r, hi) * 512] = (bf16)f2bf(acc[r]);
}

constexpr int SA_BKS = 2064, SA_BVS = 4112, SA_XVS = 4112;
constexpr int SA_BK = 0, SA_BV = 16 * SA_BKS  , SA_XV = SA_BV + 8 * SA_BVS  , SA_TAB = SA_XV + 16 * SA_XVS  ;
static_assert(SA_TAB + 6144 <= PHASE_LDS, "SSD chunk LDS map");
__device__ __forceinline__ bf16x8 tr_frag(unsigned addr) {
    s16x4 lo, hi;
    asm volatile("ds_read_b64_tr_b16 %0,%1" : "=&v"(lo) : "v"(addr) : "memory");
    asm volatile("ds_read_b64_tr_b16 %0,%1 offset:512" : "=&v"(hi) : "v"(addr) : "memory");
    asm volatile("s_waitcnt lgkmcnt(0)" ::: "memory");
    return (bf16x8){lo[0], lo[1], lo[2], lo[3], hi[0], hi[1], hi[2], hi[3]};
}
__device__ __forceinline__ void ssd_chunk_unit(Frame& F, int u) {
    const int tid = tid_fresh(), lane = tid & 63, wid = F.wave, r32 = lane & 31, hi = lane >> 5;
    const int b = u >> 7, c = (u >> 1) & 63, g = u & 1; const size_t row0 = (size_t)b * SEQ + c * 128;
    LAS unsigned char* L = F.lds; const bf16* XBC = WSP(bf16, WS_XBC);
    LAS float* T_acs = (LAS float*)(L + SA_TAB); LAS float* T_dt = T_acs + 512; LAS float* T_te = T_acs + 1024;
    __syncthreads();
#pragma unroll
    for (int k = 0; k < 4; ++k) { const int q = k * 512 + tid, j = q >> 4, c16 = q & 15; const v4u w = *(const v4u*)(XBC + (row0 + j) * 1024 + 512 + g * 128 + 8 * c16);
        *(LAS v4u*)(L + SA_BK + c16 * SA_BKS + j * 16) = w;
        *(LAS v4u*)(L + SA_BV + ((c16 >> 2) * 2 + (j >> 6)) * SA_BVS + ((j & 63) >> 4) * 1024 + (j & 15) * 64 + (c16 & 3) * 16) = w; }
#pragma unroll
    for (int k = 0; k < 8; ++k) { const int q = k * 512 + tid, j = q >> 5, c32 = q & 31; const v4u w = *(const v4u*)(XBC + (row0 + j) * 1024 + g * 256 + 8 * c32);
        *(LAS v4u*)(L + SA_XV + (((c32 >> 3) * 2 + ((c32 >> 2) & 1)) * 2 + (j >> 6)) * SA_XVS + ((j & 63) >> 4) * 1024 + (j & 15) * 64 + (c32 & 3) * 16) = w; }
    if (wid < 4) {
        const int hh = wid, h = g * 4 + hh; const float a = -__expf(F.a_log()[h]); const float* DT = WSP(float, WS_DT);
        const float d0 = DT[(row0 + 2 * lane) * 8 + h], d1 = DT[(row0 + 2 * lane + 1) * 8 + h];
        const float v0 = d0 * a, v1 = d1 * a, s = v0 + v1; float incl = s;
#pragma unroll
        for (int o = 1; o < 64; o <<= 1) { const float t = __shfl_up(incl, o); if (lane >= o) incl += t; }
        const float a0 = incl - s + v0, a1 = incl, tot = __shfl(incl, 63);
        T_acs[hh * 128 + 2 * lane] = a0; T_acs[hh * 128 + 2 * lane + 1] = a1; T_dt[hh * 128 + 2 * lane] = d0; T_dt[hh * 128 + 2 * lane + 1] = d1;
        T_te[hh * 128 + 2 * lane] = __expf(tot - a0) * d0; T_te[hh * 128 + 2 * lane + 1] = __expf(tot - a1) * d1;
        WSP(float, WS_EACS)[(row0 + 2 * lane) * 8 + h] = __expf(a0); WSP(float, WS_EACS)[(row0 + 2 * lane + 1) * 8 + h] = __expf(a1);
        if (lane == 63) WSP(float, WS_CD)[((size_t)b * 64 + c) * 8 + h] = __expf(incl);
    }
    __syncthreads();
    const int hh = wid >> 1, h = g * 4 + hh;
    const unsigned lanepart = ((lane >> 4) & 1) * 32 + (lane & 3) * 8 + (4 * hi + ((lane & 15) >> 2)) * 64;
    const unsigned lbase = (unsigned)(size_t)L;
#pragma unroll 1
    for (int ibi = 0; ibi < 2; ++ibi) {
        const int ib = (wid & 1) ? (ibi == 0 ? 1 : 2) : (ibi == 0 ? 0 : 3);
        const int i = 32 * ib + r32;
        bf16x8 cq[8];
#pragma unroll
        for (int d0 = 0; d0 < 8; ++d0) cq[d0] = *(const bf16x8*)(XBC + (row0 + i) * 1024 + 768 + g * 128 + 16 * d0 + 8 * hi);
        const float ai = T_acs[hh * 128 + i];
        f32x16 o0 = {}, o1 = {};
        for (int jt = 0; jt <= (ib >> 1); ++jt) {
            const LAS unsigned char* kp = L + SA_BK + hi * SA_BKS + (64 * jt + r32) * 16;
            f32x16 p0 = {}, p1 = {};
#pragma unroll
            for (int d0 = 0; d0 < 8; ++d0) { const bf16x8 a0 = *(const LAS bf16x8*)(kp + d0 * 2 * SA_BKS), a1 = *(const LAS bf16x8*)(kp + d0 * 2 * SA_BKS + 512);
                p0 = __builtin_amdgcn_mfma_f32_32x32x16_bf16(a0, cq[d0], p0, 0, 0, 0); p1 = __builtin_amdgcn_mfma_f32_32x32x16_bf16(a1, cq[d0], p1, 0, 0, 0); }
#pragma unroll
            for (int r = 0; r < 16; ++r) { const int j = 64 * jt + crow(r, hi), j2 = j + 32;
                p0[r] *= (j <= i) ? __expf(ai - T_acs[hh * 128 + j]) * T_dt[hh * 128 + j] : 0.f;
                p1[r] *= (j2 <= i) ? __expf(ai - T_acs[hh * 128 + j2]) * T_dt[hh * 128 + j2] : 0.f; }
            v4u w0, w1, w2, w3;
            w0.x = cvtpk_s(p0[0], p0[1]); w0.y = cvtpk_s(p0[2], p0[3]); w0.z = cvtpk_s(p0[4], p0[5]); w0.w = cvtpk_s(p0[6], p0[7]);
            w1.x = cvtpk_s(p0[8], p0[9]); w1.y = cvtpk_s(p0[10], p0[11]); w1.z = cvtpk_s(p0[12], p0[13]); w1.w = cvtpk_s(p0[14], p0[15]);
            w2.x = cvtpk_s(p1[0], p1[1]); w2.y = cvtpk_s(p1[2], p1[3]); w2.z = cvtpk_s(p1[4], p1[5]); w2.w = cvtpk_s(p1[6], p1[7]);
            w3.x = cvtpk_s(p1[8], p1[9]); w3.y = cvtpk_s(p1[10], p1[11]); w3.z = cvtpk_s(p1[12], p1[13]); w3.w = cvtpk_s(p1[14], p1[15]);
            const bf16x8 pa0 = __builtin_bit_cast(bf16x8, w0), pa1 = __builtin_bit_cast(bf16x8, w1), pa2 = __builtin_bit_cast(bf16x8, w2), pa3 = __builtin_bit_cast(bf16x8, w3);
            const unsigned vb = lbase + SA_XV + ((hh * 2 + 0) * 2 + jt) * SA_XVS + lanepart;
            pv_block(o0, vb, pa0, pa1, pa2, pa3);
            pv_block(o1, vb + 2 * SA_XVS, pa0, pa1, pa2, pa3);
        }
        float* Y = WSP(float, WS_YSSD) + (row0 + 32 * ib) * 512 + h * 64 + r32;
#pragma unroll
        for (int r = 0; r < 16; ++r) { Y[(size_t)crow(r, hi) * 512] = o0[r]; Y[(size_t)crow(r, hi) * 512 + 32] = o1[r]; }
    }
    {
        const int pb = wid & 1;
        f32x16 acc[4] = {};
#pragma unroll 2
        for (int ks = 0; ks < 8; ++ks) { const int jt = ks >> 2, rg = ks & 3, jb = 64 * jt + 16 * rg;
            const bf16x8 xa = tr_frag(lbase + SA_XV + ((hh * 2 + pb) * 2 + jt) * SA_XVS + rg * 1024 + lanepart);
            v4u w; const v4u xw = __builtin_bit_cast(v4u, xa);
            { const f32x4 t0 = *(const LAS f32x4*)(T_te + hh * 128 + jb + 4 * hi), t1 = *(const LAS f32x4*)(T_te + hh * 128 + jb + 8 + 4 * hi);
              w.x = cvtpk_s(bflo(xw.x) * t0[0], bfhi(xw.x) * t0[1]); w.y = cvtpk_s(bflo(xw.y) * t0[2], bfhi(xw.y) * t0[3]);
              w.z = cvtpk_s(bflo(xw.z) * t1[0], bfhi(xw.z) * t1[1]); w.w = cvtpk_s(bflo(xw.w) * t1[2], bfhi(xw.w) * t1[3]); }
            const bf16x8 af = __builtin_bit_cast(bf16x8, w);
#pragma unroll
            for (int nb = 0; nb < 4; ++nb) { const bf16x8 bfr = tr_frag(lbase + SA_BV + (nb * 2 + jt) * SA_BVS + rg * 1024 + lanepart);
                acc[nb] = __builtin_amdgcn_mfma_f32_32x32x16_bf16(af, bfr, acc[nb], 0, 0, 0); }
        }
        float* S = WSP(float, WS_SCH) + ((((size_t)b * 64 + c) * 8 + h) * 64 + 32 * pb) * 128 + r32;
#pragma unroll
        for (int nb = 0; nb < 4; ++nb)
#pragma unroll
            for (int r = 0; r < 16; ++r) S[(size_t)crow(r, hi) * 128 + 32 * nb] = acc[nb][r];
    }
}
__device__ __forceinline__ void ssd_scan(Frame& F) {
    const int tid = tid_fresh();
    const float* SCH = WSP(float, WS_SCH); const float* CD = WSP(float, WS_CD); bf16* HP = WSP(bf16, WS_HP);
    for (int e = F.vcu * 512 + tid; e < 131072; e += F.G * 512) {
        const int b = e >> 16, h = (e >> 13) & 7, pn = e & 8191;
        float H = 0.f;
        for (int c0 = 0; c0 < 64; c0 += 8) {
            float sv[8], dv[8];
#pragma unroll
            for (int k = 0; k < 8; ++k) { const size_t ci = ((size_t)b * 64 + c0 + k) * 8 + h; sv[k] = SCH[ci * 8192 + pn]; dv[k] = CD[ci]; }
#pragma unroll
            for (int k = 0; k < 8; ++k) { const size_t ci = ((size_t)b * 64 + c0 + k) * 8 + h; HP[ci * 8192 + pn] = (bf16)f2bf(H); H = dv[k] * H + sv[k]; }
        }
        F.out[O_SSP + ((size_t)(b * 8 + h)) * 8192 + pn] = H;
    }
}
__device__ __forceinline__ void ssd_off_unit(Frame& F, int u) {
    const int lane = tid_fresh() & 63, wid = F.wave, r32 = lane & 31, hi = lane >> 5;
    const int b = u >> 7, c = (u >> 1) & 63, g = u & 1; const size_t row0 = (size_t)b * SEQ + c * 128;
    if (c == 0) return;
    const bf16* XBC = WSP(bf16, WS_XBC); const int hh = wid >> 1, h = g * 4 + hh;
    const bf16* HPh = WSP(bf16, WS_HP) + (((size_t)b * 64 + c) * 8 + h) * 8192;
    const float* EA = WSP(float, WS_EACS);
#pragma unroll 1
    for (int ibi = 0; ibi < 2; ++ibi) {
        const int ib = (wid & 1) * 2 + ibi, i = 32 * ib + r32;
        bf16x8 ca[8];
#pragma unroll
        for (int d0 = 0; d0 < 8; ++d0) ca[d0] = *(const bf16x8*)(XBC + (row0 + i) * 1024 + 768 + g * 128 + 16 * d0 + 8 * hi);
        float ea[16];
#pragma unroll
        for (int r = 0; r < 16; ++r) ea[r] = EA[(row0 + 32 * ib + crow(r, hi)) * 8 + h];
#pragma unroll
        for (int pb = 0; pb < 2; ++pb) {
            f32x16 acc = {};
#pragma unroll
            for (int d0 = 0; d0 < 8; ++d0) { const bf16x8 bq = *(const bf16x8*)(HPh + (size_t)(32 * pb + r32) * 128 + 16 * d0 + 8 * hi); acc = __builtin_amdgcn_mfma_f32_32x32x16_bf16(ca[d0], bq, acc, 0, 0, 0); }
            float* Y = WSP(float, WS_YSSD) + (row0 + 32 * ib) * 512 + h * 64 + 32 * pb + r32;
#pragma unroll
            for (int r = 0; r < 16; ++r) Y[(size_t)crow(r, hi) * 512] += ea[r] * acc[r];
        }
    }
}


#ifndef PROBE
#define PROBE (-1)
#endif
#define GWDEF const int gw = F.vcu * NWAVES + F.wave, NGW = F.G * NWAVES
__device__ __forceinline__ void ph0(Frame& F) { p0_prologue(F); }
__device__ __forceinline__ void ph1(Frame& F) { GWDEF; const float* ADA = WSP(float, WS_ADA); const int lane = tid_fresh() & 63;
    for (int m = gw; m < MT; m += NGW) { const float* a = ADA + (size_t)arow_of(m) * 6144; norm_mod_row<true>(xrow_of(F, m), F.g_mix(), a + 1024, a, WSP(bf16, WS_H1) + (size_t)m * 1024, lane); } }
__device__ __forceinline__ void ph2(Frame& F) { pg8::Gemm g{WSP(bf16, WS_H1), WSP(bf16, WS_WIN), MT, NPROJ, 1024}; pg8::StaticOrder S; S.init(MT, NPROJ, F.G, (int)blockIdx.x);
    pg8::EpiProj E{WSP(bf16, WS_PROJ), WSP(float, WS_DTRAW)};
    pg8::gemm_phase<pg8::EpiProj, pg8::StaticOrder, true, true>(F.lds, g, S, E); }
__device__ __forceinline__ void ph3(Frame& F) { GWDEF; const int lane = tid_fresh() & 63; for (int m = gw; m < MT; m += NGW) p3_row(F, m, lane); }
__device__ __forceinline__ void ph4_gemms(Frame& F) {
    { int Kk = 256; asm volatile("" : "+s"(Kk)); pg8::Gemm g{WSP(bf16, WS_CKV), WSP(bf16, WS_WKV), MP, 1024, Kk}; pg8::StaticOrder S; S.init(MP, 1024, F.G, (int)blockIdx.x);
      pg8::EpiKV E{WSP(bf16, WS_KP), WSP(bf16, WS_VP)};
      pg8::gemm_phase<pg8::EpiKV, pg8::StaticOrder, true, true>(F.lds, g, S, E); }
    __syncthreads();
    { int Kq = 384; asm volatile("" : "+s"(Kq)); pg8::Gemm g{WSP(bf16, WS_QN), WSP(bf16, WS_WUQ), MT, 768, Kq}; pg8::StaticOrder S; S.init(MT, 768, F.G, (int)blockIdx.x);
      pg8::EpiQ E{WSP(bf16, WS_QP), WSP(bf16, WS_QSN), WSP(bf16, WS_QSR), WSP(float, WS_CS), SCL2};
      pg8::gemm_phase<pg8::EpiQ, pg8::StaticOrder, true, true>(F.lds, g, S, E); } }
__device__ __forceinline__ void ph4_ssd(Frame& F) { for (int u = F.vcu; u < 256; u += F.G) ssd_chunk_unit(F, u); }
__device__ __forceinline__ void ph4(Frame& F) { ph4_gemms(F); if (PROBE == 25) ph4_gemms(F); ph4_ssd(F); if (PROBE == 26) ph4_ssd(F); }
__device__ __forceinline__ void ph5_a(Frame& F) { ssd_scan(F); for (int u = F.vcu; u < 1024; u += F.G) ssd_sample_unit(F, u); __syncthreads(); }
__device__ __forceinline__ void ph5_dec(Frame& F) { for (int u = F.vcu; u < 256; u += F.G) attn_decode_unit(F, u >> 1, u & 1); }
__device__ __forceinline__ void ph5_att(Frame& F) { for (int v = F.vcu; v < 256; v += F.G) { attn_prompt_unit(F, v >> 4, v & 15); attn_prompt_unit(F, v >> 4, 31 - (v & 15)); } }
__device__ __forceinline__ void ph5(Frame& F) { ph5_a(F); if (PROBE == 20) ph5_a(F); ph5_dec(F); if (PROBE == 21) ph5_dec(F); ph5_att(F); if (PROBE == 22) ph5_att(F); }
__device__ __forceinline__ void ph6(Frame& F) { { GWDEF; const int lane = tid_fresh() & 63; for (int t = gw; t < 256; t += NGW) sample_ov_tile(F, t, lane); }
    for (int u = F.vcu; u < 256; u += F.G) ssd_off_unit(F, u); }
__device__ __forceinline__ void ph7(Frame& F) { GWDEF; const int lane = tid_fresh() & 63; for (int m = gw; m < MT; m += NGW) p6_row(F, m, lane); }
__device__ __forceinline__ void ph8(Frame& F) { pg8::Gemm g{WSP(bf16, WS_AMIX), WSP(bf16, WS_WOUT), MT, 1024, 1024}; pg8::StaticOrder S; S.init(MT, 1024, F.G, (int)blockIdx.x);
    pg8::EpiRes E{F.xp(), F.xs(), WSP(float, WS_X1), WSP(float, WS_ADA), 2048};
    pg8::gemm_phase<pg8::EpiRes, pg8::StaticOrder, true, true>(F.lds, g, S, E); }
__device__ __forceinline__ void ph9(Frame& F) { GWDEF; const float* ADA = WSP(float, WS_ADA); const int lane = tid_fresh() & 63;
    for (int m = gw; m < MT; m += NGW) { const float* a = ADA + (size_t)arow_of(m) * 6144; norm_mod_row<true>(WSP(float, WS_X1) + (size_t)m * 1024, F.g_mlp(), a + 4096, a + 3072, WSP(bf16, WS_H1) + (size_t)m * 1024, lane); } }
__device__ __forceinline__ void ph10(Frame& F) { pg8::Gemm g{WSP(bf16, WS_H1), WSP(bf16, WS_WUP), MT, DFF, 1024}; pg8::StaticOrder S; S.init(MT, DFF, F.G, (int)blockIdx.x);
    pg8::EpiUp E{WSP(bf16, WS_U)};
    pg8::gemm_phase<pg8::EpiUp, pg8::StaticOrder, true, true>(F.lds, g, S, E); }
__device__ __forceinline__ void ph11(Frame& F) { pg8::Gemm g{WSP(bf16, WS_U), WSP(bf16, WS_WDOWN), MT, 1024, DFF}; pg8::StaticOrder S; S.init(MT, 1024, F.G, (int)blockIdx.x);
    pg8::EpiRes E{WSP(float, WS_X1), WSP(float, WS_X1) + (size_t)MP * 1024, WSP(float, WS_X2), WSP(float, WS_ADA), 5120};
    pg8::gemm_phase<pg8::EpiRes, pg8::StaticOrder, true, true>(F.lds, g, S, E); }
__device__ __forceinline__ void ph12(Frame& F) { GWDEF; const int lane = tid_fresh() & 63; const float* AF = WSP(float, WS_ADAF);
    for (int m = gw; m < MT; m += NGW) { const float* a = AF + (size_t)arow_of(m) * 2048; float* o = m < MP ? F.out + O_YP + (size_t)m * 1024 : F.out + O_YS + (size_t)(m - MP) * 1024;
        norm_mod_row<false>(WSP(float, WS_X2) + (size_t)m * 1024, F.g_fin(), a + 1024, a, o, lane); } }

__global__ void __launch_bounds__(NWAVES * 64, 2) hymba_fwd(Args args) {
    extern __shared__ __attribute__((aligned(16))) unsigned char lds[];
    Frame F;
    F.lds = (LAS unsigned char*)lds;
    F.MISC = (volatile LAS unsigned*)(F.lds + MISC_OFF);
    F.wave = __builtin_amdgcn_readfirstlane((int)threadIdx.x >> 6);
    F.G = gridDim.x; { const int bx = blockIdx.x; F.vcu = (F.G % 8 == 0) ? (bx % 8) * (F.G / 8) + bx / 8 : bx; }
    F.ws = args.ws; F.out = args.out; F.ctl = (unsigned*)(args.ws + WS_CTL);
    F.ap = &args;
    for (int u = threadIdx.x; u < (LDS_BYTES - LDSCTL_OFF) / 4; u += NWAVES * 64) ((LAS unsigned*)(F.lds + LDSCTL_OFF))[u] = 0u;
    __syncthreads();
    XcdBarrier bar; bar.bar = F.ctl + CW_BAR; bar.x = 0; bar.st = nullptr;
#if !MK_PER_PHASE
    bar = xcd_barrier_post(F.ctl + CW_BAR, F.MISC + 8);
#endif
    const int lo = args.ph_lo, hi = args.ph_hi;
#define IN(k) (lo <= (k) && (k) < hi)
#if MK_PER_PHASE
#define SEAM(k) do { } while (0)
#else
#define SEAM(k) do { if (IN(k) && IN((k) + 1)) xcd_barrier(bar); } while (0)
#endif
#ifndef PROBE
#define PROBE (-1)
#endif
#define RUN(k, call) do { if (IN(k)) { call; if (PROBE == (k)) { xcd_barrier(bar); call; } } } while (0)
    RUN(0, ph0(F));  SEAM(0);
    RUN(1, ph1(F));  SEAM(1);
    RUN(2, ph2(F));  SEAM(2);
    RUN(3, ph3(F));  SEAM(3);
    RUN(4, ph4(F));  SEAM(4);
    RUN(5, ph5(F));  SEAM(5);
    RUN(6, ph6(F));  SEAM(6);
    RUN(7, ph7(F));  SEAM(7);
    RUN(8, ph8(F));  SEAM(8);
    RUN(9, ph9(F));  SEAM(9);
    RUN(10, ph10(F)); SEAM(10);
    RUN(11, ph11(F)); SEAM(11);
    RUN(12, ph12(F));
#undef RUN
#undef IN
#undef SEAM
}

extern "C" void kernel_launch(void* const* d_in, const int* in_sizes, int n_in, void* d_out, int out_size, void* d_ws, size_t ws_size, hipStream_t stream) {
    static int grid = 0;
    if (grid == 0) {
        if (n_in != 32 || (size_t)out_size != O_END || ws_size < WS_END) { fprintf(stderr, "kernel_launch: unexpected shapes (n_in %d, out %d, ws %zu); nothing launched\n", n_in, out_size, ws_size); grid = -1; return; }
        int dev = 0, cus = 0, per_cu = 0;
        if (hipGetDevice(&dev) != hipSuccess || hipDeviceGetAttribute(&cus, hipDeviceAttributeMultiprocessorCount, dev) != hipSuccess) { fprintf(stderr, "kernel_launch: device query failed\n"); grid = -1; return; }
        if (hipFuncSetAttribute((const void*)hymba_fwd, hipFuncAttributeMaxDynamicSharedMemorySize, LDS_BYTES) != hipSuccess) { fprintf(stderr, "kernel_launch: hipFuncSetAttribute failed\n"); grid = -1; return; }
        if (hipOccupancyMaxActiveBlocksPerMultiprocessor(&per_cu, (const void*)hymba_fwd, NWAVES * 64, LDS_BYTES) != hipSuccess || per_cu < 1) fprintf(stderr, "kernel_launch: note: occupancy query reports %d workgroups per CU\n", per_cu);
        (void)hipGetLastError();
        grid = cus;
    }
    if (grid < 0) return;
    if (hipMemsetAsync((char*)d_ws + WS_CTL, 0, CTL_ZERO_BYTES, stream) != hipSuccess) { fprintf(stderr, "kernel_launch: memset failed\n"); return; }
    Args a{};
    for (int i = 0; i < 32; ++i) a.in[i] = d_in[i];
    a.out = (float*)d_out; a.ws = (unsigned char*)d_ws;
#if MK_PER_PHASE
    for (int p = 0; p < NPHASE; ++p) { a.ph_lo = p; a.ph_hi = p + 1; hipLaunchKernelGGL(hymba_fwd, dim3(grid), dim3(NWAVES * 64), LDS_BYTES, stream, a); }
#else
    a.ph_lo = 0; a.ph_hi = NPHASE;
    hipLaunchKernelGGL(hymba_fwd, dim3(grid), dim3(NWAVES * 64), LDS_BYTES, stream, a);
#endif
    const hipError_t le = hipPeekAtLastError();
    if (le != hipSuccess) fprintf(stderr, "kernel_launch: launch failed: %s\n", hipGetErrorName(le));
}
```

```cpp
#include <hip/hip_runtime.h>
#include <cstdio>
#include <cstdint>

#ifndef MK_PER_PHASE
#define MK_PER_PHASE 0
#endif
namespace pg8 {
#define PG8_LAS __attribute__((address_space(3)))
typedef unsigned short bf16_t;
typedef short bf16x8 __attribute__((ext_vector_type(8)));
typedef float f32x4 __attribute__((ext_vector_type(4)));
typedef unsigned u32x4 __attribute__((ext_vector_type(4)));
constexpr int BM = 256, BK = 64, HALF = 128, HTB = HALF * BK * 2  , STAGE_BYTES = 8 * HTB, NXCD = 8, WGM = 8;

__host__ __device__ __forceinline__ int lds_byte(int r, int c) { const int st = (r >> 4) * 2 + (c >> 5), rr = r & 15, cc = c & 31, ob = rr * 64 + cc * 2; return st * 1024 + (ob ^ (((ob >> 9) & 1) << 5)); }
__host__ __device__ __forceinline__ void stage_rc(int b, int& R, int& C) { const int st = b / 1024, sb = b % 1024, swz = sb ^ (((sb >> 9) & 1) << 5); R = (st >> 1) * 16 + swz / 64; C = (st & 1) * 32 + (swz % 64) / 2; }
__host__ __device__ __forceinline__ int perm32(int rho) { const int n = rho >> 4, i = rho & 15; return 8 * (i >> 2) + 4 * n + (i & 3); }

struct Unit { int pm, pn; };
struct Gemm { const bf16_t* A; const bf16_t* Bt; int M, N, K; };

struct StaticOrder {
    int nM, nN, nwg, G, c;
    __host__ __device__ void init(int M, int N, int G_, int c_) { nM = M / BM; nN = N / BM; nwg = nM * nN; G = G_; c = c_; }
    __host__ __device__ bool next(int i, Unit& u) const {
        const long L = (long)i * G + c; if (L >= nwg) return false;
        int wgid = (int)L; { const int q = nwg / NXCD, r = nwg % NXCD, xcd = wgid % NXCD, off = wgid / NXCD; wgid = (xcd < r ? xcd * (q + 1) : r * (q + 1) + (xcd - r) * q) + off; }
        const int nig = WGM * nN, gid = wgid / nig, fm = gid * WGM, gsz = (nM - fm) < WGM ? (nM - fm) : WGM;
        u.pm = fm + ((wgid % nig) % gsz); u.pn = (wgid % nig) / gsz; return true;
    }
    __device__ __forceinline__ void a_ready(const Unit&) const {}
    __device__ __forceinline__ void done(const Unit&) const {}
};

__device__ __forceinline__ unsigned cvt_pk_bf16(float lo, float hi) { unsigned r; asm volatile("v_cvt_pk_bf16_f32 %0, %1, %2" : "=v"(r) : "v"(lo), "v"(hi)); return r; }
typedef float f32x2 __attribute__((ext_vector_type(2)));
typedef unsigned u32x2 __attribute__((ext_vector_type(2)));
struct EpiProj {
    static constexpr bool PERM = true, AFTER_DRAIN = false;
    bf16_t* O; float* dtraw;
    __device__ __forceinline__ void operator()(const f32x4 (&acc)[2][2][4][2], const Unit& u, int wr, int wc, int fr, int fq) const {
        const int row0 = u.pm * BM + wr * 64 + fr, col0 = u.pn * BM + wc * 32 + 8 * fq;
#pragma unroll
        for (int ai = 0; ai < 2; ++ai)
#pragma unroll
            for (int m = 0; m < 4; ++m) { const int row = row0 + ai * HALF + m * 16; bf16_t* rowp = O + (size_t)row * 2304 + col0;
#pragma unroll
                for (int bj = 0; bj < 2; ++bj) { const f32x4 v0 = acc[ai][bj][m][0], v1 = acc[ai][bj][m][1];
                    u32x4 w; w.x = cvt_pk_bf16(v0[0], v0[1]); w.y = cvt_pk_bf16(v0[2], v0[3]); w.z = cvt_pk_bf16(v1[0], v1[1]); w.w = cvt_pk_bf16(v1[2], v1[3]);
                    *(u32x4*)(rowp + bj * HALF) = w;
                    if (col0 + bj * HALF == 2208) { *(f32x4*)(dtraw + (size_t)row * 8) = v0; *(f32x4*)(dtraw + (size_t)row * 8 + 4) = v1; } } }
    }
};
struct EpiQ {
    static constexpr bool PERM = false, AFTER_DRAIN = false;
    bf16_t* QP; bf16_t* QSN; bf16_t* QSR; const float* CS; float scl;
    __device__ __forceinline__ void operator()(const f32x4 (&acc)[2][2][4][2], const Unit& u, int wr, int wc, int fr, int fq) const {
        const int row0 = u.pm * BM + wr * 64 + fr;
#pragma unroll
        for (int ai = 0; ai < 2; ++ai)
#pragma unroll
            for (int m = 0; m < 4; ++m) { const int row = row0 + ai * HALF + m * 16; const bool isp = row < 16384; const int b = row >> 13, t = row & 8191, rs = row - 16384, l = rs & 3;
                if (u.pn < 2) {
#pragma unroll
                    for (int bj = 0; bj < 2; ++bj)
#pragma unroll
                        for (int n = 0; n < 2; ++n) { const int col = u.pn * BM + bj * HALF + wc * 32 + n * 16 + 4 * fq, h = col >> 6, d = col & 63; const f32x4 v = acc[ai][bj][m][n];
                            if (isp) { u32x2 w; w.x = cvt_pk_bf16(v[0] * scl, v[1] * scl); w.y = cvt_pk_bf16(v[2] * scl, v[3] * scl); *(u32x2*)(QP + ((size_t)(b * 8 + h) * 8192 + t) * 96 + d) = w; }
                            else { u32x2 w; w.x = cvt_pk_bf16(v[0], v[1]); w.y = cvt_pk_bf16(v[2], v[3]); *(u32x2*)(QSN + (size_t)rs * 512 + col) = w; } }
                } else {
                    const int pos = isp ? t : 8192 + l; const int i0 = 4 * fq;
                    const f32x4 c0 = *(const f32x4*)(CS + ((size_t)pos * 16 + i0) * 2), c1 = *(const f32x4*)(CS + ((size_t)pos * 16 + i0) * 2 + 4);
                    const float cs_[4] = {c0[0], c0[2], c1[0], c1[2]}, sn_[4] = {c0[1], c0[3], c1[1], c1[3]};
#pragma unroll
                    for (int bj = 0; bj < 2; ++bj) { const int h = 4 * bj + wc; const f32x4 x1 = acc[ai][bj][m][0], x2 = acc[ai][bj][m][1]; float o1[4], o2[4];
#pragma unroll
                        for (int j = 0; j < 4; ++j) { o1[j] = (x1[j] * cs_[j] - x2[j] * sn_[j]) * scl; o2[j] = (x1[j] * sn_[j] + x2[j] * cs_[j]) * scl; }
                        u32x2 w1, w2; w1.x = cvt_pk_bf16(o1[0], o1[1]); w1.y = cvt_pk_bf16(o1[2], o1[3]); w2.x = cvt_pk_bf16(o2[0], o2[1]); w2.y = cvt_pk_bf16(o2[2], o2[3]);
                        bf16_t* dst = isp ? QP + ((size_t)(b * 8 + h) * 8192 + t) * 96 + 64 + i0 : QSR + ((size_t)rs * 8 + h) * 32 + i0;
                        *(u32x2*)dst = w1; *(u32x2*)(dst + 16) = w2; }
                } }
    }
};
struct EpiKV {
    static constexpr bool PERM = true, AFTER_DRAIN = false;
    bf16_t* KP; bf16_t* VP;
    __device__ __forceinline__ void operator()(const f32x4 (&acc)[2][2][4][2], const Unit& u, int wr, int wc, int fr, int fq) const {
        const int row0 = u.pm * BM + wr * 64 + fr, col0 = u.pn * BM + wc * 32 + 8 * fq;
#pragma unroll
        for (int ai = 0; ai < 2; ++ai)
#pragma unroll
            for (int m = 0; m < 4; ++m) { const int row = row0 + ai * HALF + m * 16; const int b = row >> 13, t = row & 8191, tile = t >> 6, key = t & 63;
#pragma unroll
                for (int bj = 0; bj < 2; ++bj) { const int col = col0 + bj * HALF; const f32x4 v0 = acc[ai][bj][m][0], v1 = acc[ai][bj][m][1];
                    u32x4 w; w.x = cvt_pk_bf16(v0[0], v0[1]); w.y = cvt_pk_bf16(v0[2], v0[3]); w.z = cvt_pk_bf16(v1[0], v1[1]); w.w = cvt_pk_bf16(v1[2], v1[3]);
                    bf16_t* dst;
                    if (col < 512) { const int h = col >> 6, d = col & 63; dst = KP + ((((size_t)(b * 8 + h)) * 128 + tile) * 12 + (d >> 3)) * 512 + key * 8; }
                    else { const int cc = col - 512, h = cc >> 6, d = cc & 63; dst = VP + ((((size_t)(b * 8 + h)) * 128 + tile) * 2 + (d >> 5)) * 2048 + (key >> 4) * 512 + (key & 15) * 32 + (d & 31); }
                    *(u32x4*)dst = w; } }
    }
};
struct EpiRes {
    static constexpr bool PERM = false, AFTER_DRAIN = false;
    const float* baseP; const float* baseS; float* out; const float* ada; int goff;
    __device__ __forceinline__ void operator()(const f32x4 (&acc)[2][2][4][2], const Unit& u, int wr, int wc, int fr, int fq) const {
        const int row0 = u.pm * BM + wr * 64 + fr;
#pragma unroll
        for (int ai = 0; ai < 2; ++ai)
#pragma unroll
            for (int m = 0; m < 4; ++m) { const int row = row0 + ai * HALF + m * 16; const bool isp = row < 16384;
                const float* brow = isp ? baseP + (size_t)row * 1024 : baseS + (size_t)(row - 16384) * 1024;
                const float* g = ada + (size_t)(isp ? (row >> 13) : 2 + ((row - 16384) >> 2)) * 6144 + goff;
#pragma unroll
                for (int bj = 0; bj < 2; ++bj)
#pragma unroll
                    for (int n = 0; n < 2; ++n) { const int col = u.pn * BM + bj * HALF + wc * 32 + n * 16 + 4 * fq;
                        const f32x4 o = *(const f32x4*)(brow + col) + *(const f32x4*)(g + col) * acc[ai][bj][m][n];
                        *(f32x4*)(out + (size_t)row * 1024 + col) = o; } }
    }
};
struct EpiUp {
    static constexpr bool PERM = true, AFTER_DRAIN = false;
    bf16_t* O;
    __device__ __forceinline__ void operator()(const f32x4 (&acc)[2][2][4][2], const Unit& u, int wr, int wc, int fr, int fq) const {
        const int row0 = u.pm * BM + wr * 64 + fr, col0 = u.pn * BM + wc * 32 + 8 * fq;
#pragma unroll
        for (int ai = 0; ai < 2; ++ai)
#pragma unroll
            for (int m = 0; m < 4; ++m) { bf16_t* rowp = O + (size_t)(row0 + ai * HALF + m * 16) * 4096 + col0;
#pragma unroll
                for (int bj = 0; bj < 2; ++bj) { f32x4 v0 = acc[ai][bj][m][0], v1 = acc[ai][bj][m][1];
#pragma unroll
                    for (int j = 0; j < 4; ++j) { const float a = v0[j] > 0.f ? v0[j] : 0.f, b = v1[j] > 0.f ? v1[j] : 0.f; v0[j] = a * a; v1[j] = b * b; }
                    u32x4 w; w.x = cvt_pk_bf16(v0[0], v0[1]); w.y = cvt_pk_bf16(v0[2], v0[3]); w.z = cvt_pk_bf16(v1[0], v1[1]); w.w = cvt_pk_bf16(v1[2], v1[3]);
                    *(u32x4*)(rowp + bj * HALF) = w; } }
    }
};
template <class Epi, class Sched, bool ALIGN_EPI = false, bool SP2 = false>
__device__ __forceinline__ void gemm_phase(PG8_LAS unsigned char* lds, const Gemm g, const Sched& S, const Epi& E) {
    const int tid = threadIdx.x, wid = __builtin_amdgcn_readfirstlane(tid >> 6), lane = tid & 63, wr = wid >> 2, wc = wid & 3, fr = lane & 15, fq = lane >> 4;
    const int K = g.K, nt = K / BK;
    unsigned voffA[2], voffB[2];
#pragma unroll
    for (int i = 0; i < 2; ++i) { int R, C; stage_rc(tid * 16 + i * 8192, R, C); const int Rb = Epi::PERM ? ((R & ~31) + perm32(R & 31)) : R;
        voffA[i] = (unsigned)(R * K + C) * 2u; voffB[i] = (unsigned)(Rb * K + C) * 2u; }
    const size_t kstep = (size_t)(BK * 2);
    const size_t hstep = (size_t)HALF * K * 2;
    const size_t tstep = 2 * hstep;
    const unsigned ldsw = (unsigned)wid * 1024u;
    const int aoff = lds_byte(wr * 64 + fr, fq * 8), boff = lds_byte(wc * 32 + fr, fq * 8);
#define PG8_SA(b, h) (((b) * 2 + (h)) * HTB)
#define PG8_SB(b, h) ((4 + (b) * 2 + (h)) * HTB)
#define PG8_STAGE(bufoff, gbase, voff) do { _Pragma("unroll") for (int _i = 0; _i < 2; ++_i) \
        __builtin_amdgcn_global_load_lds((const unsigned*)((const char*)(gbase) + (voff)[_i]), (PG8_LAS unsigned*)(lds + (bufoff) + ldsw + _i * 8192), 16, 0, 0); } while (0)
#define PG8_LDA(dst, b, h) do { _Pragma("unroll") for (int m = 0; m < 4; ++m) _Pragma("unroll") for (int k = 0; k < 2; ++k) dst[m][k] = *(const PG8_LAS bf16x8*)(lds + PG8_SA(b, h) + aoff + m * 2048 + k * 1024); } while (0)
#define PG8_LDB(dst, b, h) do { _Pragma("unroll") for (int n = 0; n < 2; ++n) _Pragma("unroll") for (int k = 0; k < 2; ++k) dst[n][k] = *(const PG8_LAS bf16x8*)(lds + PG8_SB(b, h) + boff + n * 2048 + k * 1024); } while (0)
#define PG8_MMA(ai, bj, At, Bt) do { __builtin_amdgcn_s_setprio(1); _Pragma("unroll") for (int m = 0; m < 4; ++m) _Pragma("unroll") for (int n = 0; n < 2; ++n) _Pragma("unroll") for (int k = 0; k < 2; ++k) \
        acc[ai][bj][m][n] = __builtin_amdgcn_mfma_f32_16x16x32_bf16(Bt[n][k], At[m][k], acc[ai][bj][m][n], 0, 0, 0); __builtin_amdgcn_s_setprio(0); } while (0)
#define PG8_WAIT_V(n) asm volatile("s_waitcnt vmcnt(" #n ")" ::: "memory")
#define PG8_WAIT_L(n) asm volatile("s_waitcnt lgkmcnt(" #n ")" ::: "memory")
#define PG8_BAR __builtin_amdgcn_s_barrier()
#define PG8_SCHED __builtin_amdgcn_sched_barrier(0)
    Unit cur, nxt; int ui = 0;
    if (!S.next(0, cur)) return;
    f32x4 acc[2][2][4][2];
#pragma unroll
    for (int a = 0; a < 2; ++a)
#pragma unroll
        for (int b = 0; b < 2; ++b)
#pragma unroll
            for (int m = 0; m < 4; ++m)
#pragma unroll
                for (int n = 0; n < 2; ++n) acc[a][b][m][n] = (f32x4){0.f, 0.f, 0.f, 0.f};
    bf16x8 At[4][2], B0[2][2], B1[2][2];
    const char* cA = (const char*)g.A + (size_t)cur.pm * tstep; const char* cB = (const char*)g.Bt + (size_t)cur.pn * tstep;
    S.a_ready(cur);
    if constexpr (SP2) {
        PG8_STAGE(PG8_SB(0, 0), cB, voffB); PG8_STAGE(PG8_SB(0, 1), cB + hstep, voffB); PG8_STAGE(PG8_SA(0, 0), cA, voffA); PG8_STAGE(PG8_SA(0, 1), cA + hstep, voffA);
        if (wr == 1) PG8_BAR;
        PG8_WAIT_V(2); PG8_BAR;
        PG8_STAGE(PG8_SB(1, 0), cB + kstep, voffB); PG8_STAGE(PG8_SA(1, 0), cA + kstep, voffA); PG8_STAGE(PG8_SB(1, 1), cB + hstep + kstep, voffB);
        PG8_WAIT_V(6); PG8_BAR;
    } else {
        PG8_STAGE(PG8_SB(0, 0), cB, voffB); PG8_STAGE(PG8_SA(0, 0), cA, voffA); PG8_STAGE(PG8_SB(0, 1), cB + hstep, voffB); PG8_STAGE(PG8_SA(0, 1), cA + hstep, voffA);
        if (wr == 1) PG8_BAR;
        PG8_WAIT_V(4); PG8_BAR;
        PG8_STAGE(PG8_SB(1, 0), cB + kstep, voffB); PG8_STAGE(PG8_SA(1, 0), cA + kstep, voffA); PG8_STAGE(PG8_SB(1, 1), cB + hstep + kstep, voffB);
        PG8_WAIT_V(6); PG8_BAR;
    }
    for (;;) {
        const bool has_next = S.next(ui + 1, nxt);
        const char* nA = has_next ? (const char*)g.A + (size_t)nxt.pm * tstep : cA; const char* nB = has_next ? (const char*)g.Bt + (size_t)nxt.pn * tstep : cB;
        for (int t = 0; t < nt; t += 2) {
            const bool last = (t == nt - 2);
            const char* a1 = cA + (size_t)(t + 1) * kstep;
            const char* a2 = last ? nA : cA + (size_t)(t + 2) * kstep; const char* b2 = last ? nB : cB + (size_t)(t + 2) * kstep;
            const char* a3 = a2 + kstep; const char* b3 = b2 + kstep;
            if (last && has_next) S.a_ready(nxt);
            if constexpr (SP2) {
            PG8_LDB(B0, 0, 0); PG8_LDB(B1, 0, 1); PG8_SCHED; PG8_LDA(At, 0, 0); PG8_STAGE(PG8_SA(1, 1), a1 + hstep, voffA);
            PG8_WAIT_V(8); PG8_WAIT_L(0); PG8_BAR; PG8_MMA(0, 0, At, B0); PG8_MMA(0, 1, At, B1); PG8_BAR; PG8_SCHED;
            PG8_LDA(At, 0, 1); PG8_STAGE(PG8_SB(0, 0), b2, voffB); PG8_STAGE(PG8_SB(0, 1), b2 + hstep, voffB); PG8_STAGE(PG8_SA(0, 0), a2, voffA);
            PG8_WAIT_V(8); PG8_WAIT_L(0); PG8_BAR; PG8_MMA(1, 0, At, B0); PG8_MMA(1, 1, At, B1); PG8_BAR; PG8_SCHED;
            PG8_LDB(B0, 1, 0); PG8_LDB(B1, 1, 1); PG8_SCHED; PG8_LDA(At, 1, 0); PG8_STAGE(PG8_SA(0, 1), a2 + hstep, voffA);
            PG8_WAIT_V(8); PG8_WAIT_L(0); PG8_BAR; PG8_MMA(0, 0, At, B0); PG8_MMA(0, 1, At, B1); PG8_BAR; PG8_SCHED;
            PG8_LDA(At, 1, 1); PG8_STAGE(PG8_SB(1, 0), b3, voffB); PG8_STAGE(PG8_SB(1, 1), b3 + hstep, voffB); PG8_STAGE(PG8_SA(1, 0), a3, voffA);
            PG8_WAIT_V(8); PG8_WAIT_L(0); PG8_BAR; PG8_MMA(1, 0, At, B0); PG8_MMA(1, 1, At, B1); PG8_BAR; PG8_SCHED;
            } else {
            PG8_LDB(B0, 0, 0); PG8_SCHED; PG8_LDA(At, 0, 0); PG8_STAGE(PG8_SA(1, 1), a1 + hstep, voffA);
            PG8_WAIT_L(8); PG8_BAR; PG8_WAIT_L(0); PG8_MMA(0, 0, At, B0); PG8_BAR; PG8_SCHED;
            PG8_LDB(B1, 0, 1); PG8_STAGE(PG8_SB(0, 0), b2, voffB);
            PG8_BAR; PG8_WAIT_L(0); PG8_MMA(0, 1, At, B1); PG8_BAR;
            PG8_LDA(At, 0, 1); PG8_STAGE(PG8_SA(0, 0), a2, voffA);
            PG8_BAR; PG8_WAIT_L(0); PG8_MMA(1, 0, At, B0); PG8_BAR; PG8_SCHED;
            PG8_STAGE(PG8_SB(0, 1), b2 + hstep, voffB);
            PG8_WAIT_V(6); PG8_BAR; PG8_MMA(1, 1, At, B1); PG8_BAR;
            PG8_LDB(B0, 1, 0); PG8_SCHED; PG8_LDA(At, 1, 0); PG8_STAGE(PG8_SA(0, 1), a2 + hstep, voffA);
            PG8_WAIT_L(8); PG8_BAR; PG8_WAIT_L(0); PG8_MMA(0, 0, At, B0); PG8_BAR; PG8_SCHED;
            PG8_LDB(B1, 1, 1); PG8_STAGE(PG8_SB(1, 0), b3, voffB);
            PG8_BAR; PG8_WAIT_L(0); PG8_MMA(0, 1, At, B1); PG8_BAR;
            PG8_LDA(At, 1, 1); PG8_STAGE(PG8_SA(1, 0), a3, voffA);
            PG8_BAR; PG8_WAIT_L(0); PG8_MMA(1, 0, At, B0); PG8_BAR; PG8_SCHED;
            PG8_STAGE(PG8_SB(1, 1), b3 + hstep, voffB);
            PG8_WAIT_V(6); PG8_BAR; PG8_MMA(1, 1, At, B1); PG8_BAR;
            }
        }
        if constexpr (ALIGN_EPI) { if (wr == 0) PG8_BAR; }
        if constexpr (!Epi::AFTER_DRAIN) { E(acc, cur, wr, wc, fr, fq); S.done(cur); }
        if (!has_next) break;
#pragma unroll
        for (int a = 0; a < 2; ++a)
#pragma unroll
            for (int b = 0; b < 2; ++b)
#pragma unroll
                for (int m = 0; m < 4; ++m)
#pragma unroll
                    for (int n = 0; n < 2; ++n) acc[a][b][m][n] = (f32x4){0.f, 0.f, 0.f, 0.f};
        cur = nxt; cA = nA; cB = nB; ++ui;
        if constexpr (ALIGN_EPI) { if (wr == 1) PG8_BAR; }
    }
    PG8_WAIT_V(0);
    if constexpr (!ALIGN_EPI) { if (wr == 0) PG8_BAR; }
    PG8_BAR;
    if constexpr (Epi::AFTER_DRAIN) { E.fused(acc, cur, wr, wc, fr, fq, lds, wid, lane); S.done(cur); }
#undef PG8_SA
#undef PG8_SB
#undef PG8_STAGE
#undef PG8_LDA
#undef PG8_LDB
#undef PG8_MMA
#undef PG8_WAIT_V
#undef PG8_WAIT_L
#undef PG8_BAR
#undef PG8_SCHED
}
}
constexpr int DM = 1024, SEQ = 8192, MP = 16384, NSEQ = 128, MS = 512, MT = 16896, NPROJ = 2304, DFF = 4096;
constexpr float EPS = 1e-6f;
constexpr float SCL2 = 0.1472444460259031f;
constexpr size_t MiB = 1u << 20;
constexpr size_t WS_CTL = 0, CTL_ZERO_BYTES = 1 * MiB;
constexpr size_t WS_WIN = 2 * MiB, WS_WUQ = 7 * MiB, WS_WKV = 8 * MiB, WS_WOUT = 9 * MiB, WS_WUP = 11 * MiB, WS_WDOWN = 19 * MiB;
constexpr size_t WS_ADA = 27 * MiB, WS_ADAF = 31 * MiB, WS_CS = 33 * MiB, WS_DTRAW = 35 * MiB, WS_DT = 36 * MiB, WS_QSN = 37 * MiB, WS_QSR = 38 * MiB, WS_KRS = 38 * MiB + 512 * 1024;
constexpr size_t WS_OPART = 39 * MiB, WS_ML = 47 * MiB, WS_H1 = 48 * MiB, WS_PROJ = 82 * MiB, WS_XBC = 158 * MiB, WS_QN = 192 * MiB, WS_CKV = 206 * MiB;
constexpr size_t WS_QP = 216 * MiB, WS_KP = 240 * MiB, WS_VP = 264 * MiB, WS_YSSD = 280 * MiB, WS_OATT = 314 * MiB, WS_AMIX = 332 * MiB, WS_X1 = 366 * MiB, WS_U = 432 * MiB, WS_X2 = 564 * MiB, WS_SCH = 632 * MiB, WS_HP = 664 * MiB, WS_CD = 680 * MiB, WS_EACS = 681 * MiB, WS_END = 682 * MiB;
constexpr int CW_BAR = 4096;
constexpr size_t O_YP = 0, O_YS = 16777216, O_KVP = 17301504, O_KRP = 21495808, O_CVP = 22020096, O_SSP = 22026240, O_KVS = 22157312, O_KRS = 22288384, O_CVS = 22304768, O_SSS = 22697984, O_END = 31086592;
constexpr int PHASE_LDS = 143360, LDSCTL_OFF = PHASE_LDS, MISC_OFF = LDSCTL_OFF + 320, LDS_BYTES = 147456;
constexpr int NWAVES = 8, NPHASE = 13;

#define GAS __attribute__((address_space(1)))
#define LAS __attribute__((address_space(3)))
typedef unsigned short bf16;
typedef unsigned v4u __attribute__((ext_vector_type(4)));
typedef unsigned v2u __attribute__((ext_vector_type(2)));
typedef float f32x4 __attribute__((ext_vector_type(4)));
typedef float f32x16 __attribute__((ext_vector_type(16)));
typedef short bf16x8 __attribute__((ext_vector_type(8)));
typedef short s16x4 __attribute__((ext_vector_type(4)));
#define LDS_WAIT() asm volatile("s_waitcnt lgkmcnt(0)" ::: "memory")
__device__ __forceinline__ unsigned f2bf(float f) { unsigned u = __builtin_bit_cast(unsigned, f); return (u + 0x7fffu + ((u >> 16) & 1u)) >> 16; }
__device__ __forceinline__ unsigned pk2(float lo, float hi) { return f2bf(lo) | (f2bf(hi) << 16); }
__device__ __forceinline__ float bflo(unsigned w) { return __uint_as_float(w << 16); }
__device__ __forceinline__ float bfhi(unsigned w) { return __uint_as_float(w & 0xffff0000u); }
__device__ __forceinline__ float bf2f(bf16 v) { return __uint_as_float((unsigned)v << 16); }
__device__ __forceinline__ float wave_sum(float v) {
#pragma unroll
    for (int o = 1; o < 64; o <<= 1) v += __shfl_xor(v, o);
    return v;
}
__device__ __forceinline__ float siluf(float v) { return v / (1.f + __expf(-v)); }

__constant__ double ROPE_REV[16] = {0.15915494309189535, 0.08949940160889101, 0.050329212104487035, 0.0283021958306234, 0.015915494309189534, 0.008949940160889102, 0.005032921210448704, 0.00283021958306234,
    0.0015915494309189536, 0.0008949940160889102, 0.0005032921210448703, 0.00028302195830623395, 0.00015915494309189535, 8.949940160889102e-05, 5.0329212104487035e-05, 2.8302195830623396e-05};

#define XB_TMO      128
#define XB_XCNT(j)  (256  + 64 * (j))
#define XB_XSUB(j)  (1280 + 64 * (j))
#define XB_XGEN(j)  (2304 + 64 * (j))
#define XB_TOP      3328
#define XB_TOPGEN   3392
#define XCD_BAR_WORDS 3456
#define XB_SPIN_CAP (1u << 18)

__device__ __forceinline__ unsigned xb_ld(unsigned* p)              { return __hip_atomic_load(p, __ATOMIC_RELAXED, __HIP_MEMORY_SCOPE_AGENT); }
__device__ __forceinline__ unsigned xb_add(unsigned* p, unsigned v) { return __hip_atomic_fetch_add(p, v, __ATOMIC_RELAXED, __HIP_MEMORY_SCOPE_AGENT); }
__device__ __forceinline__ unsigned xb_xcc_id() { return (unsigned)__builtin_amdgcn_s_getreg((3 << 11) | 20) & 0xFu; }
#define XB_SPIN(cond, bar) do { unsigned _sp = 0; while (cond) { __builtin_amdgcn_s_sleep(1); \
    if ((++_sp & 255u) == 0u) { if (xb_ld(&(bar)[XB_TMO])) break; if (_sp > XB_SPIN_CAP) { atomicAdd(&(bar)[XB_TMO], 1u); break; } } } } while (0)

struct XcdBarrier {
    unsigned* bar; unsigned x;
    volatile LAS unsigned* st;
};

__device__ __forceinline__ XcdBarrier xcd_barrier_post(unsigned* bar, volatile LAS unsigned* st) {
    XcdBarrier b; b.bar = bar; b.x = xb_xcc_id(); b.st = st;
    if (threadIdx.x == 0) (void)xb_add(&bar[XB_XCNT(b.x)], 1u);
    return b;
}
__device__ __forceinline__ void xcd_barrier_complete(unsigned* bar, unsigned x, unsigned& nloc, unsigned& nx) {
    const unsigned G = gridDim.x * gridDim.y * gridDim.z;
    unsigned sum, cnt, mine, sp = 0u;
    for (;;) {
        sum = 0u; cnt = 0u; mine = 0u;
#pragma unroll
        for (unsigned j = 0; j < 16; ++j) { const unsigned c = xb_ld(&bar[XB_XCNT(j)]); sum += c; cnt += (c > 0u) ? 1u : 0u; mine = (j == x) ? c : mine; }
        if (sum == G) break;
        __builtin_amdgcn_s_sleep(1);
        if ((++sp & 255u) == 0u) { if (xb_ld(&bar[XB_TMO])) break; if (sp > XB_SPIN_CAP) { atomicAdd(&bar[XB_TMO], 1u); break; } }
    }
    nloc = mine > 0u ? mine : 1u; nx = cnt > 0u ? cnt : 1u;
}

__device__ __forceinline__ void xcd_barrier(const XcdBarrier& b) {
    asm volatile("s_waitcnt vmcnt(0)" ::: "memory");
    __syncthreads();
    if (threadIdx.x == 0) {
        unsigned* bar = b.bar;
        __builtin_amdgcn_s_waitcnt(0);
        unsigned nloc = b.st[0], nx = b.st[1];
        if (nloc == 0u) { xcd_barrier_complete(bar, b.x, nloc, nx); b.st[0] = nloc; b.st[1] = nx; }
        const unsigned old = xb_add(&bar[XB_XSUB(b.x)], 1u);
        const unsigned gen = old / nloc;
        if (old + 1u == (gen + 1u) * nloc) {
            __builtin_amdgcn_fence(__ATOMIC_RELEASE, "agent");
            asm volatile("s_waitcnt vmcnt(0)" ::: "memory");
            const unsigned og = xb_add(&bar[XB_TOP], 1u);
            const unsigned tg = og / nx;
            if (og + 1u == (tg + 1u) * nx) xb_add(&bar[XB_TOPGEN], 1u);
            else XB_SPIN(xb_ld(&bar[XB_TOPGEN]) == tg, bar);
            __builtin_amdgcn_fence(__ATOMIC_ACQUIRE, "agent");
            xb_add(&bar[XB_XGEN(b.x)], 1u);
            asm volatile("s_waitcnt vmcnt(0)" ::: "memory");
        } else {
            XB_SPIN(xb_ld(&bar[XB_XGEN(b.x)]) == gen, bar);
            __builtin_amdgcn_fence(__ATOMIC_ACQUIRE, "agent");
            asm volatile("s_waitcnt vmcnt(0)" ::: "memory");
        }
    }
    __syncthreads();
}

struct Args { const void* in[32]; float* out; unsigned char* ws; int ph_lo, ph_hi; };
struct Frame {
    LAS unsigned char* lds;
    volatile LAS unsigned* MISC;
    unsigned* ctl;
    int wave, vcu, G;
    const Args* ap;
    float* out; unsigned char* ws;
    __device__ __forceinline__ const void* inp(int k) const { asm volatile("" : "+s"(k)); return ap->in[k]; }
    __device__ __forceinline__ const float* xp() const { return (const float*)inp(0); }
    __device__ __forceinline__ const float* xs() const { return (const float*)inp(1); }
    __device__ __forceinline__ const float* cache_kv() const { return (const float*)inp(2); }
    __device__ __forceinline__ const float* cache_kr() const { return (const float*)inp(3); }
    __device__ __forceinline__ const float* sconv() const { return (const float*)inp(4); }
    __device__ __forceinline__ const float* sssm() const { return (const float*)inp(5); }
    __device__ __forceinline__ const int* ptab() const { return (const int*)inp(6); }
    __device__ __forceinline__ const float* cprm() const { return (const float*)inp(7); }
    __device__ __forceinline__ const float* csmp() const { return (const float*)inp(8); }
    __device__ __forceinline__ const float* w_ada() const { return (const float*)inp(9); }
    __device__ __forceinline__ const float* b_ada() const { return (const float*)inp(10); }
    __device__ __forceinline__ const float* g_mix() const { return (const float*)inp(11); }
    __device__ __forceinline__ const float* w_in() const { return (const float*)inp(12); }
    __device__ __forceinline__ const float* conv_w() const { return (const float*)inp(13); }
    __device__ __forceinline__ const float* conv_b() const { return (const float*)inp(14); }
    __device__ __forceinline__ const float* dt_bias() const { return (const float*)inp(15); }
    __device__ __forceinline__ const float* a_log() const { return (const float*)inp(16); }
    __device__ __forceinline__ const float* d_skip() const { return (const float*)inp(17); }
    __device__ __forceinline__ const float* g_ssd() const { return (const float*)inp(18); }
    __device__ __forceinline__ const float* g_q() const { return (const float*)inp(19); }
    __device__ __forceinline__ const float* g_kv() const { return (const float*)inp(20); }
    __device__ __forceinline__ const float* w_uq() const { return (const float*)inp(21); }
    __device__ __forceinline__ const float* w_uk() const { return (const float*)inp(22); }
    __device__ __forceinline__ const float* w_uv() const { return (const float*)inp(23); }
    __device__ __forceinline__ const float* g_attn() const { return (const float*)inp(24); }
    __device__ __forceinline__ const float* w_out() const { return (const float*)inp(25); }
    __device__ __forceinline__ const float* g_mlp() const { return (const float*)inp(26); }
    __device__ __forceinline__ const float* w_up() const { return (const float*)inp(27); }
    __device__ __forceinline__ const float* w_down() const { return (const float*)inp(28); }
    __device__ __forceinline__ const float* w_adaf() const { return (const float*)inp(29); }
    __device__ __forceinline__ const float* b_adaf() const { return (const float*)inp(30); }
    __device__ __forceinline__ const float* g_fin() const { return (const float*)inp(31); }
};
#define WSP(T, off) ((T*)(F.ws + (off)))

__device__ __forceinline__ int tid_fresh() { int t = threadIdx.x; asm volatile("" : "+v"(t)); return t; }
__device__ __forceinline__ int crow(int r, int hi) { return (r & 3) + 8 * (r >> 2) + 4 * hi; }
template <int MODE> __device__ __forceinline__ int srccol(int n) {
    if (MODE == 1) { if (n < 1536) return n; if (n < 2208) return n + 8; if (n < 2216) return n - 2208 + 1536; return -1; }
    if (MODE == 2) { return n < 512 ? (n >> 6) * 96 + (n & 63) : ((n - 512) >> 5) * 96 + 64 + ((n - 512) & 31); }
    return n;
}
template <int MODE> __device__ __forceinline__ void transpose_item(const float* W, int K, int Nsrc, bf16* WT, int nblk, LAS float* scr, int item, int lane) {
    const int kb = item / nblk, nb = item % nblk, k0 = 64 * kb, n0 = 32 * nb;
    const int sc = srccol<MODE>(n0 + (lane & 31));
#pragma unroll 8
    for (int i = 0; i < 32; ++i) { const int kk = 2 * i + (lane >> 5); scr[kk * 33 + (lane & 31)] = sc >= 0 ? W[(size_t)(k0 + kk) * Nsrc + sc] : 0.f; }
    LDS_WAIT(); asm volatile("" ::: "memory");
    const int c = lane & 7;
#pragma unroll
    for (int j = 0; j < 4; ++j) { const int n = (lane >> 3) + 8 * j; const LAS float* s = scr + (8 * c) * 33 + n;
        v4u o; o.x = pk2(s[0 * 33], s[1 * 33]); o.y = pk2(s[2 * 33], s[3 * 33]); o.z = pk2(s[4 * 33], s[5 * 33]); o.w = pk2(s[6 * 33], s[7 * 33]);
        *(v4u*)(WT + (size_t)(n0 + n) * K + k0 + 8 * c) = o; }
    LDS_WAIT(); asm volatile("" ::: "memory");
}

__device__ __forceinline__ void p0_prologue(Frame& F) {
    const int tid = tid_fresh(), lane = tid & 63;
    const int gw = F.vcu * NWAVES + F.wave, NGW = F.G * NWAVES;
    {
        constexpr int KST = 2064;
        if (tid == 0) *(LAS unsigned*)(F.lds + 139264) = 0u;
        __syncthreads();
        for (int slab = F.vcu; slab < 256; slab += F.G) {
            const int n0 = slab * 32; const bool fin = n0 >= 6144; const float* W = fin ? F.w_adaf() : F.w_ada(); const int Nw = fin ? 2048 : 6144; const int nb = fin ? n0 - 6144 : n0;
            __syncthreads();
            { const int c = tid & 31, kp = tid >> 5;
#pragma unroll 8
              for (int p = 0; p < 32; ++p) { const int k = 2 * (p * 16 + kp); const float w0 = W[(size_t)k * Nw + nb + c], w1 = W[(size_t)(k + 1) * Nw + nb + c]; *(LAS unsigned*)(F.lds + c * KST + k * 2) = pk2(w0, w1); } }
            __syncthreads();
            if (F.wave < 5) {
                const int r32 = lane & 31, hi = lane >> 5, m = 32 * F.wave + r32;
                const float* cp = m < 2 ? F.cprm() + m * 1024 : F.csmp() + (size_t)(m < 130 ? m - 2 : 0) * 1024; const bool valid = m < 130;
                f32x16 acc = {};
#pragma unroll 4
                for (int d0 = 0; d0 < 64; ++d0) {
                    const f32x4 a0 = *(const f32x4*)(cp + 16 * d0 + 8 * hi), a1 = *(const f32x4*)(cp + 16 * d0 + 8 * hi + 4);
                    v4u w; w.x = pk2(siluf(a0[0]), siluf(a0[1])); w.y = pk2(siluf(a0[2]), siluf(a0[3])); w.z = pk2(siluf(a1[0]), siluf(a1[1])); w.w = pk2(siluf(a1[2]), siluf(a1[3]));
                    if (!valid) w = (v4u){0u, 0u, 0u, 0u};
                    const bf16x8 bq = *(const LAS bf16x8*)(F.lds + r32 * KST + (16 * d0 + 8 * hi) * 2);
                    acc = __builtin_amdgcn_mfma_f32_32x32x16_bf16(__builtin_bit_cast(bf16x8, w), bq, acc, 0, 0, 0);
                }
                const float bias = fin ? F.b_adaf()[nb + r32] : F.b_ada()[nb + r32];
                float* O = fin ? WSP(float, WS_ADAF) : WSP(float, WS_ADA); const int No = fin ? 2048 : 6144;
#pragma unroll
                for (int r = 0; r < 16; ++r) { const int mm = 32 * F.wave + crow(r, hi); if (mm < 130) O[(size_t)mm * No + nb + r32] = acc[r] + bias; }
            }
        }
    }
    {
        LAS float* scr = (LAS float*)(F.lds + 67584 + F.wave * 8448);
        constexpr int I_IN = 16 * 72, I_UQ = 6 * 24, I_KV = 4 * 32, I_OUT = 16 * 32, I_UP = 16 * 128, I_DN = 64 * 32;
        constexpr int NITEMS = I_IN + I_UQ + I_KV + I_OUT + I_UP + I_DN;
        LAS unsigned* ctr = (LAS unsigned*)(F.lds + 139264);
        for (;;) {
            unsigned k_ = 0; if (lane == 0) k_ = __hip_atomic_fetch_add(ctr, 1u, __ATOMIC_RELAXED, __HIP_MEMORY_SCOPE_WORKGROUP); k_ = (unsigned)__builtin_amdgcn_readfirstlane((int)k_);
            const int it = F.vcu + (int)k_ * F.G; if (it >= NITEMS) break;
            int r = it;
            if (r < I_IN) { transpose_item<1>(F.w_in(), 1024, 2216, WSP(bf16, WS_WIN), 72, scr, r, lane); continue; } r -= I_IN;
            if (r < I_UQ) { transpose_item<2>(F.w_uq(), 384, 768, WSP(bf16, WS_WUQ), 24, scr, r, lane); continue; } r -= I_UQ;
            if (r < I_KV) { const int nb = r % 32, kb = r / 32;
                if (nb < 16) transpose_item<0>(F.w_uk(), 256, 512, WSP(bf16, WS_WKV), 16, scr, kb * 16 + nb, lane);
                else transpose_item<0>(F.w_uv(), 256, 512, WSP(bf16, WS_WKV) + 512 * 256, 16, scr, kb * 16 + (nb - 16), lane);
                continue; } r -= I_KV;
            if (r < I_OUT) { transpose_item<0>(F.w_out(), 1024, 1024, WSP(bf16, WS_WOUT), 32, scr, r, lane); continue; } r -= I_OUT;
            if (r < I_UP) { transpose_item<0>(F.w_up(), 1024, 4096, WSP(bf16, WS_WUP), 128, scr, r, lane); continue; } r -= I_UP;
            transpose_item<0>(F.w_down(), 4096, 1024, WSP(bf16, WS_WDOWN), 32, scr, r, lane);
        }
    }
    for (int idx = (F.vcu * 512 + tid); idx < 8196 * 16; idx += F.G * 512) {
        const int pos = idx >> 4, i = idx & 15; double rev = (double)pos * ROPE_REV[i]; rev -= __builtin_rint(rev); const float fr = (float)rev;
        WSP(float, WS_CS)[2 * idx] = __builtin_amdgcn_cosf(fr); WSP(float, WS_CS)[2 * idx + 1] = __builtin_amdgcn_sinf(fr);
    }
}

__device__ __forceinline__ const float* xrow_of(Frame& F, int m) { return m < MP ? F.xp() + (size_t)m * DM : F.xs() + (size_t)(m - MP) * DM; }
__device__ __forceinline__ int arow_of(int m) { return m < MP ? (m >> 13) : 2 + ((m - MP) >> 2); }

template <bool BF16OUT> __device__ __forceinline__ void norm_mod_row(const float* xr_, const float* g, const float* sc, const float* sh, void* orow, int lane) {
    const f32x4* xr = (const f32x4*)xr_ + lane;
    f32x4 v[4]; float s2 = 0.f;
#pragma unroll
    for (int j = 0; j < 4; ++j) { v[j] = xr[64 * j]; s2 += (v[j][0] * v[j][0] + v[j][1] * v[j][1]) + (v[j][2] * v[j][2] + v[j][3] * v[j][3]); }
    const float rstd = 1.f / sqrtf(wave_sum(s2) * (1.f / 1024.f) + EPS);
#pragma unroll
    for (int j = 0; j < 4; ++j) { const f32x4 gg = ((const f32x4*)g)[lane + 64 * j], cc = ((const f32x4*)sc)[lane + 64 * j], hh = ((const f32x4*)sh)[lane + 64 * j];
        f32x4 o;
#pragma unroll
        for (int e = 0; e < 4; ++e) o[e] = v[j][e] * rstd * gg[e] * (1.f + cc[e]) + hh[e];
        if (BF16OUT) { v2u w; w.x = pk2(o[0], o[1]); w.y = pk2(o[2], o[3]); ((v2u*)orow)[lane + 64 * j] = w; }
        else ((f32x4*)orow)[lane + 64 * j] = o; }
}

template <bool BF16OUT, class RowFn> __device__ __forceinline__ void norm_mod_rows4(const RowFn& rf, const float* g, int m0, int stride, int lane) {
    f32x4 v[4][4]; float s2[4];
#pragma unroll
    for (int i = 0; i < 4; ++i) { const f32x4* xr = (const f32x4*)rf.x(m0 + i * stride) + lane;
#pragma unroll
        for (int j = 0; j < 4; ++j) v[i][j] = xr[64 * j]; }
#pragma unroll
    for (int i = 0; i < 4; ++i) { float a = 0.f;
#pragma unroll
        for (int j = 0; j < 4; ++j) a += (v[i][j][0] * v[i][j][0] + v[i][j][1] * v[i][j][1]) + (v[i][j][2] * v[i][j][2] + v[i][j][3] * v[i][j][3]);
        s2[i] = a; }
#pragma unroll
    for (int o = 1; o < 64; o <<= 1) {
#pragma unroll
        for (int i = 0; i < 4; ++i) s2[i] += __shfl_xor(s2[i], o); }
#pragma unroll
    for (int i = 0; i < 4; ++i) { const int m = m0 + i * stride; const float rstd = 1.f / sqrtf(s2[i] * (1.f / 1024.f) + EPS); const float* sc = rf.sc(m); const float* sh = rf.sh(m); void* orow = rf.o(m);
#pragma unroll
        for (int j = 0; j < 4; ++j) { const f32x4 gg = ((const f32x4*)g)[lane + 64 * j], cc = ((const f32x4*)sc)[lane + 64 * j], hh = ((const f32x4*)sh)[lane + 64 * j];
            f32x4 o;
#pragma unroll
            for (int e = 0; e < 4; ++e) o[e] = v[i][j][e] * rstd * gg[e] * (1.f + cc[e]) + hh[e];
            if (BF16OUT) { v2u w; w.x = pk2(o[0], o[1]); w.y = pk2(o[2], o[3]); ((v2u*)orow)[lane + 64 * j] = w; }
            else ((f32x4*)orow)[lane + 64 * j] = o; } }
}

__device__ __forceinline__ void p3_row(Frame& F, int row, const int lane) {
    const bf16* PROJ = WSP(bf16, WS_PROJ); const bf16* P = PROJ + (size_t)row * NPROJ;
    const bool isp = row < MP; const int b = row >> 13, rs = row - MP, s = rs >> 2, l = rs & 3; const int t = isp ? (row & 8191) : l;
#pragma unroll
    for (int half = 0; half < 2; ++half) {
        const int c0 = half * 512 + 8 * lane;
        float acc[8], cur[8];
        { const f32x4 b0 = *(const f32x4*)(F.conv_b() + c0), b1 = *(const f32x4*)(F.conv_b() + c0 + 4);
#pragma unroll
          for (int e = 0; e < 4; ++e) { acc[e] = b0[e]; acc[4 + e] = b1[e]; } }
#pragma unroll
        for (int j = 0; j < 4; ++j) {
            const int tt = t - 3 + j; float xin[8];
            if (tt >= 0) { const v4u w = *(const v4u*)(PROJ + (size_t)(row - 3 + j) * NPROJ + 512 + c0);
                xin[0] = bflo(w.x); xin[1] = bfhi(w.x); xin[2] = bflo(w.y); xin[3] = bfhi(w.y); xin[4] = bflo(w.z); xin[5] = bfhi(w.z); xin[6] = bflo(w.w); xin[7] = bfhi(w.w); }
            else if (!isp) { const float* sp = F.sconv() + ((size_t)s * 3 + (3 + tt)) * 1024 + c0; const f32x4 a0 = *(const f32x4*)sp, a1 = *(const f32x4*)(sp + 4);
#pragma unroll
                for (int e = 0; e < 4; ++e) { xin[e] = a0[e]; xin[4 + e] = a1[e]; } }
            else {
#pragma unroll
                for (int e = 0; e < 8; ++e) xin[e] = 0.f; }
            const f32x4 w0 = *(const f32x4*)(F.conv_w() + j * 1024 + c0), w1 = *(const f32x4*)(F.conv_w() + j * 1024 + c0 + 4);
#pragma unroll
            for (int e = 0; e < 4; ++e) { acc[e] += w0[e] * xin[e]; acc[4 + e] += w1[e] * xin[4 + e]; }
            if (j == 3) {
#pragma unroll
                for (int e = 0; e < 8; ++e) cur[e] = xin[e]; }
        }
        v4u o; o.x = pk2(siluf(acc[0]), siluf(acc[1])); o.y = pk2(siluf(acc[2]), siluf(acc[3])); o.z = pk2(siluf(acc[4]), siluf(acc[5])); o.w = pk2(siluf(acc[6]), siluf(acc[7]));
        *(v4u*)(WSP(bf16, WS_XBC) + (size_t)row * 1024 + c0) = o;
        float* cdst = nullptr;
        if (isp) { if (t >= SEQ - 3) cdst = F.out + O_CVP + ((size_t)b * 3 + (t - (SEQ - 3))) * 1024 + c0; }
        else { if (l >= 1) cdst = F.out + O_CVS + ((size_t)s * 3 + (l - 1)) * 1024 + c0; }
        if (cdst) { *(f32x4*)cdst = (f32x4){cur[0], cur[1], cur[2], cur[3]}; *(f32x4*)(cdst + 4) = (f32x4){cur[4], cur[5], cur[6], cur[7]}; }
    }
    if (lane < 8) { const float x = WSP(float, WS_DTRAW)[(size_t)row * 8 + lane] + F.dt_bias()[lane]; WSP(float, WS_DT)[(size_t)row * 8 + lane] = x > 20.f ? x : log1pf(__expf(x)); }
    {
        float v[6]; float s2 = 0.f;
#pragma unroll
        for (int j = 0; j < 3; ++j) { const unsigned w = *(const unsigned*)(P + 1536 + 2 * lane + 128 * j); v[2 * j] = bflo(w); v[2 * j + 1] = bfhi(w); s2 += v[2 * j] * v[2 * j] + v[2 * j + 1] * v[2 * j + 1]; }
        const float rstd = 1.f / sqrtf(wave_sum(s2) * (1.f / 384.f) + EPS);
#pragma unroll
        for (int j = 0; j < 3; ++j) { const int c = 2 * lane + 128 * j; *(unsigned*)(WSP(bf16, WS_QN) + (size_t)row * 384 + c) = pk2(v[2 * j] * rstd * F.g_q()[c], v[2 * j + 1] * rstd * F.g_q()[c + 1]); }
    }
    {
        const v2u w = *(const v2u*)(P + 1920 + 4 * lane); float v[4] = {bflo(w.x), bfhi(w.x), bflo(w.y), bfhi(w.y)};
        const float s2 = (v[0] * v[0] + v[1] * v[1]) + (v[2] * v[2] + v[3] * v[3]);
        const float rstd = 1.f / sqrtf(wave_sum(s2) * (1.f / 256.f) + EPS);
        const f32x4 g = *(const f32x4*)(F.g_kv() + 4 * lane); f32x4 o;
#pragma unroll
        for (int e = 0; e < 4; ++e) o[e] = v[e] * rstd * g[e];
        float* od = isp ? F.out + O_KVP + (size_t)row * 256 + 4 * lane : F.out + O_KVS + (size_t)rs * 256 + 4 * lane;
        *(f32x4*)od = o;
        v2u q; q.x = pk2(o[0], o[1]); q.y = pk2(o[2], o[3]); *(v2u*)(WSP(bf16, WS_CKV) + (size_t)row * 256 + 4 * lane) = q;
    }
    if (lane < 32) {
        const int i = lane & 15; const float x1 = bf2f(P[2176 + i]), x2 = bf2f(P[2176 + 16 + i]);
        const int pos = isp ? t : SEQ + l; const float c = WSP(float, WS_CS)[((size_t)pos * 16 + i) * 2], sn = WSP(float, WS_CS)[((size_t)pos * 16 + i) * 2 + 1];
        const float val = lane < 16 ? x1 * c - x2 * sn : x1 * sn + x2 * c;
        if (isp) { F.out[O_KRP + (size_t)row * 32 + lane] = val; const bf16 vb = (bf16)f2bf(val);
#pragma unroll
            for (int h = 0; h < 8; ++h) WSP(bf16, WS_KP)[((((size_t)(b * 8 + h)) * 128 + (t >> 6)) * 12 + 8 + (lane >> 3)) * 512 + (t & 63) * 8 + (lane & 7)] = vb; }
        else { F.out[O_KRS + (size_t)rs * 32 + lane] = val; WSP(bf16, WS_KRS)[(size_t)rs * 32 + lane] = (bf16)f2bf(val); }
    }
}

__device__ __forceinline__ void ssd_sample_unit(Frame& F, int u) {
    const int tid = tid_fresh(); const int s = u >> 3, h = u & 7, g = h >> 2, p = tid >> 3, nq = tid & 7;
    const float a = -__expf(F.a_log()[h]);
    const bf16* XBC = WSP(bf16, WS_XBC); const float* DT = WSP(float, WS_DT); float* Y = WSP(float, WS_YSSD);
    const size_t so = ((size_t)(s * 8 + h) * 64 + p) * 128 + 16 * nq;
    float st[16];
#pragma unroll
    for (int j = 0; j < 4; ++j) { const f32x4 v = *(const f32x4*)(F.sssm() + so + 4 * j); st[4 * j] = v[0]; st[4 * j + 1] = v[1]; st[4 * j + 2] = v[2]; st[4 * j + 3] = v[3]; }
#pragma unroll
    for (int t = 0; t < 4; ++t) {
        const size_t row = (size_t)MP + s * 4 + t; const float dtv = DT[row * 8 + h], xv = bf2f(XBC[row * 1024 + h * 64 + p]);
        const v4u b0 = *(const v4u*)(XBC + row * 1024 + 512 + g * 128 + 16 * nq), b1 = *(const v4u*)(XBC + row * 1024 + 512 + g * 128 + 16 * nq + 8);
        const v4u c0 = *(const v4u*)(XBC + row * 1024 + 768 + g * 128 + 16 * nq), c1 = *(const v4u*)(XBC + row * 1024 + 768 + g * 128 + 16 * nq + 8);
        const unsigned bw[8] = {b0.x, b0.y, b0.z, b0.w, b1.x, b1.y, b1.z, b1.w}, cw[8] = {c0.x, c0.y, c0.z, c0.w, c1.x, c1.y, c1.z, c1.w};
        const float dA = __expf(dtv * a), dx = dtv * xv; float part = 0.f;
#pragma unroll
        for (int j = 0; j < 8; ++j) { st[2 * j] = st[2 * j] * dA + dx * bflo(bw[j]); st[2 * j + 1] = st[2 * j + 1] * dA + dx * bfhi(bw[j]); part += st[2 * j] * bflo(cw[j]) + st[2 * j + 1] * bfhi(cw[j]); }
        part += __shfl_xor(part, 1); part += __shfl_xor(part, 2); part += __shfl_xor(part, 4);
        if (nq == 0) Y[row * 512 + h * 64 + p] = part;
    }
#pragma unroll
    for (int j = 0; j < 4; ++j) *(f32x4*)(F.out + O_SSS + so + 4 * j) = (f32x4){st[4 * j], st[4 * j + 1], st[4 * j + 2], st[4 * j + 3]};
}

__device__ __forceinline__ unsigned cvtpk_s(float lo, float hi) { typedef float f2 __attribute__((ext_vector_type(2))); typedef __bf16 b2 __attribute__((ext_vector_type(2))); f2 v = {lo, hi}; b2 b = __builtin_convertvector(v, b2); return __builtin_bit_cast(unsigned, b); }
__device__ __forceinline__ float rowmax32(const f32x16& p0, const f32x16& p1) {
    float a = __builtin_fmaxf(__builtin_fmaxf(p0[0], p0[1]), p1[0]), b = __builtin_fmaxf(__builtin_fmaxf(p0[2], p0[3]), p1[1]); a = __builtin_fmaxf(__builtin_fmaxf(a, p1[2]), p1[3]);
#pragma unroll
    for (int r = 4; r < 16; r += 4) { a = __builtin_fmaxf(__builtin_fmaxf(a, p0[r]), p0[r + 1]); b = __builtin_fmaxf(__builtin_fmaxf(b, p0[r + 2]), p0[r + 3]); a = __builtin_fmaxf(__builtin_fmaxf(a, p1[r]), p1[r + 1]); b = __builtin_fmaxf(__builtin_fmaxf(b, p1[r + 2]), p1[r + 3]); }
    a = __builtin_fmaxf(a, b);
    { auto rr = __builtin_amdgcn_permlane32_swap(__float_as_uint(a), __float_as_uint(a), false, false); return fmaxf(__uint_as_float(rr[0]), __uint_as_float(rr[1])); }
}
__device__ __forceinline__ void pv_block(f32x16& o, unsigned vb, bf16x8 pa0, bf16x8 pa1, bf16x8 pa2, bf16x8 pa3) {
    s16x4 lo[4], hi[4];
#pragma unroll
    for (int ks = 0; ks < 4; ++ks) {
        asm volatile("ds_read_b64_tr_b16 %0,%1 offset:%c2" : "=&v"(lo[ks]) : "v"(vb), "i"(ks * 1024) : "memory");
        asm volatile("ds_read_b64_tr_b16 %0,%1 offset:%c2" : "=&v"(hi[ks]) : "v"(vb), "i"(ks * 1024 + 512) : "memory"); }
    asm volatile("s_waitcnt lgkmcnt(0)" ::: "memory"); __builtin_amdgcn_sched_barrier(0);
#define PKV(k) (bf16x8){lo[k][0], lo[k][1], lo[k][2], lo[k][3], hi[k][0], hi[k][1], hi[k][2], hi[k][3]}
    o = __builtin_amdgcn_mfma_f32_32x32x16_bf16(pa0, PKV(0), o, 0, 0, 0);
    o = __builtin_amdgcn_mfma_f32_32x32x16_bf16(pa1, PKV(1), o, 0, 0, 0);
    o = __builtin_amdgcn_mfma_f32_32x32x16_bf16(pa2, PKV(2), o, 0, 0, 0);
    o = __builtin_amdgcn_mfma_f32_32x32x16_bf16(pa3, PKV(3), o, 0, 0, 0);
#undef PKV
}
__device__ __forceinline__ void softmax_step(f32x16& p0, f32x16& p1, float& m, float& l, float& alpha, bf16x8& pa0, bf16x8& pa1, bf16x8& pa2, bf16x8& pa3) {
    const float rm = rowmax32(p0, p1); const float mn = fmaxf(m, rm);
    alpha = __builtin_amdgcn_exp2f(m - mn); m = mn;
    typedef float f32x2_ __attribute__((ext_vector_type(2)));
    const f32x2_ mn2 = {mn, mn}; f32x2_ acc2 = {0.f, 0.f};
#pragma unroll
    for (int r = 0; r < 16; r += 2) { f32x2_ d0 = (f32x2_){p0[r], p0[r + 1]} - mn2, d1 = (f32x2_){p1[r], p1[r + 1]} - mn2;
        d0.x = __builtin_amdgcn_exp2f(d0.x); d0.y = __builtin_amdgcn_exp2f(d0.y); d1.x = __builtin_amdgcn_exp2f(d1.x); d1.y = __builtin_amdgcn_exp2f(d1.y);
        acc2 += d0; acc2 += d1; p0[r] = d0.x; p0[r + 1] = d0.y; p1[r] = d1.x; p1[r + 1] = d1.y; }
    l = l * alpha + (acc2.x + acc2.y);
    v4u w0, w1, w2, w3;
    w0.x = cvtpk_s(p0[0], p0[1]); w0.y = cvtpk_s(p0[2], p0[3]); w0.z = cvtpk_s(p0[4], p0[5]); w0.w = cvtpk_s(p0[6], p0[7]);
    w1.x = cvtpk_s(p0[8], p0[9]); w1.y = cvtpk_s(p0[10], p0[11]); w1.z = cvtpk_s(p0[12], p0[13]); w1.w = cvtpk_s(p0[14], p0[15]);
    w2.x = cvtpk_s(p1[0], p1[1]); w2.y = cvtpk_s(p1[2], p1[3]); w2.z = cvtpk_s(p1[4], p1[5]); w2.w = cvtpk_s(p1[6], p1[7]);
    w3.x = cvtpk_s(p1[8], p1[9]); w3.y = cvtpk_s(p1[10], p1[11]); w3.z = cvtpk_s(p1[12], p1[13]); w3.w = cvtpk_s(p1[14], p1[15]);
    pa0 = __builtin_bit_cast(bf16x8, w0); pa1 = __builtin_bit_cast(bf16x8, w1); pa2 = __builtin_bit_cast(bf16x8, w2); pa3 = __builtin_bit_cast(bf16x8, w3);
}

constexpr int AP_K = 0, AP_V = 24576, AP_WS = 40960;
__device__ __forceinline__ void attn_prompt_unit(Frame& F, int bh, int qb) {
    const int tid = tid_fresh(), lane = tid & 63, wid = F.wave, r32 = lane & 31, hi = lane >> 5;
    const int b = bh >> 3, h = bh & 7, q0 = qb * 256, NT = 4 * (qb + 1), qrel = wid * 32 + r32;
    const bf16* Qw = WSP(bf16, WS_QP) + ((size_t)bh * SEQ + q0 + wid * 32 + r32) * 96 + hi * 8;
    bf16x8 qr[6];
#pragma unroll
    for (int d0 = 0; d0 < 6; ++d0) qr[d0] = *(const bf16x8*)(Qw + d0 * 16);
    const v4u* Kg = (const v4u*)(WSP(bf16, WS_KP) + (size_t)bh * 128 * 6144);
    const v4u* Vg = (const v4u*)(WSP(bf16, WS_VP) + (size_t)bh * 128 * 4096);
    LAS unsigned char* L = F.lds;
    LAS float* wsf = (LAS float*)(L + AP_WS) + wid * 64;
    const unsigned vb0 = (unsigned)(size_t)(L + AP_V) + ((lane >> 4) & 1) * 32 + (lane & 3) * 8 + (4 * hi + ((lane & 15) >> 2)) * 64;
    v4u k0r = Kg[tid], k1r = (tid < 256) ? Kg[512 + tid] : (v4u){0u, 0u, 0u, 0u}, v0r = Vg[tid];
    float m = -1e30f, l = 0.f; f32x16 o0 = {}, o1 = {};
    for (int t = 0; t < NT; ++t) {
        const int buf = t & 1;
        LAS v4u* Kb = (LAS v4u*)(L + AP_K + buf * 12288); LAS v4u* Vb = (LAS v4u*)(L + AP_V + buf * 8192);
        Kb[tid] = k0r; if (tid < 256) Kb[512 + tid] = k1r; Vb[tid] = v0r;
        __syncthreads();
        if (t + 1 < NT) { k0r = Kg[(size_t)(t + 1) * 768 + tid]; if (tid < 256) k1r = Kg[(size_t)(t + 1) * 768 + 512 + tid]; v0r = Vg[(size_t)(t + 1) * 512 + tid]; }
        const int jb = t - (NT - 4);
        if (jb >= 0 && wid * 32 + 31 < 64 * jb) continue;
        const LAS unsigned char* kp = L + AP_K + buf * 12288 + hi * 1024 + r32 * 16;
        f32x16 p0 = {}, p1 = {};
#pragma unroll
        for (int d0 = 0; d0 < 6; ++d0) { const bf16x8 a0 = *(const LAS bf16x8*)(kp + d0 * 2048), a1 = *(const LAS bf16x8*)(kp + d0 * 2048 + 512);
            p0 = __builtin_amdgcn_mfma_f32_32x32x16_bf16(a0, qr[d0], p0, 0, 0, 0); p1 = __builtin_amdgcn_mfma_f32_32x32x16_bf16(a1, qr[d0], p1, 0, 0, 0); }
        if (jb >= 0) {
#pragma unroll
            for (int r = 0; r < 16; ++r) { const int kv = 64 * jb + crow(r, hi); if (kv > qrel) p0[r] = -INFINITY; if (kv + 32 > qrel) p1[r] = -INFINITY; } }
        float alpha; bf16x8 pa0, pa1, pa2, pa3;
        softmax_step(p0, p1, m, l, alpha, pa0, pa1, pa2, pa3);
        if (hi == 0) wsf[r32] = alpha;
        LDS_WAIT();
#pragma unroll
        for (int r = 0; r < 16; ++r) { const float f = wsf[crow(r, hi)]; o0[r] *= f; o1[r] *= f; }
        LDS_WAIT();
        const unsigned vb = vb0 + buf * 8192;
        pv_block(o0, vb, pa0, pa1, pa2, pa3);
        pv_block(o1, vb + 4096, pa0, pa1, pa2, pa3);
    }
    l += __shfl_xor(l, 32);
    if (hi == 0) wsf[32 + r32] = 1.f / l;
    LDS_WAIT();
    bf16* Ow = WSP(bf16, WS_OATT) + ((size_t)b * SEQ + q0 + wid * 32) * 512 + h * 64 + r32;
#pragma unroll
    for (int r = 0; r < 16; ++r) { const int qrow = crow(r, hi); const float f = wsf[32 + qrow]; Ow[(size_t)qrow * 512] = (bf16)f2bf(o0[r] * f); Ow[(size_t)qrow * 512 + 32] = (bf16)f2bf(o1[r] * f); }
    LDS_WAIT();
    __syncthreads();
}

constexpr int AD_KCS = 1040, AD_VDS = 4160, AD_QRS = 592;
constexpr int AD_K = 0, AD_V = 36 * AD_KCS  , AD_Q = AD_V + 8 * AD_VDS  , AD_WS = AD_Q + 32 * AD_QRS  , AD_QN = AD_WS + 8 * 256  ;
__device__ __forceinline__ void attn_decode_unit(Frame& F, int s, int split) {
    const int tid = tid_fresh(), lane = tid & 63, wid = F.wave, r32 = lane & 31, hi = lane >> 5;
    LAS unsigned char* L = F.lds;
    LAS float* wsf = (LAS float*)(L + AD_WS) + wid * 64;
    {
        LAS float* qn = (LAS float*)(L + AD_QN);
        for (int i = tid; i < 2048; i += 512) qn[i] = bf2f(WSP(bf16, WS_QSN)[(size_t)s * 2048 + i]);
        __syncthreads();
        const int r = tid & 255, lh = tid >> 8; const bf16* WK = WSP(bf16, WS_WKV);
        for (int h = 0; h < 8; ++h) { float a0 = 0.f, a1 = 0.f;
#pragma unroll 8
            for (int d = 0; d < 64; ++d) { const float w = bf2f(WK[(size_t)(h * 64 + d) * 256 + r]); a0 += w * qn[(2 * lh) * 512 + h * 64 + d]; a1 += w * qn[(2 * lh + 1) * 512 + h * 64 + d]; }
            *(LAS bf16*)(L + AD_Q + ((2 * lh) * 8 + h) * AD_QRS + r * 2) = (bf16)f2bf(a0 * SCL2); *(LAS bf16*)(L + AD_Q + ((2 * lh + 1) * 8 + h) * AD_QRS + r * 2) = (bf16)f2bf(a1 * SCL2); }
        for (int i = tid; i < 1024; i += 512) { const int row = i >> 5, j = i & 31; *(LAS bf16*)(L + AD_Q + row * AD_QRS + (256 + j) * 2) = WSP(bf16, WS_QSR)[((size_t)s * 32 + row) * 32 + j]; }
        __syncthreads();
    }
    const unsigned vb0 = (unsigned)(size_t)(L + AD_V) + wid * AD_VDS + ((lane >> 4) & 1) * 32 + (lane & 3) * 8 + (4 * hi + ((lane & 15) >> 2)) * 64;
    const LAS unsigned char* kp = L + AD_K + hi * AD_KCS + r32 * 16;
    const LAS unsigned char* qp = L + AD_Q + r32 * AD_QRS + hi * 16;
    float m = -1e30f, l = 0.f; f32x16 o = {};
    const int NTL = 64 + (split == 1 ? 1 : 0);
    f32x4 kreg[8], rreg;
#define AD_LOAD(tile) do { const int pg_ = F.ptab()[s * 64 + split * 32 + ((tile) >> 1)]; const size_t rb_ = (size_t)pg_ * 128 + ((tile) & 1) * 64; \
        _Pragma("unroll") for (int j = 0; j < 8; ++j) { const int g_ = j * 512 + tid; kreg[j] = *(const f32x4*)(F.cache_kv() + (rb_ + (g_ >> 6)) * 256 + (g_ & 63) * 4); } \
        rreg = *(const f32x4*)(F.cache_kr() + (rb_ + (tid >> 3)) * 32 + (tid & 7) * 4); } while (0)
    AD_LOAD(0);
    for (int t = 0; t < NTL; ++t) {
        __syncthreads();
        if (t < 64) {
#pragma unroll
            for (int j = 0; j < 8; ++j) { const int g = j * 512 + tid, key = g >> 6, i = g & 63; v2u w; w.x = pk2(kreg[j][0], kreg[j][1]); w.y = pk2(kreg[j][2], kreg[j][3]);
                *(LAS v2u*)(L + AD_K + (i >> 1) * AD_KCS + key * 16 + (i & 1) * 8) = w;
                *(LAS v2u*)(L + AD_V + (i >> 3) * AD_VDS + (key >> 4) * 1024 + (key & 15) * 64 + (i & 7) * 8) = w; }
            { const int key = tid >> 3, i = tid & 7; v2u w; w.x = pk2(rreg[0], rreg[1]); w.y = pk2(rreg[2], rreg[3]); *(LAS v2u*)(L + AD_K + (32 + (i >> 1)) * AD_KCS + key * 16 + (i & 1) * 8) = w; }
        } else {
#pragma unroll
            for (int j = 0; j < 8; ++j) { const int g = j * 512 + tid, key = g >> 6, i = g & 63; v2u w = {0u, 0u}; if (key < 4) w = *(const v2u*)(WSP(bf16, WS_CKV) + ((size_t)MP + s * 4 + key) * 256 + 4 * i);
                *(LAS v2u*)(L + AD_K + (i >> 1) * AD_KCS + key * 16 + (i & 1) * 8) = w;
                *(LAS v2u*)(L + AD_V + (i >> 3) * AD_VDS + (key >> 4) * 1024 + (key & 15) * 64 + (i & 7) * 8) = w; }
            { const int key = tid >> 3, i = tid & 7; v2u w = {0u, 0u}; if (key < 4) w = *(const v2u*)(WSP(bf16, WS_KRS) + ((size_t)s * 4 + key) * 32 + 4 * i); *(LAS v2u*)(L + AD_K + (32 + (i >> 1)) * AD_KCS + key * 16 + (i & 1) * 8) = w; }
        }
        __syncthreads();
        if (t + 1 < 64) AD_LOAD(t + 1);
        f32x16 p0 = {}, p1 = {};
#pragma unroll 6
        for (int d0 = 0; d0 < 18; ++d0) { const bf16x8 a0 = *(const LAS bf16x8*)(kp + d0 * 2 * AD_KCS), a1 = *(const LAS bf16x8*)(kp + d0 * 2 * AD_KCS + 512), bq = *(const LAS bf16x8*)(qp + d0 * 32);
            p0 = __builtin_amdgcn_mfma_f32_32x32x16_bf16(a0, bq, p0, 0, 0, 0); p1 = __builtin_amdgcn_mfma_f32_32x32x16_bf16(a1, bq, p1, 0, 0, 0); }
        if (t == 64) {
#pragma unroll
            for (int r = 0; r < 16; ++r) { if (crow(r, hi) > (r32 >> 3)) p0[r] = -INFINITY; p1[r] = -INFINITY; } }
        float alpha; bf16x8 pa0, pa1, pa2, pa3;
        softmax_step(p0, p1, m, l, alpha, pa0, pa1, pa2, pa3);
        if (hi == 0) wsf[r32] = alpha;
        LDS_WAIT();
#pragma unroll
        for (int r = 0; r < 16; ++r) o[r] *= wsf[crow(r, hi)];
        LDS_WAIT();
        pv_block(o, vb0, pa0, pa1, pa2, pa3);
    }
#undef AD_LOAD
    l += __shfl_xor(l, 32);
    float* OP = WSP(float, WS_OPART) + ((size_t)(s * 2 + split) * 32) * 256 + wid * 32 + r32;
#pragma unroll
    for (int r = 0; r < 16; ++r) OP[(size_t)crow(r, hi) * 256] = o[r];
    if (wid == 0 && hi == 0) { float* ML = WSP(float, WS_ML) + ((size_t)(s * 2 + split) * 32 + r32) * 2; ML[0] = m; ML[1] = l; }
    __syncthreads();
}

__device__ __forceinline__ void p6_row(Frame& F, int row, const int lane) {
    bf16* A = WSP(bf16, WS_AMIX) + (size_t)row * 1024;
    {
        const float* y = WSP(float, WS_YSSD) + (size_t)row * 512; const bf16* z = WSP(bf16, WS_PROJ) + (size_t)row * NPROJ;
        float v[8]; float s2 = 0.f;
#pragma unroll
        for (int j = 0; j < 2; ++j) { f32x4 yy = *(const f32x4*)(y + 4 * lane + 256 * j); const v2u zz = *(const v2u*)(z + 4 * lane + 256 * j);
            const v2u xx = *(const v2u*)(WSP(bf16, WS_XBC) + (size_t)row * 1024 + 4 * lane + 256 * j); const float Dh = F.d_skip()[(4 * lane + 256 * j) >> 6];
            yy[0] += Dh * bflo(xx.x); yy[1] += Dh * bfhi(xx.x); yy[2] += Dh * bflo(xx.y); yy[3] += Dh * bfhi(xx.y);
            v[4 * j] = yy[0] * siluf(bflo(zz.x)); v[4 * j + 1] = yy[1] * siluf(bfhi(zz.x)); v[4 * j + 2] = yy[2] * siluf(bflo(zz.y)); v[4 * j + 3] = yy[3] * siluf(bfhi(zz.y)); }
#pragma unroll
        for (int e = 0; e < 8; ++e) s2 += v[e] * v[e];
        const float rstd = 1.f / sqrtf(wave_sum(s2) * (1.f / 512.f) + EPS);
#pragma unroll
        for (int j = 0; j < 2; ++j) { const f32x4 g = *(const f32x4*)(F.g_ssd() + 4 * lane + 256 * j); v2u w; w.x = pk2(v[4 * j] * rstd * g[0], v[4 * j + 1] * rstd * g[1]); w.y = pk2(v[4 * j + 2] * rstd * g[2], v[4 * j + 3] * rstd * g[3]);
            *(v2u*)(A + 4 * lane + 256 * j) = w; }
    }
    float v[8];
    { const bf16* o = WSP(bf16, WS_OATT) + (size_t)row * 512;
#pragma unroll
      for (int j = 0; j < 2; ++j) { const v2u w = *(const v2u*)(o + 4 * lane + 256 * j); v[4 * j] = bflo(w.x); v[4 * j + 1] = bfhi(w.x); v[4 * j + 2] = bflo(w.y); v[4 * j + 3] = bfhi(w.y); } }
    float s2 = 0.f;
#pragma unroll
    for (int e = 0; e < 8; ++e) s2 += v[e] * v[e];
    const float rstd = 1.f / sqrtf(wave_sum(s2) * (1.f / 512.f) + EPS);
#pragma unroll
    for (int j = 0; j < 2; ++j) { const f32x4 g = *(const f32x4*)(F.g_attn() + 4 * lane + 256 * j); v2u w; w.x = pk2(v[4 * j] * rstd * g[0], v[4 * j + 1] * rstd * g[1]); w.y = pk2(v[4 * j + 2] * rstd * g[2], v[4 * j + 3] * rstd * g[3]);
        *(v2u*)(A + 512 + 4 * lane + 256 * j) = w; }
}

__device__ __forceinline__ void sample_ov_tile(Frame& F, int tile, const int lane) {
    const int r32 = lane & 31, hi = lane >> 5, rb = tile >> 4, h = (tile >> 1) & 7, cb = tile & 1;
    const int rs = 32 * rb + r32, s = rs >> 2, q = (rs & 3) * 8 + h;
    const float* ml0 = WSP(float, WS_ML) + ((size_t)(s * 2 + 0) * 32 + q) * 2; const float* ml1 = WSP(float, WS_ML) + ((size_t)(s * 2 + 1) * 32 + q) * 2;
    const float m0 = ml0[0], l0 = ml0[1], m1 = ml1[0], l1 = ml1[1], M = fmaxf(m0, m1), e0 = __builtin_amdgcn_exp2f(m0 - M), e1 = __builtin_amdgcn_exp2f(m1 - M), inv = 1.f / (e0 * l0 + e1 * l1), w0 = e0 * inv, w1 = e1 * inv;
    const float* P0 = WSP(float, WS_OPART) + ((size_t)(s * 2 + 0) * 32 + q) * 256 + 8 * hi; const float* P1 = WSP(float, WS_OPART) + ((size_t)(s * 2 + 1) * 32 + q) * 256 + 8 * hi;
    const bf16* Bw = WSP(bf16, WS_WKV) + (size_t)(512 + h * 64 + 32 * cb + r32) * 256 + 8 * hi;
    f32x16 acc = {};
#pragma unroll 4
    for (int d0 = 0; d0 < 16; ++d0) {
        const f32x4 a0 = *(const f32x4*)(P0 + 16 * d0), a1 = *(const f32x4*)(P0 + 16 * d0 + 4), b0 = *(const f32x4*)(P1 + 16 * d0), b1 = *(const f32x4*)(P1 + 16 * d0 + 4);
        v4u w; w.x = pk2(a0[0] * w0 + b0[0] * w1, a0[1] * w0 + b0[1] * w1); w.y = pk2(a0[2] * w0 + b0[2] * w1, a0[3] * w0 + b0[3] * w1);
        w.z = pk2(a1[0] * w0 + b1[0] * w1, a1[1] * w0 + b1[1] * w1); w.w = pk2(a1[2] * w0 + b1[2] * w1, a1[3] * w0 + b1[3] * w1);
        const bf16x8 bq = *(const bf16x8*)(Bw + 16 * d0);
        acc = __builtin_amdgcn_mfma_f32_32x32x16_bf16(__builtin_bit_cast(bf16x8, w), bq, acc, 0, 0, 0);
    }
    bf16* O = WSP(bf16, WS_OATT) + ((size_t)MP + 32 * rb) * 512 + h * 64 + 32 * cb + r32;
#pragma unroll
    for (int r = 0; r < 16; ++r) O[(size_t)crow(r, hi) * 512] = (bf16)f2bf(acc[r]);
}

constexpr int SA_BKS = 2064, SA_BVS = 4112, SA_XVS = 4112;
constexpr int SA_BK = 0, SA_BV = 16 * SA_BKS  , SA_XV = SA_BV + 8 * SA_BVS  , SA_TAB = SA_XV + 16 * SA_XVS  ;
static_assert(SA_TAB + 6144 <= PHASE_LDS, "SSD chunk LDS map");
__device__ __forceinline__ bf16x8 tr_frag(unsigned addr) {
    s16x4 lo, hi;
    asm volatile("ds_read_b64_tr_b16 %0,%1" : "=&v"(lo) : "v"(addr) : "memory");
    asm volatile("ds_read_b64_tr_b16 %0,%1 offset:512" : "=&v"(hi) : "v"(addr) : "memory");
    asm volatile("s_waitcnt lgkmcnt(0)" ::: "memory");
    return (bf16x8){lo[0], lo[1], lo[2], lo[3], hi[0], hi[1], hi[2], hi[3]};
}
__device__ __forceinline__ void ssd_chunk_unit(Frame& F, int u) {
    const int tid = tid_fresh(), lane = tid & 63, wid = F.wave, r32 = lane & 31, hi = lane >> 5;
    const int b = u >> 7, c = (u >> 1) & 63, g = u & 1; const size_t row0 = (size_t)b * SEQ + c * 128;
    LAS unsigned char* L = F.lds; const bf16* XBC = WSP(bf16, WS_XBC);
    LAS float* T_acs = (LAS float*)(L + SA_TAB); LAS float* T_dt = T_acs + 512; LAS float* T_te = T_acs + 1024;
    __syncthreads();
#pragma unroll
    for (int k = 0; k < 4; ++k) { const int q = k * 512 + tid, j = q >> 4, c16 = q & 15; const v4u w = *(const v4u*)(XBC + (row0 + j) * 1024 + 512 + g * 128 + 8 * c16);
        *(LAS v4u*)(L + SA_BK + c16 * SA_BKS + j * 16) = w;
        *(LAS v4u*)(L + SA_BV + ((c16 >> 2) * 2 + (j >> 6)) * SA_BVS + ((j & 63) >> 4) * 1024 + (j & 15) * 64 + (c16 & 3) * 16) = w; }
#pragma unroll
    for (int k = 0; k < 8; ++k) { const int q = k * 512 + tid, j = q >> 5, c32 = q & 31; const v4u w = *(const v4u*)(XBC + (row0 + j) * 1024 + g * 256 + 8 * c32);
        *(LAS v4u*)(L + SA_XV + (((c32 >> 3) * 2 + ((c32 >> 2) & 1)) * 2 + (j >> 6)) * SA_XVS + ((j & 63) >> 4) * 1024 + (j & 15) * 64 + (c32 & 3) * 16) = w; }
    if (wid < 4) {
        const int hh = wid, h = g * 4 + hh; const float a = -__expf(F.a_log()[h]); const float* DT = WSP(float, WS_DT);
        const float d0 = DT[(row0 + 2 * lane) * 8 + h], d1 = DT[(row0 + 2 * lane + 1) * 8 + h];
        const float v0 = d0 * a, v1 = d1 * a, s = v0 + v1; float incl = s;
#pragma unroll
        for (int o = 1; o < 64; o <<= 1) { const float t = __shfl_up(incl, o); if (lane >= o) incl += t; }
        const float a0 = incl - s + v0, a1 = incl, tot = __shfl(incl, 63);
        T_acs[hh * 128 + 2 * lane] = a0; T_acs[hh * 128 + 2 * lane + 1] = a1; T_dt[hh * 128 + 2 * lane] = d0; T_dt[hh * 128 + 2 * lane + 1] = d1;
        T_te[hh * 128 + 2 * lane] = __expf(tot - a0) * d0; T_te[hh * 128 + 2 * lane + 1] = __expf(tot - a1) * d1;
        WSP(float, WS_EACS)[(row0 + 2 * lane) * 8 + h] = __expf(a0); WSP(float, WS_EACS)[(row0 + 2 * lane + 1) * 8 + h] = __expf(a1);
        if (lane == 63) WSP(float, WS_CD)[((size_t)b * 64 + c) * 8 + h] = __expf(incl);
    }
    __syncthreads();
    const int hh = wid >> 1, h = g * 4 + hh;
    const unsigned lanepart = ((lane >> 4) & 1) * 32 + (lane & 3) * 8 + (4 * hi + ((lane & 15) >> 2)) * 64;
    const unsigned lbase = (unsigned)(size_t)L;
#pragma unroll 1
    for (int ibi = 0; ibi < 2; ++ibi) {
        const int ib = (wid & 1) ? (ibi == 0 ? 1 : 2) : (ibi == 0 ? 0 : 3);
        const int i = 32 * ib + r32;
        bf16x8 cq[8];
#pragma unroll
        for (int d0 = 0; d0 < 8; ++d0) cq[d0] = *(const bf16x8*)(XBC + (row0 + i) * 1024 + 768 + g * 128 + 16 * d0 + 8 * hi);
        const float ai = T_acs[hh * 128 + i];
        f32x16 o0 = {}, o1 = {};
        for (int jt = 0; jt <= (ib >> 1); ++jt) {
            const LAS unsigned char* kp = L + SA_BK + hi * SA_BKS + (64 * jt + r32) * 16;
            f32x16 p0 = {}, p1 = {};
#pragma unroll
            for (int d0 = 0; d0 < 8; ++d0) { const bf16x8 a0 = *(const LAS bf16x8*)(kp + d0 * 2 * SA_BKS), a1 = *(const LAS bf16x8*)(kp + d0 * 2 * SA_BKS + 512);
                p0 = __builtin_amdgcn_mfma_f32_32x32x16_bf16(a0, cq[d0], p0, 0, 0, 0); p1 = __builtin_amdgcn_mfma_f32_32x32x16_bf16(a1, cq[d0], p1, 0, 0, 0); }
#pragma unroll
            for (int r = 0; r < 16; ++r) { const int j = 64 * jt + crow(r, hi), j2 = j + 32;
                p0[r] *= (j <= i) ? __expf(ai - T_acs[hh * 128 + j]) * T_dt[hh * 128 + j] : 0.f;
                p1[r] *= (j2 <= i) ? __expf(ai - T_acs[hh * 128 + j2]) * T_dt[hh * 128 + j2] : 0.f; }
            v4u w0, w1, w2, w3;
            w0.x = cvtpk_s(p0[0], p0[1]); w0.y = cvtpk_s(p0[2], p0[3]); w0.z = cvtpk_s(p0[4], p0[5]); w0.w = cvtpk_s(p0[6], p0[7]);
            w1.x = cvtpk_s(p0[8], p0[9]); w1.y = cvtpk_s(p0[10], p0[11]); w1.z = cvtpk_s(p0[12], p0[13]); w1.w = cvtpk_s(p0[14], p0[15]);
            w2.x = cvtpk_s(p1[0], p1[1]); w2.y = cvtpk_s(p1[2], p1[3]); w2.z = cvtpk_s(p1[4], p1[5]); w2.w = cvtpk_s(p1[6], p1[7]);
            w3.x = cvtpk_s(p1[8], p1[9]); w3.y = cvtpk_s(p1[10], p1[11]); w3.z = cvtpk_s(p1[12], p1[13]); w3.w = cvtpk_s(p1[14], p1[15]);
            const bf16x8 pa0 = __builtin_bit_cast(bf16x8, w0), pa1 = __builtin_bit_cast(bf16x8, w1), pa2 = __builtin_bit_cast(bf16x8, w2), pa3 = __builtin_bit_cast(bf16x8, w3);
            const unsigned vb = lbase + SA_XV + ((hh * 2 + 0) * 2 + jt) * SA_XVS + lanepart;
            pv_block(o0, vb, pa0, pa1, pa2, pa3);
            pv_block(o1, vb + 2 * SA_XVS, pa0, pa1, pa2, pa3);
        }
        float* Y = WSP(float, WS_YSSD) + (row0 + 32 * ib) * 512 + h * 64 + r32;
#pragma unroll
        for (int r = 0; r < 16; ++r) { Y[(size_t)crow(r, hi) * 512] = o0[r]; Y[(size_t)crow(r, hi) * 512 + 32] = o1[r]; }
    }
    {
        const int pb = wid & 1;
        f32x16 acc[4] = {};
#pragma unroll 2
        for (int ks = 0; ks < 8; ++ks) { const int jt = ks >> 2, rg = ks & 3, jb = 64 * jt + 16 * rg;
            const bf16x8 xa = tr_frag(lbase + SA_XV + ((hh * 2 + pb) * 2 + jt) * SA_XVS + rg * 1024 + lanepart);
            v4u w; const v4u xw = __builtin_bit_cast(v4u, xa);
            { const f32x4 t0 = *(const LAS f32x4*)(T_te + hh * 128 + jb + 4 * hi), t1 = *(const LAS f32x4*)(T_te + hh * 128 + jb + 8 + 4 * hi);
              w.x = cvtpk_s(bflo(xw.x) * t0[0], bfhi(xw.x) * t0[1]); w.y = cvtpk_s(bflo(xw.y) * t0[2], bfhi(xw.y) * t0[3]);
              w.z = cvtpk_s(bflo(xw.z) * t1[0], bfhi(xw.z) * t1[1]); w.w = cvtpk_s(bflo(xw.w) * t1[2], bfhi(xw.w) * t1[3]); }
            const bf16x8 af = __builtin_bit_cast(bf16x8, w);
#pragma unroll
            for (int nb = 0; nb < 4; ++nb) { const bf16x8 bfr = tr_frag(lbase + SA_BV + (nb * 2 + jt) * SA_BVS + rg * 1024 + lanepart);
                acc[nb] = __builtin_amdgcn_mfma_f32_32x32x16_bf16(af, bfr, acc[nb], 0, 0, 0); }
        }
        float* S = WSP(float, WS_SCH) + ((((size_t)b * 64 + c) * 8 + h) * 64 + 32 * pb) * 128 + r32;
#pragma unroll
        for (int nb = 0; nb < 4; ++nb)
#pragma unroll
            for (int r = 0; r < 16; ++r) S[(size_t)crow(r, hi) * 128 + 32 * nb] = acc[nb][r];
    }
}
__device__ __forceinline__ void ssd_scan(Frame& F) {
    const int tid = tid_fresh();
    const float* SCH = WSP(float, WS_SCH); const float* CD = WSP(float, WS_CD); bf16* HP = WSP(bf16, WS_HP);
    for (int e = F.vcu * 512 + tid; e < 131072; e += F.G * 512) {
        const int b = e >> 16, h = (e >> 13) & 7, pn = e & 8191;
        float H = 0.f;
        for (int c0 = 0; c0 < 64; c0 += 8) {
            float sv[8], dv[8];
#pragma unroll
            for (int k = 0; k < 8; ++k) { const size_t ci = ((size_t)b * 64 + c0 + k) * 8 + h; sv[k] = SCH[ci * 8192 + pn]; dv[k] = CD[ci]; }
#pragma unroll
            for (int k = 0; k < 8; ++k) { const size_t ci = ((size_t)b * 64 + c0 + k) * 8 + h; HP[ci * 8192 + pn] = (bf16)f2bf(H); H = dv[k] * H + sv[k]; }
        }
        F.out[O_SSP + ((size_t)(b * 8 + h)) * 8192 + pn] = H;
    }
}
__device__ __forceinline__ void ssd_off_unit(Frame& F, int u) {
    const int lane = tid_fresh() & 63, wid = F.wave, r32 = lane & 31, hi = lane >> 5;
    const int b = u >> 7, c = (u >> 1) & 63, g = u & 1; const size_t row0 = (size_t)b * SEQ + c * 128;
    if (c == 0) return;
    const bf16* XBC = WSP(bf16, WS_XBC); const int hh = wid >> 1, h = g * 4 + hh;
    const bf16* HPh = WSP(bf16, WS_HP) + (((size_t)b * 64 + c) * 8 + h) * 8192;
    const float* EA = WSP(float, WS_EACS);
#pragma unroll 1
    for (int ibi = 0; ibi < 2; ++ibi) {
        const int ib = (wid & 1) * 2 + ibi, i = 32 * ib + r32;
        bf16x8 ca[8];
#pragma unroll
        for (int d0 = 0; d0 < 8; ++d0) ca[d0] = *(const bf16x8*)(XBC + (row0 + i) * 1024 + 768 + g * 128 + 16 * d0 + 8 * hi);
        float ea[16];
#pragma unroll
        for (int r = 0; r < 16; ++r) ea[r] = EA[(row0 + 32 * ib + crow(r, hi)) * 8 + h];
#pragma unroll
        for (int pb = 0; pb < 2; ++pb) {
            f32x16 acc = {};
#pragma unroll
            for (int d0 = 0; d0 < 8; ++d0) { const bf16x8 bq = *(const bf16x8*)(HPh + (size_t)(32 * pb + r32) * 128 + 16 * d0 + 8 * hi); acc = __builtin_amdgcn_mfma_f32_32x32x16_bf16(ca[d0], bq, acc, 0, 0, 0); }
            float* Y = WSP(float, WS_YSSD) + (row0 + 32 * ib) * 512 + h * 64 + 32 * pb + r32;
#pragma unroll
            for (int r = 0; r < 16; ++r) Y[(size_t)crow(r, hi) * 512] += ea[r] * acc[r];
        }
    }
}

struct SEpiRes { const float* base; float* out; const float* ada; int goff;
    __device__ __forceinline__ void operator()(int rs, int col, float v) const { out[(size_t)(MP + rs) * 1024 + col] = base[(size_t)rs * 1024 + col] + ada[(size_t)(2 + (rs >> 2)) * 6144 + goff + col] * v; } };
struct SEpiUp { bf16* U;
    __device__ __forceinline__ void operator()(int rs, int col, float v) const { const float a = v > 0.f ? v : 0.f; U[(size_t)(MP + rs) * 4096 + col] = (bf16)f2bf(a * a); } };
template <int KS, class EPI> __device__ __forceinline__ void sgemm_sample(Frame& F, const bf16* A, const bf16* Bt, int N, int K, const EPI& epi) {
    const int lane = tid_fresh() & 63, r32 = lane & 31, hi = lane >> 5, wid = F.wave;
    constexpr int TPB = 8 / KS;
    const int T = 16 * (N >> 5), kchunk = K / KS;
    LAS float* red = (LAS float*)F.lds;
    for (int base = F.vcu * TPB; base < T; base += F.G * TPB) {
        const int tile = base + wid / KS, ks = wid % KS; const bool live = tile < T;
        const int mb = tile & 15, nbk = tile >> 4;
        f32x16 acc = {};
        if (live) {
            const bf16* Ap = A + (size_t)(32 * mb + r32) * K + ks * kchunk + 8 * hi; const bf16* Bp = Bt + (size_t)(32 * nbk + r32) * K + ks * kchunk + 8 * hi;
#pragma unroll 8
            for (int k0 = 0; k0 < kchunk; k0 += 16) { const bf16x8 a = *(const bf16x8*)(Ap + k0), bq = *(const bf16x8*)(Bp + k0); acc = __builtin_amdgcn_mfma_f32_32x32x16_bf16(a, bq, acc, 0, 0, 0); }
        }
        if (KS > 1) {
            __syncthreads();
            if (ks != 0) {
#pragma unroll
                for (int r = 0; r < 16; ++r) red[(wid * 16 + r) * 64 + lane] = acc[r]; }
            __syncthreads();
            if (ks == 0) {
#pragma unroll
                for (int q = 1; q < KS; ++q)
#pragma unroll
                    for (int r = 0; r < 16; ++r) acc[r] += red[((wid + q) * 16 + r) * 64 + lane]; }
        }
        if (live && ks == 0) {
#pragma unroll
            for (int r = 0; r < 16; ++r) epi(32 * mb + crow(r, hi), 32 * nbk + r32, acc[r]); }
    }
    if (KS > 1) __syncthreads();
}

constexpr int MG_AK = 0, MG_AV = 24576, MG_AWS = 40960, MG_IMG = 43008, MG_ROPE = 32768, MG_RCS = 1040, MG_IMGSZ = MG_ROPE + 4 * MG_RCS  , MG_Q = MG_IMG + 2 * MG_IMGSZ  ,
              MG_P = MG_Q + 32 * AD_QRS  , MG_PMAX = MG_P + 4096, MG_ALPHA = MG_PMAX + 256, MG_MBUF = MG_ALPHA + 128, MG_PGS = MG_MBUF + 128, MG_NEWK = MG_PGS + 128, MG_END = MG_NEWK + 4 * 576;
static_assert(MG_END <= PHASE_LDS && MG_IMGSZ % 16 == 0 && MG_Q % 16 == 0 && MG_P % 16 == 0, "merged attention LDS map");
__device__ __forceinline__ unsigned dimg_off(unsigned row, unsigned ch) { const unsigned f = ((row & 3u) << 2) | ((row >> 2) & 3u); return 512u * row + 16u * ((ch & 16u) | ((ch ^ f) & 15u)); }
struct DecRegs { f32x4 k[4]; f32x4 r; };
__device__ __forceinline__ void dec_issue(LAS unsigned char* L, const float* ck, const float* cr, int x, int tid, DecRegs& R) {
    asm volatile("" : "+v"(tid));
    const int pg = ((const LAS int*)(L + MG_PGS))[x >> 2]; const size_t rb = (size_t)pg * 128 + (x & 3) * 32;
#pragma unroll
    for (int q = 0; q < 4; ++q) { const int g = q * 512 + tid; const float* a = ck + (rb + (g >> 6)) * 256 + (g & 63) * 4; asm volatile("global_load_dwordx4 %0, %1, off nt" : "=&v"(R.k[q]) : "v"(a) : "memory"); }
    { const float* a = cr + (rb + ((tid & 255) >> 3)) * 32 + (tid & 7) * 4; asm volatile("global_load_dwordx4 %0, %1, off nt" : "=&v"(R.r) : "v"(a) : "memory"); }
}
__device__ __forceinline__ void dec_write(const LAS unsigned char* nk, LAS unsigned char* img, int x, int tid, const DecRegs& R) {
    asm volatile("" : "+v"(tid));
    const int k0 = 32 * (x & 1);
    if (x < 128) {
#pragma unroll
        for (int q = 0; q < 4; ++q) { const int g = q * 512 + tid, key = k0 + (g >> 6), i = g & 63; v2u w; w.x = pk2(R.k[q][0], R.k[q][1]); w.y = pk2(R.k[q][2], R.k[q][3]);
            *(LAS v2u*)(img + dimg_off(key, i >> 1) + (i & 1) * 8) = w; }
        if (tid < 256) { const int key = k0 + (tid >> 3), i = tid & 7; v2u w; w.x = pk2(R.r[0], R.r[1]); w.y = pk2(R.r[2], R.r[3]); *(LAS v2u*)(img + MG_ROPE + (i >> 1) * MG_RCS + key * 16 + (i & 1) * 8) = w; }
    } else {
#pragma unroll
        for (int q = 0; q < 4; ++q) { const int g = q * 512 + tid, key = k0 + (g >> 6), i = g & 63; v2u w = {0u, 0u}; if (key < 4) w = *(const LAS v2u*)(nk + key * 576 + 8 * i);
            *(LAS v2u*)(img + dimg_off(key, i >> 1) + (i & 1) * 8) = w; }
        if (tid < 256) { const int key = k0 + (tid >> 3), i = tid & 7; v2u w = {0u, 0u}; if (key < 4) w = *(const LAS v2u*)(nk + key * 576 + 512 + 8 * i); *(LAS v2u*)(img + MG_ROPE + (i >> 1) * MG_RCS + key * 16 + (i & 1) * 8) = w; }
    }
}
__device__ __forceinline__ void dec_qk_softmax(LAS unsigned char* L, const LAS unsigned char* img, int lane, bool newkeys) {
    asm volatile("" : "+v"(lane));
    const int r32 = lane & 31, hi = lane >> 5;
    const LAS unsigned char* qp = L + MG_Q + r32 * AD_QRS + hi * 16;
    const unsigned fk = ((r32 & 3u) << 2) | ((r32 >> 2) & 3u);
    const LAS unsigned char* krow = img + 512 * r32;
    f32x16 p0 = {}, p1 = {};
#pragma unroll 2
    for (int d0 = 0; d0 < 16; ++d0) { const unsigned ch = 2 * d0 + hi, co = 16u * ((ch & 16u) | ((ch ^ fk) & 15u));
        const bf16x8 a0 = *(const LAS bf16x8*)(krow + co), a1 = *(const LAS bf16x8*)(krow + 16384 + co), bq = *(const LAS bf16x8*)(qp + d0 * 32);
        p0 = __builtin_amdgcn_mfma_f32_32x32x16_bf16(a0, bq, p0, 0, 0, 0); p1 = __builtin_amdgcn_mfma_f32_32x32x16_bf16(a1, bq, p1, 0, 0, 0); }
#pragma unroll
    for (int d0 = 16; d0 < 18; ++d0) { const LAS unsigned char* rp = img + MG_ROPE + (2 * (d0 - 16) + hi) * MG_RCS + r32 * 16;
        const bf16x8 a0 = *(const LAS bf16x8*)rp, a1 = *(const LAS bf16x8*)(rp + 512), bq = *(const LAS bf16x8*)(qp + d0 * 32);
        p0 = __builtin_amdgcn_mfma_f32_32x32x16_bf16(a0, bq, p0, 0, 0, 0); p1 = __builtin_amdgcn_mfma_f32_32x32x16_bf16(a1, bq, p1, 0, 0, 0); }
    if (newkeys) {
#pragma unroll
        for (int r = 0; r < 16; ++r) { if (crow(r, hi) > (r32 >> 3)) p0[r] = -INFINITY; p1[r] = -INFINITY; } }
    LAS float* mb = (LAS float*)(L + MG_MBUF);
    const float rm = rowmax32(p0, p1), mo = mb[r32], mn = fmaxf(mo, rm);
    if (hi == 0) { ((LAS float*)(L + MG_ALPHA))[r32] = __builtin_amdgcn_exp2f(mo - mn); mb[r32] = mn; }
#pragma unroll
    for (int r = 0; r < 16; ++r) { p0[r] = __builtin_amdgcn_exp2f(p0[r] - mn); p1[r] = __builtin_amdgcn_exp2f(p1[r] - mn); }
    v4u w0, w1, w2, w3;
    w0.x = cvtpk_s(p0[0], p0[1]); w0.y = cvtpk_s(p0[2], p0[3]); w0.z = cvtpk_s(p0[4], p0[5]); w0.w = cvtpk_s(p0[6], p0[7]);
    w1.x = cvtpk_s(p0[8], p0[9]); w1.y = cvtpk_s(p0[10], p0[11]); w1.z = cvtpk_s(p0[12], p0[13]); w1.w = cvtpk_s(p0[14], p0[15]);
    w2.x = cvtpk_s(p1[0], p1[1]); w2.y = cvtpk_s(p1[2], p1[3]); w2.z = cvtpk_s(p1[4], p1[5]); w2.w = cvtpk_s(p1[6], p1[7]);
    w3.x = cvtpk_s(p1[8], p1[9]); w3.y = cvtpk_s(p1[10], p1[11]); w3.z = cvtpk_s(p1[12], p1[13]); w3.w = cvtpk_s(p1[14], p1[15]);
    *(LAS v4u*)(L + MG_P + 0 * 1024 + lane * 16) = w0; *(LAS v4u*)(L + MG_P + 1 * 1024 + lane * 16) = w1; *(LAS v4u*)(L + MG_P + 2 * 1024 + lane * 16) = w2; *(LAS v4u*)(L + MG_P + 3 * 1024 + lane * 16) = w3;
}
__device__ __forceinline__ void dec_pv(LAS unsigned char* L, const LAS unsigned char* img, int lane, int wid, float& l, f32x16& o) {
    asm volatile("" : "+v"(lane));
    const int r32 = lane & 31, hi = lane >> 5;
    const LAS float* al = (const LAS float*)(L + MG_ALPHA);
    v4u pw[4];
#pragma unroll
    for (int ks = 0; ks < 4; ++ks) pw[ks] = *(const LAS v4u*)(L + MG_P + ks * 1024 + lane * 16);
    const unsigned blk = (lane >> 4) & 1, q = (lane & 15) >> 2, p = lane & 3;
    const unsigned ch = 4 * wid + 2 * blk + (p >> 1);
    const unsigned a_t0 = (unsigned)(size_t)img + dimg_off(4 * hi + q, ch) + 8 * (p & 1), a_t1 = (unsigned)(size_t)img + dimg_off(4 * hi + 8 + q, ch) + 8 * (p & 1);
    s16x4 lo[4], hh[4];
#pragma unroll
    for (int ks = 0; ks < 4; ++ks) {
        asm volatile("ds_read_b64_tr_b16 %0,%1 offset:%c2" : "=&v"(lo[ks]) : "v"(a_t0), "i"(ks * 8192) : "memory");
        asm volatile("ds_read_b64_tr_b16 %0,%1 offset:%c2" : "=&v"(hh[ks]) : "v"(a_t1), "i"(ks * 8192) : "memory"); }
    const float aq = al[r32];
#pragma unroll
    for (int r = 0; r < 16; ++r) o[r] *= al[crow(r, hi)];
    float sum = 0.f;
#pragma unroll
    for (int ks = 0; ks < 4; ++ks) sum += (bflo(pw[ks].x) + bfhi(pw[ks].x)) + (bflo(pw[ks].y) + bfhi(pw[ks].y)) + (bflo(pw[ks].z) + bfhi(pw[ks].z)) + (bflo(pw[ks].w) + bfhi(pw[ks].w));
    sum += __shfl_xor(sum, 32);
    l = l * aq + sum;
    asm volatile("s_waitcnt lgkmcnt(0)" ::: "memory"); __builtin_amdgcn_sched_barrier(0);
#define PKV(k) (bf16x8){lo[k][0], lo[k][1], lo[k][2], lo[k][3], hh[k][0], hh[k][1], hh[k][2], hh[k][3]}
    o = __builtin_amdgcn_mfma_f32_32x32x16_bf16(__builtin_bit_cast(bf16x8, pw[0]), PKV(0), o, 0, 0, 0);
    o = __builtin_amdgcn_mfma_f32_32x32x16_bf16(__builtin_bit_cast(bf16x8, pw[1]), PKV(1), o, 0, 0, 0);
    o = __builtin_amdgcn_mfma_f32_32x32x16_bf16(__builtin_bit_cast(bf16x8, pw[2]), PKV(2), o, 0, 0, 0);
    o = __builtin_amdgcn_mfma_f32_32x32x16_bf16(__builtin_bit_cast(bf16x8, pw[3]), PKV(3), o, 0, 0, 0);
#undef PKV
}
__device__ __forceinline__ void glds16(const void* gsrc, unsigned lds_dst) { unsigned keep;
    asm volatile("s_mov_b32 %0, m0\n\ts_mov_b32 m0, %2\n\ts_nop 0\n\tglobal_load_lds_dwordx4 %1, off\n\ts_mov_b32 m0, %0" : "=&s"(keep) : "v"(gsrc), "s"(lds_dst) : "memory"); }
__device__ __forceinline__ void att_tile(LAS unsigned char* L, int buf, int jb, int lane, int wid, const bf16x8 (&qr)[6], float& m, float& l, f32x16& o0, f32x16& o1) {
    asm volatile("" : "+v"(lane));
    const int r32 = lane & 31, hi = lane >> 5, qrel = wid * 32 + r32;
    if (jb >= 0 && wid * 32 + 31 < 64 * jb) return;
    LAS float* wsf = (LAS float*)(L + MG_AWS) + wid * 64;
    const LAS unsigned char* kp = L + MG_AK + buf * 12288 + hi * 1024 + r32 * 16;
    f32x16 p0 = {}, p1 = {};
#pragma unroll
    for (int d0 = 0; d0 < 6; ++d0) { const bf16x8 a0 = *(const LAS bf16x8*)(kp + d0 * 2048), a1 = *(const LAS bf16x8*)(kp + d0 * 2048 + 512);
        p0 = __builtin_amdgcn_mfma_f32_32x32x16_bf16(a0, qr[d0], p0, 0, 0, 0); p1 = __builtin_amdgcn_mfma_f32_32x32x16_bf16(a1, qr[d0], p1, 0, 0, 0); }
    if (jb >= 0) {
#pragma unroll
        for (int r = 0; r < 16; ++r) { const int kv = 64 * jb + crow(r, hi); if (kv > qrel) p0[r] = -INFINITY; if (kv + 32 > qrel) p1[r] = -INFINITY; } }
    float alpha; bf16x8 pa0, pa1, pa2, pa3;
    softmax_step(p0, p1, m, l, alpha, pa0, pa1, pa2, pa3);
    if (__any(alpha != 1.f)) {
        if (hi == 0) wsf[r32] = alpha;
        LDS_WAIT();
#pragma unroll
        for (int r = 0; r < 16; ++r) { const float f = wsf[crow(r, hi)]; o0[r] *= f; o1[r] *= f; }
        LDS_WAIT();
    }
    const unsigned vb = (unsigned)(size_t)(L + MG_AV) + buf * 8192 + ((lane >> 4) & 1) * 32 + (lane & 3) * 8 + (4 * hi + ((lane & 15) >> 2)) * 64;
    pv_block(o0, vb, pa0, pa1, pa2, pa3);
    pv_block(o1, vb + 4096, pa0, pa1, pa2, pa3);
}
#define DEC_PRE(g, RR) do { if ((MODE & 2) && !(MODE & 16) && (g) < 2 * NST) dec_write(L + MG_NEWK, L + MG_IMG + (((g) >> 1) & 1) * MG_IMGSZ, (g), tid, RR); } while (0)
#define DEC_POST(g, RR) do { const int j_ = (g) >> 1; \
        if (!(MODE & 4)) {} else if ((g) & 1) { if (j_ < NST && wid == (j_ & 7)) dec_qk_softmax(L, L + MG_IMG + (j_ & 1) * MG_IMGSZ, lane, j_ == 64); } \
        else if (j_ >= 1 && j_ - 1 < NST) dec_pv(L, L + MG_IMG + ((j_ - 1) & 1) * MG_IMGSZ, lane, wid, ld, od); } while (0)
template <int MODE> __device__ __forceinline__ void p5_merged_round(Frame& F, int v) {
    const int tid = tid_fresh(), lane = tid & 63, wid = F.wave, r32 = lane & 31, hi = lane >> 5;
    LAS unsigned char* L = F.lds;
    const int s = v >> 1, split = v & 1, NST = 64 + (split == 1 ? 1 : 0);
    __syncthreads();
    {
        LAS float* qn = (LAS float*)L;
        for (int i = tid; i < 2048; i += 512) qn[i] = bf2f(WSP(bf16, WS_QSN)[(size_t)s * 2048 + i]);
        __syncthreads();
        const int r = tid & 255, lh = tid >> 8; const bf16* WK = WSP(bf16, WS_WKV);
        for (int h = 0; h < 8; ++h) { float a0 = 0.f, a1 = 0.f;
#pragma unroll 8
            for (int d = 0; d < 64; ++d) { const float w = bf2f(WK[(size_t)(h * 64 + d) * 256 + r]); a0 += w * qn[(2 * lh) * 512 + h * 64 + d]; a1 += w * qn[(2 * lh + 1) * 512 + h * 64 + d]; }
            *(LAS bf16*)(L + MG_Q + ((2 * lh) * 8 + h) * AD_QRS + r * 2) = (bf16)f2bf(a0 * SCL2); *(LAS bf16*)(L + MG_Q + ((2 * lh + 1) * 8 + h) * AD_QRS + r * 2) = (bf16)f2bf(a1 * SCL2); }
        for (int i = tid; i < 1024; i += 512) { const int row = i >> 5, j = i & 31; *(LAS bf16*)(L + MG_Q + row * AD_QRS + (256 + j) * 2) = WSP(bf16, WS_QSR)[((size_t)s * 32 + row) * 32 + j]; }
        if (tid < 288) { const int key = tid / 72, c = tid % 72;
            const v2u w = c < 64 ? *(const v2u*)(WSP(bf16, WS_CKV) + ((size_t)MP + s * 4 + key) * 256 + 4 * c) : *(const v2u*)(WSP(bf16, WS_KRS) + ((size_t)s * 4 + key) * 32 + 4 * (c - 64));
            *(LAS v2u*)(L + MG_NEWK + key * 576 + 8 * c) = w; }
        if (tid < 32) { ((LAS float*)(L + MG_MBUF))[tid] = -1e30f; ((LAS int*)(L + MG_PGS))[tid] = F.ptab()[s * 64 + split * 32 + tid]; }
        __syncthreads();
    }
    DecRegs RA, RB;
    const float* ck_ = F.cache_kv(); const float* cr_ = F.cache_kr();
    if (MODE & 2) { dec_issue(L, ck_, cr_, 0, tid, RA); dec_issue(L, ck_, cr_, 1, tid, RB); } else { RA.r = (f32x4){0.f, 0.f, 0.f, 0.f}; for (int q = 0; q < 4; ++q) RA.k[q] = RA.r; RB = RA; }
    float ld = 0.f; f32x16 od = {};
    int g = 0;
#pragma unroll 1
    for (int uu = 0; uu < 2; ++uu) {
        const int bh = v >> 4, qb = uu == 0 ? (v & 15) : 31 - (v & 15);
        const int b = bh >> 3, h = bh & 7, q0 = qb * 256, NT = 4 * (qb + 1), qrel = wid * 32 + r32;
        const bf16* Qw = WSP(bf16, WS_QP) + ((size_t)bh * SEQ + q0 + wid * 32 + r32) * 96 + hi * 8;
        bf16x8 qr[6];
#pragma unroll
        for (int d0 = 0; d0 < 6; ++d0) qr[d0] = *(const bf16x8*)(Qw + d0 * 16);
        asm volatile("" : "+v"(qr[0]), "+v"(qr[1]), "+v"(qr[2]), "+v"(qr[3]), "+v"(qr[4]), "+v"(qr[5]));
        const v4u* Kg = (const v4u*)(WSP(bf16, WS_KP) + (size_t)bh * 128 * 6144);
        const v4u* Vg = (const v4u*)(WSP(bf16, WS_VP) + (size_t)bh * 128 * 4096);
        LAS float* wsf = (LAS float*)(L + MG_AWS) + wid * 64;
#define ATT_DMA(tt, bb) do { glds16(Kg + (size_t)(tt) * 768 + wid * 64 + lane, (unsigned)__builtin_amdgcn_readfirstlane((int)(lbase_ + MG_AK + (bb) * 12288 + wid * 1024))); \
        glds16(Kg + (size_t)(tt) * 768 + (8 + (wid & 3)) * 64 + lane, (unsigned)__builtin_amdgcn_readfirstlane((int)(lbase_ + MG_AK + (bb) * 12288 + (8 + (wid & 3)) * 1024)));     \
        glds16(Vg + (size_t)(tt) * 512 + wid * 64 + lane, (unsigned)__builtin_amdgcn_readfirstlane((int)(lbase_ + MG_AV + (bb) * 8192 + wid * 1024))); } while (0)
        const unsigned lbase_ = (unsigned)(size_t)L;
        ATT_DMA(0, 0);
        float m = -1e30f, l = 0.f; f32x16 o0 = {}, o1 = {};
#pragma unroll 1
#define MG_STEP(tt, RR) do { \
            if ((MODE & 2) && (tt) >= 2 && g + 1 < 128) asm volatile("s_waitcnt vmcnt(8)" ::: "memory");     \
            else asm volatile("s_waitcnt vmcnt(0)" ::: "memory"); \
            asm volatile("" : "+v"(RR.k[0]), "+v"(RR.k[1]), "+v"(RR.k[2]), "+v"(RR.k[3]), "+v"(RR.r)); \
            DEC_PRE(g, RR); \
            if ((MODE & 2) && (tt) > 0 && g + 1 < 128) asm volatile("s_waitcnt vmcnt(5) lgkmcnt(0)\n\ts_barrier" ::: "memory"); \
            else asm volatile("s_waitcnt vmcnt(0) lgkmcnt(0)\n\ts_barrier" ::: "memory"); \
            if ((tt) + 1 < NT) ATT_DMA((tt) + 1, ((tt) + 1) & 1); \
            asm volatile("" ::: "memory"); \
            if ((MODE & 2) && g + 2 < 128) dec_issue(L, ck_, cr_, g + 2, tid, RR);     \
            asm volatile("" ::: "memory"); \
            if (MODE & 1) att_tile(L, (tt) & 1, (tt) - (NT - 4), lane, wid, qr, m, l, o0, o1); \
            DEC_POST(g, RR); ++g; } while (0)
        for (int t = 0; t < NT; t += 2) { MG_STEP(t, RA); MG_STEP(t + 1, RB); }
#undef MG_STEP
        l += __shfl_xor(l, 32);
        if (hi == 0) wsf[32 + r32] = 1.f / l;
        LDS_WAIT();
        bf16* Ow = WSP(bf16, (MODE & 8) ? WS_U : WS_OATT) + ((size_t)b * SEQ + q0 + wid * 32) * 512 + h * 64 + r32;
#pragma unroll
        for (int r = 0; r < 16; ++r) { const int qrow = crow(r, hi); const float f = wsf[32 + qrow]; Ow[(size_t)qrow * 512] = (bf16)f2bf(o0[r] * f); Ow[(size_t)qrow * 512 + 32] = (bf16)f2bf(o1[r] * f); }
        LDS_WAIT();
#undef ATT_DMA
    }
#pragma unroll 1
    for (; g <= 2 * NST; ) {
        asm volatile("s_waitcnt vmcnt(0)" ::: "memory"); asm volatile("" : "+v"(RA.k[0]), "+v"(RA.k[1]), "+v"(RA.k[2]), "+v"(RA.k[3]), "+v"(RA.r));
        DEC_PRE(g, RA); __syncthreads(); if ((MODE & 2) && g + 2 < 128) dec_issue(L, ck_, cr_, g + 2, tid, RA); DEC_POST(g, RA); ++g;
        asm volatile("s_waitcnt vmcnt(0)" ::: "memory"); asm volatile("" : "+v"(RB.k[0]), "+v"(RB.k[1]), "+v"(RB.k[2]), "+v"(RB.k[3]), "+v"(RB.r));
        DEC_PRE(g, RB); __syncthreads(); if ((MODE & 2) && g + 2 < 128) dec_issue(L, ck_, cr_, g + 2, tid, RB); DEC_POST(g, RB); ++g;
    }
    float* OP = WSP(float, (MODE & 8) ? WS_X2 : WS_OPART) + ((size_t)(s * 2 + split) * 32) * 256 + wid * 32 + r32;
#pragma unroll
    for (int r = 0; r < 16; ++r) OP[(size_t)crow(r, hi) * 256] = od[r];
    if (wid == 0 && hi == 0) { float* ML = WSP(float, (MODE & 8) ? WS_X2 + 16 * MiB : WS_ML) + ((size_t)(s * 2 + split) * 32 + r32) * 2; ML[0] = ((const LAS float*)(L + MG_MBUF))[r32]; ML[1] = ld; }
    __syncthreads();
}


#ifndef PROBE
#define PROBE (-1)
#endif
#define GWDEF const int gw = F.vcu * NWAVES + F.wave, NGW = F.G * NWAVES
__device__ __forceinline__ void ph0(Frame& F) { p0_prologue(F); }
struct RowsP1 { const float* xp; const float* xs; const float* ada; bf16* H;
    __device__ __forceinline__ const float* x(int m) const { return m < MP ? xp + (size_t)m * DM : xs + (size_t)(m - MP) * DM; }
    __device__ __forceinline__ const float* sc(int m) const { return ada + (size_t)arow_of(m) * 6144 + 1024; }
    __device__ __forceinline__ const float* sh(int m) const { return ada + (size_t)arow_of(m) * 6144; }
    __device__ __forceinline__ void* o(int m) const { return H + (size_t)m * 1024; } };
__device__ __forceinline__ void ph1(Frame& F) { GWDEF; const int lane = tid_fresh() & 63; const RowsP1 R{F.xp(), F.xs(), WSP(float, WS_ADA), WSP(bf16, WS_H1)}; const float* g = F.g_mix();
    for (int m = gw; m < MT; m += 4 * NGW) { if (m + 3 * NGW < MT) norm_mod_rows4<true>(R, g, m, NGW, lane); else for (int mm = m; mm < MT; mm += NGW) norm_mod_row<true>(R.x(mm), g, R.sc(mm), R.sh(mm), R.o(mm), lane); } }
__device__ __forceinline__ void ph2(Frame& F) { pg8::Gemm g{WSP(bf16, WS_H1), WSP(bf16, WS_WIN), MT, NPROJ, 1024}; pg8::StaticOrder S; S.init(MT, NPROJ, F.G, (int)blockIdx.x);
    pg8::EpiProj E{WSP(bf16, WS_PROJ), WSP(float, WS_DTRAW)};
    pg8::gemm_phase<pg8::EpiProj, pg8::StaticOrder, true, true>(F.lds, g, S, E); }
__device__ __forceinline__ void ph3(Frame& F) { GWDEF; const int lane = tid_fresh() & 63; for (int m = gw; m < MT; m += NGW) p3_row(F, m, lane); }
__device__ __forceinline__ void ph4_gemms(Frame& F) {
    { int Kk = 256; asm volatile("" : "+s"(Kk)); pg8::Gemm g{WSP(bf16, WS_CKV), WSP(bf16, WS_WKV), MP, 1024, Kk}; pg8::StaticOrder S; S.init(MP, 1024, F.G, (int)blockIdx.x);
      pg8::EpiKV E{WSP(bf16, WS_KP), WSP(bf16, WS_VP)};
      pg8::gemm_phase<pg8::EpiKV, pg8::StaticOrder, true, true>(F.lds, g, S, E); }
    __syncthreads();
    { int Kq = 384; asm volatile("" : "+s"(Kq)); pg8::Gemm g{WSP(bf16, WS_QN), WSP(bf16, WS_WUQ), MT, 768, Kq}; pg8::StaticOrder S; S.init(MT, 768, F.G, (int)blockIdx.x);
      pg8::EpiQ E{WSP(bf16, WS_QP), WSP(bf16, WS_QSN), WSP(bf16, WS_QSR), WSP(float, WS_CS), SCL2};
      pg8::gemm_phase<pg8::EpiQ, pg8::StaticOrder, true, true>(F.lds, g, S, E); } }
__device__ __forceinline__ void ph4_ssd(Frame& F) { for (int u = F.vcu; u < 256; u += F.G) ssd_chunk_unit(F, u); }
__device__ __forceinline__ void ph4(Frame& F) { ph4_gemms(F); if (PROBE == 25) ph4_gemms(F); ph4_ssd(F); if (PROBE == 26) ph4_ssd(F); }
__device__ __forceinline__ void ph5_a(Frame& F) { ssd_scan(F); for (int u = F.vcu; u < 1024; u += F.G) ssd_sample_unit(F, u); __syncthreads(); }
__device__ __forceinline__ void ph5_dec(Frame& F) { for (int u = F.vcu; u < 256; u += F.G) attn_decode_unit(F, u >> 1, u & 1); }
__device__ __forceinline__ void ph5_att(Frame& F) { for (int v = F.vcu; v < 256; v += F.G) { attn_prompt_unit(F, v >> 4, v & 15); attn_prompt_unit(F, v >> 4, 31 - (v & 15)); } }
__device__ __forceinline__ void ph5_m(Frame& F) { for (int v = F.vcu; v < 256; v += F.G) p5_merged_round<7>(F, v); }
#if PROBE >= 100
__device__ __forceinline__ void ph5_var(Frame& F) { for (int v = F.vcu; v < 256; v += F.G) p5_merged_round<(PROBE - 100) | 8>(F, v); }
#else
__device__ __forceinline__ void ph5_var(Frame& F) {}
#endif
#ifndef MERGED
#define MERGED 1
#endif
__device__ __forceinline__ void ph5(Frame& F) { ph5_a(F); if (PROBE == 20) ph5_a(F);
    if (MERGED) { ph5_m(F); if (PROBE == 23) ph5_m(F); if (PROBE >= 100) ph5_var(F); }
    else { ph5_dec(F); if (PROBE == 21) ph5_dec(F); ph5_att(F); if (PROBE == 22) ph5_att(F); } }
__device__ __forceinline__ void ph6(Frame& F) { { GWDEF; const int lane = tid_fresh() & 63; for (int t = gw; t < 256; t += NGW) sample_ov_tile(F, t, lane); }
    for (int u = F.vcu; u < 256; u += F.G) ssd_off_unit(F, u); }
__device__ __forceinline__ void ph7(Frame& F) { GWDEF; const int lane = tid_fresh() & 63; for (int m = gw; m < MT; m += NGW) p6_row(F, m, lane); }
__device__ __forceinline__ void ph8(Frame& F) { pg8::Gemm g{WSP(bf16, WS_AMIX), WSP(bf16, WS_WOUT), MP, 1024, 1024}; pg8::StaticOrder S; S.init(MP, 1024, F.G, (int)blockIdx.x);
    pg8::EpiRes E{F.xp(), F.xs(), WSP(float, WS_X1), WSP(float, WS_ADA), 2048};
    pg8::gemm_phase<pg8::EpiRes, pg8::StaticOrder, true, true>(F.lds, g, S, E);
    __syncthreads();
    SEpiRes SE{F.xs(), WSP(float, WS_X1), WSP(float, WS_ADA), 2048};
    sgemm_sample<4, SEpiRes>(F, WSP(bf16, WS_AMIX) + (size_t)MP * 1024, WSP(bf16, WS_WOUT), 1024, 1024, SE); }
struct RowsP9 { const float* X1; const float* ada; bf16* H;
    __device__ __forceinline__ const float* x(int m) const { return X1 + (size_t)m * 1024; }
    __device__ __forceinline__ const float* sc(int m) const { return ada + (size_t)arow_of(m) * 6144 + 4096; }
    __device__ __forceinline__ const float* sh(int m) const { return ada + (size_t)arow_of(m) * 6144 + 3072; }
    __device__ __forceinline__ void* o(int m) const { return H + (size_t)m * 1024; } };
__device__ __forceinline__ void ph9(Frame& F) { GWDEF; const int lane = tid_fresh() & 63; const RowsP9 R{WSP(float, WS_X1), WSP(float, WS_ADA), WSP(bf16, WS_H1)}; const float* g = F.g_mlp();
    for (int m = gw; m < MT; m += 4 * NGW) { if (m + 3 * NGW < MT) norm_mod_rows4<true>(R, g, m, NGW, lane); else for (int mm = m; mm < MT; mm += NGW) norm_mod_row<true>(R.x(mm), g, R.sc(mm), R.sh(mm), R.o(mm), lane); } }
__device__ __forceinline__ void ph10(Frame& F) { pg8::Gemm g{WSP(bf16, WS_H1), WSP(bf16, WS_WUP), MP, DFF, 1024}; pg8::StaticOrder S; S.init(MP, DFF, F.G, (int)blockIdx.x);
    pg8::EpiUp E{WSP(bf16, WS_U)};
    pg8::gemm_phase<pg8::EpiUp, pg8::StaticOrder, true, true>(F.lds, g, S, E);
    __syncthreads();
    SEpiUp SE{WSP(bf16, WS_U)};
    sgemm_sample<1, SEpiUp>(F, WSP(bf16, WS_H1) + (size_t)MP * 1024, WSP(bf16, WS_WUP), DFF, 1024, SE); }
__device__ __forceinline__ void ph11(Frame& F) { pg8::Gemm g{WSP(bf16, WS_U), WSP(bf16, WS_WDOWN), MP, 1024, DFF}; pg8::StaticOrder S; S.init(MP, 1024, F.G, (int)blockIdx.x);
    pg8::EpiRes E{WSP(float, WS_X1), WSP(float, WS_X1) + (size_t)MP * 1024, WSP(float, WS_X2), WSP(float, WS_ADA), 5120};
    pg8::gemm_phase<pg8::EpiRes, pg8::StaticOrder, true, true>(F.lds, g, S, E);
    __syncthreads();
    SEpiRes SE{WSP(float, WS_X1) + (size_t)MP * 1024, WSP(float, WS_X2), WSP(float, WS_ADA), 5120};
    sgemm_sample<4, SEpiRes>(F, WSP(bf16, WS_U) + (size_t)MP * 4096, WSP(bf16, WS_WDOWN), 1024, DFF, SE); }
struct RowsP12 { const float* X2; const float* adaf; float* out;
    __device__ __forceinline__ const float* x(int m) const { return X2 + (size_t)m * 1024; }
    __device__ __forceinline__ const float* sc(int m) const { return adaf + (size_t)arow_of(m) * 2048 + 1024; }
    __device__ __forceinline__ const float* sh(int m) const { return adaf + (size_t)arow_of(m) * 2048; }
    __device__ __forceinline__ void* o(int m) const { return m < MP ? out + O_YP + (size_t)m * 1024 : out + O_YS + (size_t)(m - MP) * 1024; } };
__device__ __forceinline__ void ph12(Frame& F) { GWDEF; const int lane = tid_fresh() & 63; const RowsP12 R{WSP(float, WS_X2), WSP(float, WS_ADAF), F.out}; const float* g = F.g_fin();
    for (int m = gw; m < MT; m += 4 * NGW) { if (m + 3 * NGW < MT) norm_mod_rows4<false>(R, g, m, NGW, lane); else for (int mm = m; mm < MT; mm += NGW) norm_mod_row<false>(R.x(mm), g, R.sc(mm), R.sh(mm), R.o(mm), lane); } }

__global__ void __launch_bounds__(NWAVES * 64, 2) hymba_fwd(Args args) {
    extern __shared__ __attribute__((aligned(16))) unsigned char lds[];
    Frame F;
    F.lds = (LAS unsigned char*)lds;
    F.MISC = (volatile LAS unsigned*)(F.lds + MISC_OFF);
    F.wave = __builtin_amdgcn_readfirstlane((int)threadIdx.x >> 6);
    F.G = gridDim.x; { const int bx = blockIdx.x; F.vcu = (F.G % 8 == 0) ? (bx % 8) * (F.G / 8) + bx / 8 : bx; }
    F.ws = args.ws; F.out = args.out; F.ctl = (unsigned*)(args.ws + WS_CTL);
    F.ap = &args;
    for (int u = threadIdx.x; u < (LDS_BYTES - LDSCTL_OFF) / 4; u += NWAVES * 64) ((LAS unsigned*)(F.lds + LDSCTL_OFF))[u] = 0u;
    __syncthreads();
    XcdBarrier bar; bar.bar = F.ctl + CW_BAR; bar.x = 0; bar.st = nullptr;
#if !MK_PER_PHASE
    bar = xcd_barrier_post(F.ctl + CW_BAR, F.MISC + 8);
#endif
    const int lo = args.ph_lo, hi = args.ph_hi;
#define IN(k) (lo <= (k) && (k) < hi)
#if MK_PER_PHASE
#define SEAM(k) do { } while (0)
#else
#define SEAM(k) do { if (IN(k) && IN((k) + 1)) xcd_barrier(bar); } while (0)
#endif
#ifndef PROBE
#define PROBE (-1)
#endif
#define RUN(k, call) do { if (IN(k)) { call; if (PROBE == (k)) { xcd_barrier(bar); call; } } } while (0)
    RUN(0, ph0(F));  SEAM(0);
    RUN(1, ph1(F));  SEAM(1);
    RUN(2, ph2(F));  SEAM(2);
    RUN(3, ph3(F));  SEAM(3);
    RUN(4, ph4(F));  SEAM(4);
    RUN(5, ph5(F));  SEAM(5);
    RUN(6, ph6(F));  SEAM(6);
    RUN(7, ph7(F));  SEAM(7);
    RUN(8, ph8(F));  SEAM(8);
    RUN(9, ph9(F));  SEAM(9);
    RUN(10, ph10(F)); SEAM(10);
    RUN(11, ph11(F)); SEAM(11);
    RUN(12, ph12(F));
#undef RUN
#undef IN
#undef SEAM
}

extern "C" void kernel_launch(void* const* d_in, const int* in_sizes, int n_in, void* d_out, int out_size, void* d_ws, size_t ws_size, hipStream_t stream) {
    static int grid = 0;
    if (grid == 0) {
        if (n_in != 32 || (size_t)out_size != O_END || ws_size < WS_END) { fprintf(stderr, "kernel_launch: unexpected shapes (n_in %d, out %d, ws %zu); nothing launched\n", n_in, out_size, ws_size); grid = -1; return; }
        int dev = 0, cus = 0, per_cu = 0;
        if (hipGetDevice(&dev) != hipSuccess || hipDeviceGetAttribute(&cus, hipDeviceAttributeMultiprocessorCount, dev) != hipSuccess) { fprintf(stderr, "kernel_launch: device query failed\n"); grid = -1; return; }
        if (hipFuncSetAttribute((const void*)hymba_fwd, hipFuncAttributeMaxDynamicSharedMemorySize, LDS_BYTES) != hipSuccess) { fprintf(stderr, "kernel_launch: hipFuncSetAttribute failed\n"); grid = -1; return; }
        if (hipOccupancyMaxActiveBlocksPerMultiprocessor(&per_cu, (const void*)hymba_fwd, NWAVES * 64, LDS_BYTES) != hipSuccess || per_cu < 1) fprintf(stderr, "kernel_launch: note: occupancy query reports %d workgroups per CU\n", per_cu);
        (void)hipGetLastError();
        grid = cus;
    }
    if (grid < 0) return;
    if (hipMemsetAsync((char*)d_ws + WS_CTL, 0, CTL_ZERO_BYTES, stream) != hipSuccess) { fprintf(stderr, "kernel_launch: memset failed\n"); return; }
    Args a{};
    for (int i = 0; i < 32; ++i) a.in[i] = d_in[i];
    a.out = (float*)d_out; a.ws = (unsigned char*)d_ws;
#if MK_PER_PHASE
    for (int p = 0; p < NPHASE; ++p) { a.ph_lo = p; a.ph_hi = p + 1; hipLaunchKernelGGL(hymba_fwd, dim3(grid), dim3(NWAVES * 64), LDS_BYTES, stream, a); }
#else
    a.ph_lo = 0; a.ph_hi = NPHASE;
    hipLaunchKernelGGL(hymba_fwd, dim3(grid), dim3(NWAVES * 64), LDS_BYTES, stream, a);
#endif
    const hipError_t le = hipPeekAtLastError();
    if (le != hipSuccess) fprintf(stderr, "kernel_launch: launch failed: %s\n", hipGetErrorName(le));
}
```

```cpp
#include <hip/hip_runtime.h>
#include <cstdio>
#include <cstdint>

#ifndef MK_PER_PHASE
#define MK_PER_PHASE 0
#endif
namespace pg8 {
#define PG8_LAS __attribute__((address_space(3)))
typedef unsigned short bf16_t;
typedef short bf16x8 __attribute__((ext_vector_type(8)));
typedef float f32x4 __attribute__((ext_vector_type(4)));
typedef unsigned u32x4 __attribute__((ext_vector_type(4)));
constexpr int BM = 256, BK = 64, HALF = 128, HTB = HALF * BK * 2  , STAGE_BYTES = 8 * HTB, NXCD = 8, WGM = 8;

__host__ __device__ __forceinline__ int lds_byte(int r, int c) { const int st = (r >> 4) * 2 + (c >> 5), rr = r & 15, cc = c & 31, ob = rr * 64 + cc * 2; return st * 1024 + (ob ^ (((ob >> 9) & 1) << 5)); }
__host__ __device__ __forceinline__ void stage_rc(int b, int& R, int& C) { const int st = b / 1024, sb = b % 1024, swz = sb ^ (((sb >> 9) & 1) << 5); R = (st >> 1) * 16 + swz / 64; C = (st & 1) * 32 + (swz % 64) / 2; }
__host__ __device__ __forceinline__ int perm32(int rho) { const int n = rho >> 4, i = rho & 15; return 8 * (i >> 2) + 4 * n + (i & 3); }

struct Unit { int pm, pn; };
struct Gemm { const bf16_t* A; const bf16_t* Bt; int M, N, K; };

struct StaticOrder {
    int nM, nN, nwg, G, c;
    __host__ __device__ void init(int M, int N, int G_, int c_) { nM = M / BM; nN = N / BM; nwg = nM * nN; G = G_; c = c_; }
    __host__ __device__ bool next(int i, Unit& u) const {
        const long L = (long)i * G + c; if (L >= nwg) return false;
        int wgid = (int)L; { const int q = nwg / NXCD, r = nwg % NXCD, xcd = wgid % NXCD, off = wgid / NXCD; wgid = (xcd < r ? xcd * (q + 1) : r * (q + 1) + (xcd - r) * q) + off; }
        const int nig = WGM * nN, gid = wgid / nig, fm = gid * WGM, gsz = (nM - fm) < WGM ? (nM - fm) : WGM;
        u.pm = fm + ((wgid % nig) % gsz); u.pn = (wgid % nig) / gsz; return true;
    }
    __device__ __forceinline__ void a_ready(const Unit&) const {}
    __device__ __forceinline__ void done(const Unit&) const {}
};

__device__ __forceinline__ unsigned cvt_pk_bf16(float lo, float hi) { unsigned r; asm volatile("v_cvt_pk_bf16_f32 %0, %1, %2" : "=v"(r) : "v"(lo), "v"(hi)); return r; }
typedef float f32x2 __attribute__((ext_vector_type(2)));
typedef unsigned u32x2 __attribute__((ext_vector_type(2)));
struct EpiProj {
    static constexpr bool PERM = true, AFTER_DRAIN = false;
    bf16_t* O; float* dtraw;
    __device__ __forceinline__ void operator()(const f32x4 (&acc)[2][2][4][2], const Unit& u, int wr, int wc, int fr, int fq) const {
        const int row0 = u.pm * BM + wr * 64 + fr, col0 = u.pn * BM + wc * 32 + 8 * fq;
#pragma unroll
        for (int ai = 0; ai < 2; ++ai)
#pragma unroll
            for (int m = 0; m < 4; ++m) { const int row = row0 + ai * HALF + m * 16; bf16_t* rowp = O + (size_t)row * 2304 + col0;
#pragma unroll
                for (int bj = 0; bj < 2; ++bj) { const f32x4 v0 = acc[ai][bj][m][0], v1 = acc[ai][bj][m][1];
                    u32x4 w; w.x = cvt_pk_bf16(v0[0], v0[1]); w.y = cvt_pk_bf16(v0[2], v0[3]); w.z = cvt_pk_bf16(v1[0], v1[1]); w.w = cvt_pk_bf16(v1[2], v1[3]);
                    *(u32x4*)(rowp + bj * HALF) = w;
                    if (col0 + bj * HALF == 2208) { *(f32x4*)(dtraw + (size_t)row * 8) = v0; *(f32x4*)(dtraw + (size_t)row * 8 + 4) = v1; } } }
    }
};
struct EpiQ {
    static constexpr bool PERM = false, AFTER_DRAIN = false;
    bf16_t* QP; bf16_t* QSN; bf16_t* QSR; const float* CS; float scl;
    __device__ __forceinline__ void operator()(const f32x4 (&acc)[2][2][4][2], const Unit& u, int wr, int wc, int fr, int fq) const {
        const int row0 = u.pm * BM + wr * 64 + fr;
#pragma unroll
        for (int ai = 0; ai < 2; ++ai)
#pragma unroll
            for (int m = 0; m < 4; ++m) { const int row = row0 + ai * HALF + m * 16; const bool isp = row < 16384; const int b = row >> 13, t = row & 8191, rs = row - 16384, l = rs & 3;
                if (u.pn < 2) {
#pragma unroll
                    for (int bj = 0; bj < 2; ++bj)
#pragma unroll
                        for (int n = 0; n < 2; ++n) { const int col = u.pn * BM + bj * HALF + wc * 32 + n * 16 + 4 * fq, h = col >> 6, d = col & 63; const f32x4 v = acc[ai][bj][m][n];
                            if (isp) { u32x2 w; w.x = cvt_pk_bf16(v[0] * scl, v[1] * scl); w.y = cvt_pk_bf16(v[2] * scl, v[3] * scl); *(u32x2*)(QP + ((size_t)(b * 8 + h) * 8192 + t) * 96 + d) = w; }
                            else { u32x2 w; w.x = cvt_pk_bf16(v[0], v[1]); w.y = cvt_pk_bf16(v[2], v[3]); *(u32x2*)(QSN + (size_t)rs * 512 + col) = w; } }
                } else {
                    const int pos = isp ? t : 8192 + l; const int i0 = 4 * fq;
                    const f32x4 c0 = *(const f32x4*)(CS + ((size_t)pos * 16 + i0) * 2), c1 = *(const f32x4*)(CS + ((size_t)pos * 16 + i0) * 2 + 4);
                    const float cs_[4] = {c0[0], c0[2], c1[0], c1[2]}, sn_[4] = {c0[1], c0[3], c1[1], c1[3]};
#pragma unroll
                    for (int bj = 0; bj < 2; ++bj) { const int h = 4 * bj + wc; const f32x4 x1 = acc[ai][bj][m][0], x2 = acc[ai][bj][m][1]; float o1[4], o2[4];
#pragma unroll
                        for (int j = 0; j < 4; ++j) { o1[j] = (x1[j] * cs_[j] - x2[j] * sn_[j]) * scl; o2[j] = (x1[j] * sn_[j] + x2[j] * cs_[j]) * scl; }
                        u32x2 w1, w2; w1.x = cvt_pk_bf16(o1[0], o1[1]); w1.y = cvt_pk_bf16(o1[2], o1[3]); w2.x = cvt_pk_bf16(o2[0], o2[1]); w2.y = cvt_pk_bf16(o2[2], o2[3]);
                        bf16_t* dst = isp ? QP + ((size_t)(b * 8 + h) * 8192 + t) * 96 + 64 + i0 : QSR + ((size_t)rs * 8 + h) * 32 + i0;
                        *(u32x2*)dst = w1; *(u32x2*)(dst + 16) = w2; }
                } }
    }
};
struct EpiKV {
    static constexpr bool PERM = true, AFTER_DRAIN = false;
    bf16_t* KP; bf16_t* VP;
    __device__ __forceinline__ void operator()(const f32x4 (&acc)[2][2][4][2], const Unit& u, int wr, int wc, int fr, int fq) const {
        const int row0 = u.pm * BM + wr * 64 + fr, col0 = u.pn * BM + wc * 32 + 8 * fq;
#pragma unroll
        for (int ai = 0; ai < 2; ++ai)
#pragma unroll
            for (int m = 0; m < 4; ++m) { const int row = row0 + ai * HALF + m * 16; const int b = row >> 13, t = row & 8191, tile = t >> 6, key = t & 63;
#pragma unroll
                for (int bj = 0; bj < 2; ++bj) { const int col = col0 + bj * HALF; const f32x4 v0 = acc[ai][bj][m][0], v1 = acc[ai][bj][m][1];
                    u32x4 w; w.x = cvt_pk_bf16(v0[0], v0[1]); w.y = cvt_pk_bf16(v0[2], v0[3]); w.z = cvt_pk_bf16(v1[0], v1[1]); w.w = cvt_pk_bf16(v1[2], v1[3]);
                    bf16_t* dst;
                    if (col < 512) { const int h = col >> 6, d = col & 63; dst = KP + ((((size_t)(b * 8 + h)) * 128 + tile) * 12 + (d >> 3)) * 512 + key * 8; }
                    else { const int cc = col - 512, h = cc >> 6, d = cc & 63; dst = VP + ((((size_t)(b * 8 + h)) * 128 + tile) * 2 + (d >> 5)) * 2048 + (key >> 4) * 512 + (key & 15) * 32 + (d & 31); }
                    *(u32x4*)dst = w; } }
    }
};
struct EpiRes {
    static constexpr bool PERM = false, AFTER_DRAIN = false;
    const float* baseP; const float* baseS; float* out; const float* ada; int goff;
    __device__ __forceinline__ void operator()(const f32x4 (&acc)[2][2][4][2], const Unit& u, int wr, int wc, int fr, int fq) const {
        const int row0 = u.pm * BM + wr * 64 + fr;
#pragma unroll
        for (int ai = 0; ai < 2; ++ai)
#pragma unroll
            for (int m = 0; m < 4; ++m) { const int row = row0 + ai * HALF + m * 16; const bool isp = row < 16384;
                const float* brow = isp ? baseP + (size_t)row * 1024 : baseS + (size_t)(row - 16384) * 1024;
                const float* g = ada + (size_t)(isp ? (row >> 13) : 2 + ((row - 16384) >> 2)) * 6144 + goff;
#pragma unroll
                for (int bj = 0; bj < 2; ++bj)
#pragma unroll
                    for (int n = 0; n < 2; ++n) { const int col = u.pn * BM + bj * HALF + wc * 32 + n * 16 + 4 * fq;
                        const f32x4 o = *(const f32x4*)(brow + col) + *(const f32x4*)(g + col) * acc[ai][bj][m][n];
                        *(f32x4*)(out + (size_t)row * 1024 + col) = o; } }
    }
};
struct EpiUp {
    static constexpr bool PERM = true, AFTER_DRAIN = false;
    bf16_t* O;
    __device__ __forceinline__ void operator()(const f32x4 (&acc)[2][2][4][2], const Unit& u, int wr, int wc, int fr, int fq) const {
        const int row0 = u.pm * BM + wr * 64 + fr, col0 = u.pn * BM + wc * 32 + 8 * fq;
#pragma unroll
        for (int ai = 0; ai < 2; ++ai)
#pragma unroll
            for (int m = 0; m < 4; ++m) { bf16_t* rowp = O + (size_t)(row0 + ai * HALF + m * 16) * 4096 + col0;
#pragma unroll
                for (int bj = 0; bj < 2; ++bj) { f32x4 v0 = acc[ai][bj][m][0], v1 = acc[ai][bj][m][1];
#pragma unroll
                    for (int j = 0; j < 4; ++j) { const float a = v0[j] > 0.f ? v0[j] : 0.f, b = v1[j] > 0.f ? v1[j] : 0.f; v0[j] = a * a; v1[j] = b * b; }
                    u32x4 w; w.x = cvt_pk_bf16(v0[0], v0[1]); w.y = cvt_pk_bf16(v0[2], v0[3]); w.z = cvt_pk_bf16(v1[0], v1[1]); w.w = cvt_pk_bf16(v1[2], v1[3]);
                    *(u32x4*)(rowp + bj * HALF) = w; } }
    }
};
template <class Epi, class Sched, bool ALIGN_EPI = false, bool SP2 = false>
__device__ __forceinline__ void gemm_phase(PG8_LAS unsigned char* lds, const Gemm g, const Sched& S, const Epi& E) {
    const int tid = threadIdx.x, wid = __builtin_amdgcn_readfirstlane(tid >> 6), lane = tid & 63, wr = wid >> 2, wc = wid & 3, fr = lane & 15, fq = lane >> 4;
    const int K = g.K, nt = K / BK;
    unsigned voffA[2], voffB[2];
#pragma unroll
    for (int i = 0; i < 2; ++i) { int R, C; stage_rc(tid * 16 + i * 8192, R, C); const int Rb = Epi::PERM ? ((R & ~31) + perm32(R & 31)) : R;
        voffA[i] = (unsigned)(R * K + C) * 2u; voffB[i] = (unsigned)(Rb * K + C) * 2u; }
    const size_t kstep = (size_t)(BK * 2);
    const size_t hstep = (size_t)HALF * K * 2;
    const size_t tstep = 2 * hstep;
    const unsigned ldsw = (unsigned)wid * 1024u;
    const int aoff = lds_byte(wr * 64 + fr, fq * 8), boff = lds_byte(wc * 32 + fr, fq * 8);
#define PG8_SA(b, h) (((b) * 2 + (h)) * HTB)
#define PG8_SB(b, h) ((4 + (b) * 2 + (h)) * HTB)
#define PG8_STAGE(bufoff, gbase, voff) do { _Pragma("unroll") for (int _i = 0; _i < 2; ++_i) \
        __builtin_amdgcn_global_load_lds((const unsigned*)((const char*)(gbase) + (voff)[_i]), (PG8_LAS unsigned*)(lds + (bufoff) + ldsw + _i * 8192), 16, 0, 0); } while (0)
#define PG8_LDA(dst, b, h) do { _Pragma("unroll") for (int m = 0; m < 4; ++m) _Pragma("unroll") for (int k = 0; k < 2; ++k) dst[m][k] = *(const PG8_LAS bf16x8*)(lds + PG8_SA(b, h) + aoff + m * 2048 + k * 1024); } while (0)
#define PG8_LDB(dst, b, h) do { _Pragma("unroll") for (int n = 0; n < 2; ++n) _Pragma("unroll") for (int k = 0; k < 2; ++k) dst[n][k] = *(const PG8_LAS bf16x8*)(lds + PG8_SB(b, h) + boff + n * 2048 + k * 1024); } while (0)
#define PG8_MMA(ai, bj, At, Bt) do { __builtin_amdgcn_s_setprio(1); _Pragma("unroll") for (int m = 0; m < 4; ++m) _Pragma("unroll") for (int n = 0; n < 2; ++n) _Pragma("unroll") for (int k = 0; k < 2; ++k) \
        acc[ai][bj][m][n] = __builtin_amdgcn_mfma_f32_16x16x32_bf16(Bt[n][k], At[m][k], acc[ai][bj][m][n], 0, 0, 0); __builtin_amdgcn_s_setprio(0); } while (0)
#define PG8_WAIT_V(n) asm volatile("s_waitcnt vmcnt(" #n ")" ::: "memory")
#define PG8_WAIT_L(n) asm volatile("s_waitcnt lgkmcnt(" #n ")" ::: "memory")
#define PG8_BAR __builtin_amdgcn_s_barrier()
#define PG8_SCHED __builtin_amdgcn_sched_barrier(0)
    Unit cur, nxt; int ui = 0;
    if (!S.next(0, cur)) return;
    f32x4 acc[2][2][4][2];
#pragma unroll
    for (int a = 0; a < 2; ++a)
#pragma unroll
        for (int b = 0; b < 2; ++b)
#pragma unroll
            for (int m = 0; m < 4; ++m)
#pragma unroll
                for (int n = 0; n < 2; ++n) acc[a][b][m][n] = (f32x4){0.f, 0.f, 0.f, 0.f};
    bf16x8 At[4][2], B0[2][2], B1[2][2];
    const char* cA = (const char*)g.A + (size_t)cur.pm * tstep; const char* cB = (const char*)g.Bt + (size_t)cur.pn * tstep;
    S.a_ready(cur);
    if constexpr (SP2) {
        PG8_STAGE(PG8_SB(0, 0), cB, voffB); PG8_STAGE(PG8_SB(0, 1), cB + hstep, voffB); PG8_STAGE(PG8_SA(0, 0), cA, voffA); PG8_STAGE(PG8_SA(0, 1), cA + hstep, voffA);
        if (wr == 1) PG8_BAR;
        PG8_WAIT_V(2); PG8_BAR;
        PG8_STAGE(PG8_SB(1, 0), cB + kstep, voffB); PG8_STAGE(PG8_SA(1, 0), cA + kstep, voffA); PG8_STAGE(PG8_SB(1, 1), cB + hstep + kstep, voffB);
        PG8_WAIT_V(6); PG8_BAR;
    } else {
        PG8_STAGE(PG8_SB(0, 0), cB, voffB); PG8_STAGE(PG8_SA(0, 0), cA, voffA); PG8_STAGE(PG8_SB(0, 1), cB + hstep, voffB); PG8_STAGE(PG8_SA(0, 1), cA + hstep, voffA);
        if (wr == 1) PG8_BAR;
        PG8_WAIT_V(4); PG8_BAR;
        PG8_STAGE(PG8_SB(1, 0), cB + kstep, voffB); PG8_STAGE(PG8_SA(1, 0), cA + kstep, voffA); PG8_STAGE(PG8_SB(1, 1), cB + hstep + kstep, voffB);
        PG8_WAIT_V(6); PG8_BAR;
    }
    for (;;) {
        const bool has_next = S.next(ui + 1, nxt);
        const char* nA = has_next ? (const char*)g.A + (size_t)nxt.pm * tstep : cA; const char* nB = has_next ? (const char*)g.Bt + (size_t)nxt.pn * tstep : cB;
        for (int t = 0; t < nt; t += 2) {
            const bool last = (t == nt - 2);
            const char* a1 = cA + (size_t)(t + 1) * kstep;
            const char* a2 = last ? nA : cA + (size_t)(t + 2) * kstep; const char* b2 = last ? nB : cB + (size_t)(t + 2) * kstep;
            const char* a3 = a2 + kstep; const char* b3 = b2 + kstep;
            if (last && has_next) S.a_ready(nxt);
            if constexpr (SP2) {
            PG8_LDB(B0, 0, 0); PG8_LDB(B1, 0, 1); PG8_SCHED; PG8_LDA(At, 0, 0); PG8_STAGE(PG8_SA(1, 1), a1 + hstep, voffA);
            PG8_WAIT_V(8); PG8_WAIT_L(0); PG8_BAR; PG8_MMA(0, 0, At, B0); PG8_MMA(0, 1, At, B1); PG8_BAR; PG8_SCHED;
            PG8_LDA(At, 0, 1); PG8_STAGE(PG8_SB(0, 0), b2, voffB); PG8_STAGE(PG8_SB(0, 1), b2 + hstep, voffB); PG8_STAGE(PG8_SA(0, 0), a2, voffA);
            PG8_WAIT_V(8); PG8_WAIT_L(0); PG8_BAR; PG8_MMA(1, 0, At, B0); PG8_MMA(1, 1, At, B1); PG8_BAR; PG8_SCHED;
            PG8_LDB(B0, 1, 0); PG8_LDB(B1, 1, 1); PG8_SCHED; PG8_LDA(At, 1, 0); PG8_STAGE(PG8_SA(0, 1), a2 + hstep, voffA);
            PG8_WAIT_V(8); PG8_WAIT_L(0); PG8_BAR; PG8_MMA(0, 0, At, B0); PG8_MMA(0, 1, At, B1); PG8_BAR; PG8_SCHED;
            PG8_LDA(At, 1, 1); PG8_STAGE(PG8_SB(1, 0), b3, voffB); PG8_STAGE(PG8_SB(1, 1), b3 + hstep, voffB); PG8_STAGE(PG8_SA(1, 0), a3, voffA);
            PG8_WAIT_V(8); PG8_WAIT_L(0); PG8_BAR; PG8_MMA(1, 0, At, B0); PG8_MMA(1, 1, At, B1); PG8_BAR; PG8_SCHED;
            } else {
            PG8_LDB(B0, 0, 0); PG8_SCHED; PG8_LDA(At, 0, 0); PG8_STAGE(PG8_SA(1, 1), a1 + hstep, voffA);
            PG8_WAIT_L(8); PG8_BAR; PG8_WAIT_L(0); PG8_MMA(0, 0, At, B0); PG8_BAR; PG8_SCHED;
            PG8_LDB(B1, 0, 1); PG8_STAGE(PG8_SB(0, 0), b2, voffB);
            PG8_BAR; PG8_WAIT_L(0); PG8_MMA(0, 1, At, B1); PG8_BAR;
            PG8_LDA(At, 0, 1); PG8_STAGE(PG8_SA(0, 0), a2, voffA);
            PG8_BAR; PG8_WAIT_L(0); PG8_MMA(1, 0, At, B0); PG8_BAR; PG8_SCHED;
            PG8_STAGE(PG8_SB(0, 1), b2 + hstep, voffB);
            PG8_WAIT_V(6); PG8_BAR; PG8_MMA(1, 1, At, B1); PG8_BAR;
            PG8_LDB(B0, 1, 0); PG8_SCHED; PG8_LDA(At, 1, 0); PG8_STAGE(PG8_SA(0, 1), a2 + hstep, voffA);
            PG8_WAIT_L(8); PG8_BAR; PG8_WAIT_L(0); PG8_MMA(0, 0, At, B0); PG8_BAR; PG8_SCHED;
            PG8_LDB(B1, 1, 1); PG8_STAGE(PG8_SB(1, 0), b3, voffB);
            PG8_BAR; PG8_WAIT_L(0); PG8_MMA(0, 1, At, B1); PG8_BAR;
            PG8_LDA(At, 1, 1); PG8_STAGE(PG8_SA(1, 0), a3, voffA);
            PG8_BAR; PG8_WAIT_L(0); PG8_MMA(1, 0, At, B0); PG8_BAR; PG8_SCHED;
            PG8_STAGE(PG8_SB(1, 1), b3 + hstep, voffB);
            PG8_WAIT_V(6); PG8_BAR; PG8_MMA(1, 1, At, B1); PG8_BAR;
            }
        }
        if constexpr (ALIGN_EPI) { if (wr == 0) PG8_BAR; }
        if constexpr (!Epi::AFTER_DRAIN) { E(acc, cur, wr, wc, fr, fq); S.done(cur); }
        if (!has_next) break;
#pragma unroll
        for (int a = 0; a < 2; ++a)
#pragma unroll
            for (int b = 0; b < 2; ++b)
#pragma unroll
                for (int m = 0; m < 4; ++m)
#pragma unroll
                    for (int n = 0; n < 2; ++n) acc[a][b][m][n] = (f32x4){0.f, 0.f, 0.f, 0.f};
        cur = nxt; cA = nA; cB = nB; ++ui;
        if constexpr (ALIGN_EPI) { if (wr == 1) PG8_BAR; }
    }
    PG8_WAIT_V(0);
    if constexpr (!ALIGN_EPI) { if (wr == 0) PG8_BAR; }
    PG8_BAR;
    if constexpr (Epi::AFTER_DRAIN) { E.fused(acc, cur, wr, wc, fr, fq, lds, wid, lane); S.done(cur); }
#undef PG8_SA
#undef PG8_SB
#undef PG8_STAGE
#undef PG8_LDA
#undef PG8_LDB
#undef PG8_MMA
#undef PG8_WAIT_V
#undef PG8_WAIT_L
#undef PG8_BAR
#undef PG8_SCHED
}
}
constexpr int DM = 1024, SEQ = 8192, MP = 16384, NSEQ = 128, MS = 512, MT = 16896, NPROJ = 2304, DFF = 4096;
constexpr float EPS = 1e-6f;
constexpr float SCL2 = 0.1472444460259031f;
constexpr size_t MiB = 1u << 20;
constexpr size_t WS_CTL = 0, CTL_ZERO_BYTES = 1 * MiB;
constexpr size_t WS_WIN = 2 * MiB, WS_WUQ = 7 * MiB, WS_WKV = 8 * MiB, WS_WOUT = 9 * MiB, WS_WUP = 11 * MiB, WS_WDOWN = 19 * MiB;
constexpr size_t WS_ADA = 27 * MiB, WS_ADAF = 31 * MiB, WS_CS = 33 * MiB, WS_DTRAW = 35 * MiB, WS_DT = 36 * MiB, WS_QSN = 37 * MiB, WS_QSR = 38 * MiB, WS_KRS = 38 * MiB + 512 * 1024;
constexpr size_t WS_OPART = 39 * MiB, WS_ML = 47 * MiB, WS_H1 = 48 * MiB, WS_PROJ = 82 * MiB, WS_XBC = 158 * MiB, WS_QN = 192 * MiB, WS_CKV = 206 * MiB;
constexpr size_t WS_QP = 216 * MiB, WS_KP = 240 * MiB, WS_VP = 264 * MiB, WS_YSSD = 280 * MiB, WS_OATT = 314 * MiB, WS_AMIX = 332 * MiB, WS_X1 = 366 * MiB, WS_U = 432 * MiB, WS_X2 = 564 * MiB, WS_SCH = 632 * MiB, WS_HP = 664 * MiB, WS_CD = 680 * MiB, WS_EACS = 681 * MiB, WS_PART = 682 * MiB, WS_END = 690 * MiB;
constexpr int CW_BAR = 4096;
constexpr size_t O_YP = 0, O_YS = 16777216, O_KVP = 17301504, O_KRP = 21495808, O_CVP = 22020096, O_SSP = 22026240, O_KVS = 22157312, O_KRS = 22288384, O_CVS = 22304768, O_SSS = 22697984, O_END = 31086592;
constexpr int PHASE_LDS = 143360, LDSCTL_OFF = PHASE_LDS, MISC_OFF = LDSCTL_OFF + 320, LDS_BYTES = 147456;
constexpr int NWAVES = 8, NPHASE = 13;

#define GAS __attribute__((address_space(1)))
#define LAS __attribute__((address_space(3)))
typedef unsigned short bf16;
typedef unsigned v4u __attribute__((ext_vector_type(4)));
typedef unsigned v2u __attribute__((ext_vector_type(2)));
typedef float f32x4 __attribute__((ext_vector_type(4)));
typedef float f32x16 __attribute__((ext_vector_type(16)));
typedef short bf16x8 __attribute__((ext_vector_type(8)));
typedef short s16x4 __attribute__((ext_vector_type(4)));
#define LDS_WAIT() asm volatile("s_waitcnt lgkmcnt(0)" ::: "memory")
__device__ __forceinline__ unsigned f2bf(float f) { unsigned u = __builtin_bit_cast(unsigned, f); return (u + 0x7fffu + ((u >> 16) & 1u)) >> 16; }
__device__ __forceinline__ unsigned pk2(float lo, float hi) { return f2bf(lo) | (f2bf(hi) << 16); }
__device__ __forceinline__ float bflo(unsigned w) { return __uint_as_float(w << 16); }
__device__ __forceinline__ float bfhi(unsigned w) { return __uint_as_float(w & 0xffff0000u); }
__device__ __forceinline__ float bf2f(bf16 v) { return __uint_as_float((unsigned)v << 16); }
__device__ __forceinline__ float wave_sum(float v) {
#pragma unroll
    for (int o = 1; o < 64; o <<= 1) v += __shfl_xor(v, o);
    return v;
}
__device__ __forceinline__ float siluf(float v) { return v / (1.f + __expf(-v)); }

__constant__ double ROPE_REV[16] = {0.15915494309189535, 0.08949940160889101, 0.050329212104487035, 0.0283021958306234, 0.015915494309189534, 0.008949940160889102, 0.005032921210448704, 0.00283021958306234,
    0.0015915494309189536, 0.0008949940160889102, 0.0005032921210448703, 0.00028302195830623395, 0.00015915494309189535, 8.949940160889102e-05, 5.0329212104487035e-05, 2.8302195830623396e-05};

#define XB_TMO      128
#define XB_XCNT(j)  (256  + 64 * (j))
#define XB_XSUB(j)  (1280 + 64 * (j))
#define XB_XGEN(j)  (2304 + 64 * (j))
#define XB_TOP      3328
#define XB_TOPGEN   3392
#define XCD_BAR_WORDS 3456
#define XB_SPIN_CAP (1u << 18)

__device__ __forceinline__ unsigned xb_ld(unsigned* p)              { return __hip_atomic_load(p, __ATOMIC_RELAXED, __HIP_MEMORY_SCOPE_AGENT); }
__device__ __forceinline__ unsigned xb_add(unsigned* p, unsigned v) { return __hip_atomic_fetch_add(p, v, __ATOMIC_RELAXED, __HIP_MEMORY_SCOPE_AGENT); }
__device__ __forceinline__ unsigned xb_xcc_id() { return (unsigned)__builtin_amdgcn_s_getreg((3 << 11) | 20) & 0xFu; }
#define XB_SPIN(cond, bar) do { unsigned _sp = 0; while (cond) { __builtin_amdgcn_s_sleep(1); \
    if ((++_sp & 255u) == 0u) { if (xb_ld(&(bar)[XB_TMO])) break; if (_sp > XB_SPIN_CAP) { atomicAdd(&(bar)[XB_TMO], 1u); break; } } } } while (0)

struct XcdBarrier {
    unsigned* bar; unsigned x;
    volatile LAS unsigned* st;
};

__device__ __forceinline__ XcdBarrier xcd_barrier_post(unsigned* bar, volatile LAS unsigned* st) {
    XcdBarrier b; b.bar = bar; b.x = xb_xcc_id(); b.st = st;
    if (threadIdx.x == 0) (void)xb_add(&bar[XB_XCNT(b.x)], 1u);
    return b;
}
__device__ __forceinline__ void xcd_barrier_complete(unsigned* bar, unsigned x, unsigned& nloc, unsigned& nx) {
    const unsigned G = gridDim.x * gridDim.y * gridDim.z;
    unsigned sum, cnt, mine, sp = 0u;
    for (;;) {
        sum = 0u; cnt = 0u; mine = 0u;
#pragma unroll
        for (unsigned j = 0; j < 16; ++j) { const unsigned c = xb_ld(&bar[XB_XCNT(j)]); sum += c; cnt += (c > 0u) ? 1u : 0u; mine = (j == x) ? c : mine; }
        if (sum == G) break;
        __builtin_amdgcn_s_sleep(1);
        if ((++sp & 255u) == 0u) { if (xb_ld(&bar[XB_TMO])) break; if (sp > XB_SPIN_CAP) { atomicAdd(&bar[XB_TMO], 1u); break; } }
    }
    nloc = mine > 0u ? mine : 1u; nx = cnt > 0u ? cnt : 1u;
}

__device__ __forceinline__ void xcd_barrier(const XcdBarrier& b) {
    asm volatile("s_waitcnt vmcnt(0)" ::: "memory");
    __syncthreads();
    if (threadIdx.x == 0) {
        unsigned* bar = b.bar;
        __builtin_amdgcn_s_waitcnt(0);
        unsigned nloc = b.st[0], nx = b.st[1];
        if (nloc == 0u) { xcd_barrier_complete(bar, b.x, nloc, nx); b.st[0] = nloc; b.st[1] = nx; }
        const unsigned old = xb_add(&bar[XB_XSUB(b.x)], 1u);
        const unsigned gen = old / nloc;
        if (old + 1u == (gen + 1u) * nloc) {
            __builtin_amdgcn_fence(__ATOMIC_RELEASE, "agent");
            asm volatile("s_waitcnt vmcnt(0)" ::: "memory");
            const unsigned og = xb_add(&bar[XB_TOP], 1u);
            const unsigned tg = og / nx;
            if (og + 1u == (tg + 1u) * nx) xb_add(&bar[XB_TOPGEN], 1u);
            else XB_SPIN(xb_ld(&bar[XB_TOPGEN]) == tg, bar);
            __builtin_amdgcn_fence(__ATOMIC_ACQUIRE, "agent");
            xb_add(&bar[XB_XGEN(b.x)], 1u);
            asm volatile("s_waitcnt vmcnt(0)" ::: "memory");
        } else {
            XB_SPIN(xb_ld(&bar[XB_XGEN(b.x)]) == gen, bar);
            __builtin_amdgcn_fence(__ATOMIC_ACQUIRE, "agent");
            asm volatile("s_waitcnt vmcnt(0)" ::: "memory");
        }
    }
    __syncthreads();
}

struct Args { const void* in[32]; float* out; unsigned char* ws; int ph_lo, ph_hi; };
struct Frame {
    LAS unsigned char* lds;
    volatile LAS unsigned* MISC;
    unsigned* ctl;
    int wave, vcu, G;
    const Args* ap;
    float* out; unsigned char* ws;
    __device__ __forceinline__ const void* inp(int k) const { asm volatile("" : "+s"(k)); return ap->in[k]; }
    __device__ __forceinline__ const float* xp() const { return (const float*)inp(0); }
    __device__ __forceinline__ const float* xs() const { return (const float*)inp(1); }
    __device__ __forceinline__ const float* cache_kv() const { return (const float*)inp(2); }
    __device__ __forceinline__ const float* cache_kr() const { return (const float*)inp(3); }
    __device__ __forceinline__ const float* sconv() const { return (const float*)inp(4); }
    __device__ __forceinline__ const float* sssm() const { return (const float*)inp(5); }
    __device__ __forceinline__ const int* ptab() const { return (const int*)inp(6); }
    __device__ __forceinline__ const float* cprm() const { return (const float*)inp(7); }
    __device__ __forceinline__ const float* csmp() const { return (const float*)inp(8); }
    __device__ __forceinline__ const float* w_ada() const { return (const float*)inp(9); }
    __device__ __forceinline__ const float* b_ada() const { return (const float*)inp(10); }
    __device__ __forceinline__ const float* g_mix() const { return (const float*)inp(11); }
    __device__ __forceinline__ const float* w_in() const { return (const float*)inp(12); }
    __device__ __forceinline__ const float* conv_w() const { return (const float*)inp(13); }
    __device__ __forceinline__ const float* conv_b() const { return (const float*)inp(14); }
    __device__ __forceinline__ const float* dt_bias() const { return (const float*)inp(15); }
    __device__ __forceinline__ const float* a_log() const { return (const float*)inp(16); }
    __device__ __forceinline__ const float* d_skip() const { return (const float*)inp(17); }
    __device__ __forceinline__ const float* g_ssd() const { return (const float*)inp(18); }
    __device__ __forceinline__ const float* g_q() const { return (const float*)inp(19); }
    __device__ __forceinline__ const float* g_kv() const { return (const float*)inp(20); }
    __device__ __forceinline__ const float* w_uq() const { return (const float*)inp(21); }
    __device__ __forceinline__ const float* w_uk() const { return (const float*)inp(22); }
    __device__ __forceinline__ const float* w_uv() const { return (const float*)inp(23); }
    __device__ __forceinline__ const float* g_attn() const { return (const float*)inp(24); }
    __device__ __forceinline__ const float* w_out() const { return (const float*)inp(25); }
    __device__ __forceinline__ const float* g_mlp() const { return (const float*)inp(26); }
    __device__ __forceinline__ const float* w_up() const { return (const float*)inp(27); }
    __device__ __forceinline__ const float* w_down() const { return (const float*)inp(28); }
    __device__ __forceinline__ const float* w_adaf() const { return (const float*)inp(29); }
    __device__ __forceinline__ const float* b_adaf() const { return (const float*)inp(30); }
    __device__ __forceinline__ const float* g_fin() const { return (const float*)inp(31); }
};
#define WSP(T, off) ((T*)(F.ws + (off)))

__device__ __forceinline__ int tid_fresh() { int t = threadIdx.x; asm volatile("" : "+v"(t)); return t; }
__device__ __forceinline__ int crow(int r, int hi) { return (r & 3) + 8 * (r >> 2) + 4 * hi; }
__device__ __forceinline__ unsigned cvtpk_s(float lo, float hi) { typedef float f2 __attribute__((ext_vector_type(2))); typedef __bf16 b2 __attribute__((ext_vector_type(2))); f2 v = {lo, hi}; b2 b = __builtin_convertvector(v, b2); return __builtin_bit_cast(unsigned, b); }
template <int MODE> __device__ __forceinline__ int srccol(int n) {
    if (MODE == 1) { if (n < 1536) return n; if (n < 2208) return n + 8; if (n < 2216) return n - 2208 + 1536; return -1; }
    if (MODE == 2) { return n < 512 ? (n >> 6) * 96 + (n & 63) : ((n - 512) >> 5) * 96 + 64 + ((n - 512) & 31); }
    return n;
}
template <int MODE> __device__ __forceinline__ void transpose_item(const float* W, int K, int Nsrc, bf16* WT, int nblk, LAS float* scr, int item, int lane) {
    const int kb = item / nblk, nb = item % nblk, k0 = 64 * kb, n0 = 32 * nb;
    const int sc = srccol<MODE>(n0 + (lane & 31));
#pragma unroll 8
    for (int i = 0; i < 32; ++i) { const int kk = 2 * i + (lane >> 5); scr[kk * 33 + (lane & 31)] = sc >= 0 ? W[(size_t)(k0 + kk) * Nsrc + sc] : 0.f; }
    LDS_WAIT(); asm volatile("" ::: "memory");
    const int c = lane & 7;
#pragma unroll
    for (int j = 0; j < 4; ++j) { const int n = (lane >> 3) + 8 * j; const LAS float* s = scr + (8 * c) * 33 + n;
        v4u o; o.x = pk2(s[0 * 33], s[1 * 33]); o.y = pk2(s[2 * 33], s[3 * 33]); o.z = pk2(s[4 * 33], s[5 * 33]); o.w = pk2(s[6 * 33], s[7 * 33]);
        *(v4u*)(WT + (size_t)(n0 + n) * K + k0 + 8 * c) = o; }
    LDS_WAIT(); asm volatile("" ::: "memory");
}

__device__ __forceinline__ void p0_prologue(Frame& F) {
    const int tid = tid_fresh(), lane = tid & 63;
    const int gw = F.vcu * NWAVES + F.wave, NGW = F.G * NWAVES;
    {
        constexpr int KST = 2064;
        if (tid == 0) *(LAS unsigned*)(F.lds + 139264) = 0u;
        __syncthreads();
        for (int slab = F.vcu; slab < 256; slab += F.G) {
            const int n0 = slab * 32; const bool fin = n0 >= 6144; const float* W = fin ? F.w_adaf() : F.w_ada(); const int Nw = fin ? 2048 : 6144; const int nb = fin ? n0 - 6144 : n0;
            __syncthreads();
            { const int c = tid & 31, kp = tid >> 5;
#pragma unroll 8
              for (int p = 0; p < 32; ++p) { const int k = 2 * (p * 16 + kp); const float w0 = W[(size_t)k * Nw + nb + c], w1 = W[(size_t)(k + 1) * Nw + nb + c]; *(LAS unsigned*)(F.lds + c * KST + k * 2) = pk2(w0, w1); } }
            __syncthreads();
            if (F.wave < 5) {
                const int r32 = lane & 31, hi = lane >> 5, m = 32 * F.wave + r32;
                const float* cp = m < 2 ? F.cprm() + m * 1024 : F.csmp() + (size_t)(m < 130 ? m - 2 : 0) * 1024; const bool valid = m < 130;
                f32x16 acc = {};
#pragma unroll 4
                for (int d0 = 0; d0 < 64; ++d0) {
                    const f32x4 a0 = *(const f32x4*)(cp + 16 * d0 + 8 * hi), a1 = *(const f32x4*)(cp + 16 * d0 + 8 * hi + 4);
                    v4u w; w.x = pk2(siluf(a0[0]), siluf(a0[1])); w.y = pk2(siluf(a0[2]), siluf(a0[3])); w.z = pk2(siluf(a1[0]), siluf(a1[1])); w.w = pk2(siluf(a1[2]), siluf(a1[3]));
                    if (!valid) w = (v4u){0u, 0u, 0u, 0u};
                    const bf16x8 bq = *(const LAS bf16x8*)(F.lds + r32 * KST + (16 * d0 + 8 * hi) * 2);
                    acc = __builtin_amdgcn_mfma_f32_32x32x16_bf16(__builtin_bit_cast(bf16x8, w), bq, acc, 0, 0, 0);
                }
                const float bias = fin ? F.b_adaf()[nb + r32] : F.b_ada()[nb + r32];
                float* O = fin ? WSP(float, WS_ADAF) : WSP(float, WS_ADA); const int No = fin ? 2048 : 6144;
#pragma unroll
                for (int r = 0; r < 16; ++r) { const int mm = 32 * F.wave + crow(r, hi); if (mm < 130) O[(size_t)mm * No + nb + r32] = acc[r] + bias; }
            }
        }
    }
    {
        LAS float* scr = (LAS float*)(F.lds + 67584 + F.wave * 8448);
        constexpr int I_IN = 16 * 72, I_UQ = 6 * 24, I_KV = 4 * 32, I_OUT = 16 * 32, I_UP = 16 * 128, I_DN = 64 * 32;
        constexpr int NITEMS = I_IN + I_UQ + I_KV + I_OUT + I_UP + I_DN;
        LAS unsigned* ctr = (LAS unsigned*)(F.lds + 139264);
        for (;;) {
            unsigned k_ = 0; if (lane == 0) k_ = __hip_atomic_fetch_add(ctr, 1u, __ATOMIC_RELAXED, __HIP_MEMORY_SCOPE_WORKGROUP); k_ = (unsigned)__builtin_amdgcn_readfirstlane((int)k_);
            const int it = F.vcu + (int)k_ * F.G; if (it >= NITEMS) break;
            int r = it;
            if (r < I_IN) { transpose_item<1>(F.w_in(), 1024, 2216, WSP(bf16, WS_WIN), 72, scr, r, lane); continue; } r -= I_IN;
            if (r < I_UQ) { transpose_item<2>(F.w_uq(), 384, 768, WSP(bf16, WS_WUQ), 24, scr, r, lane); continue; } r -= I_UQ;
            if (r < I_KV) { const int nb = r % 32, kb = r / 32;
                if (nb < 16) transpose_item<0>(F.w_uk(), 256, 512, WSP(bf16, WS_WKV), 16, scr, kb * 16 + nb, lane);
                else transpose_item<0>(F.w_uv(), 256, 512, WSP(bf16, WS_WKV) + 512 * 256, 16, scr, kb * 16 + (nb - 16), lane);
                continue; } r -= I_KV;
            if (r < I_OUT) { transpose_item<0>(F.w_out(), 1024, 1024, WSP(bf16, WS_WOUT), 32, scr, r, lane); continue; } r -= I_OUT;
            if (r < I_UP) { transpose_item<0>(F.w_up(), 1024, 4096, WSP(bf16, WS_WUP), 128, scr, r, lane); continue; } r -= I_UP;
            transpose_item<0>(F.w_down(), 4096, 1024, WSP(bf16, WS_WDOWN), 32, scr, r, lane);
        }
    }
    for (int idx = (F.vcu * 512 + tid); idx < 8196 * 16; idx += F.G * 512) {
        const int pos = idx >> 4, i = idx & 15; double rev = (double)pos * ROPE_REV[i]; rev -= __builtin_rint(rev); const float fr = (float)rev;
        WSP(float, WS_CS)[2 * idx] = __builtin_amdgcn_cosf(fr); WSP(float, WS_CS)[2 * idx + 1] = __builtin_amdgcn_sinf(fr);
    }
}

__device__ __forceinline__ const float* xrow_of(Frame& F, int m) { return m < MP ? F.xp() + (size_t)m * DM : F.xs() + (size_t)(m - MP) * DM; }
__device__ __forceinline__ int arow_of(int m) { return m < MP ? (m >> 13) : 2 + ((m - MP) >> 2); }

template <bool BF16OUT> __device__ __forceinline__ void norm_mod_row(const float* xr_, const float* g, const float* sc, const float* sh, void* orow, int lane) {
    const f32x4* xr = (const f32x4*)xr_ + lane;
    f32x4 v[4]; float s2 = 0.f;
#pragma unroll
    for (int j = 0; j < 4; ++j) { v[j] = xr[64 * j]; s2 += (v[j][0] * v[j][0] + v[j][1] * v[j][1]) + (v[j][2] * v[j][2] + v[j][3] * v[j][3]); }
    const float rstd = 1.f / sqrtf(wave_sum(s2) * (1.f / 1024.f) + EPS);
#pragma unroll
    for (int j = 0; j < 4; ++j) { const f32x4 gg = ((const f32x4*)g)[lane + 64 * j], cc = ((const f32x4*)sc)[lane + 64 * j], hh = ((const f32x4*)sh)[lane + 64 * j];
        f32x4 o;
#pragma unroll
        for (int e = 0; e < 4; ++e) o[e] = v[j][e] * rstd * gg[e] * (1.f + cc[e]) + hh[e];
        if (BF16OUT) { v2u w; w.x = pk2(o[0], o[1]); w.y = pk2(o[2], o[3]); ((v2u*)orow)[lane + 64 * j] = w; }
        else ((f32x4*)orow)[lane + 64 * j] = o; }
}

template <bool BF16OUT> __device__ __forceinline__ void reduce_norm_row(const float* base, const float* gate, const float* part, size_t plane, float* xout, const float* g, const float* sc, const float* sh, void* orow, int lane) {
    f32x4 v[4]; float s2 = 0.f;
#pragma unroll
    for (int j = 0; j < 4; ++j) { const int c = 4 * lane + 256 * j;
        const f32x4 p = (*(const f32x4*)(part + c) + *(const f32x4*)(part + plane + c)) + (*(const f32x4*)(part + 2 * plane + c) + *(const f32x4*)(part + 3 * plane + c));
        v[j] = *(const f32x4*)(base + c) + *(const f32x4*)(gate + c) * p;
        if (xout) *(f32x4*)(xout + c) = v[j];
        s2 += (v[j][0] * v[j][0] + v[j][1] * v[j][1]) + (v[j][2] * v[j][2] + v[j][3] * v[j][3]); }
    const float rstd = 1.f / sqrtf(wave_sum(s2) * (1.f / 1024.f) + EPS);
#pragma unroll
    for (int j = 0; j < 4; ++j) { const f32x4 gg = ((const f32x4*)g)[lane + 64 * j], cc = ((const f32x4*)sc)[lane + 64 * j], hh = ((const f32x4*)sh)[lane + 64 * j];
        f32x4 o;
#pragma unroll
        for (int e = 0; e < 4; ++e) o[e] = v[j][e] * rstd * gg[e] * (1.f + cc[e]) + hh[e];
        if (BF16OUT) { v2u w; w.x = pk2(o[0], o[1]); w.y = pk2(o[2], o[3]); ((v2u*)orow)[lane + 64 * j] = w; }
        else ((f32x4*)orow)[lane + 64 * j] = o; }
}
template <bool BF16OUT, class RowFn> __device__ __forceinline__ void norm_mod_rows4(const RowFn& rf, const float* g, int m0, int stride, int lane) {
    f32x4 v[4][4]; float s2[4];
#pragma unroll
    for (int i = 0; i < 4; ++i) { const f32x4* xr = (const f32x4*)rf.x(m0 + i * stride) + lane;
#pragma unroll
        for (int j = 0; j < 4; ++j) v[i][j] = xr[64 * j]; }
#pragma unroll
    for (int i = 0; i < 4; ++i) { float a = 0.f;
#pragma unroll
        for (int j = 0; j < 4; ++j) a += (v[i][j][0] * v[i][j][0] + v[i][j][1] * v[i][j][1]) + (v[i][j][2] * v[i][j][2] + v[i][j][3] * v[i][j][3]);
        s2[i] = a; }
#pragma unroll
    for (int o = 1; o < 64; o <<= 1) {
#pragma unroll
        for (int i = 0; i < 4; ++i) s2[i] += __shfl_xor(s2[i], o); }
#pragma unroll
    for (int i = 0; i < 4; ++i) { const int m = m0 + i * stride; const float rstd = 1.f / sqrtf(s2[i] * (1.f / 1024.f) + EPS); const float* sc = rf.sc(m); const float* sh = rf.sh(m); void* orow = rf.o(m);
#pragma unroll
        for (int j = 0; j < 4; ++j) { const f32x4 gg = ((const f32x4*)g)[lane + 64 * j], cc = ((const f32x4*)sc)[lane + 64 * j], hh = ((const f32x4*)sh)[lane + 64 * j];
            f32x4 o;
#pragma unroll
            for (int e = 0; e < 4; ++e) o[e] = v[i][j][e] * rstd * gg[e] * (1.f + cc[e]) + hh[e];
            if (BF16OUT) { v2u w; w.x = pk2(o[0], o[1]); w.y = pk2(o[2], o[3]); ((v2u*)orow)[lane + 64 * j] = w; }
            else ((f32x4*)orow)[lane + 64 * j] = o; } }
}

__device__ __forceinline__ void p3_row(Frame& F, int row, const int lane) {
    const bf16* PROJ = WSP(bf16, WS_PROJ); const bf16* P = PROJ + (size_t)row * NPROJ;
    const bool isp = row < MP; const int b = row >> 13, rs = row - MP, s = rs >> 2, l = rs & 3; const int t = isp ? (row & 8191) : l;
#pragma unroll
    for (int half = 0; half < 2; ++half) {
        const int c0 = half * 512 + 8 * lane;
        float acc[8], cur[8];
        { const f32x4 b0 = *(const f32x4*)(F.conv_b() + c0), b1 = *(const f32x4*)(F.conv_b() + c0 + 4);
#pragma unroll
          for (int e = 0; e < 4; ++e) { acc[e] = b0[e]; acc[4 + e] = b1[e]; } }
#pragma unroll
        for (int j = 0; j < 4; ++j) {
            const int tt = t - 3 + j; float xin[8];
            if (tt >= 0) { const v4u w = *(const v4u*)(PROJ + (size_t)(row - 3 + j) * NPROJ + 512 + c0);
                xin[0] = bflo(w.x); xin[1] = bfhi(w.x); xin[2] = bflo(w.y); xin[3] = bfhi(w.y); xin[4] = bflo(w.z); xin[5] = bfhi(w.z); xin[6] = bflo(w.w); xin[7] = bfhi(w.w); }
            else if (!isp) { const float* sp = F.sconv() + ((size_t)s * 3 + (3 + tt)) * 1024 + c0; const f32x4 a0 = *(const f32x4*)sp, a1 = *(const f32x4*)(sp + 4);
#pragma unroll
                for (int e = 0; e < 4; ++e) { xin[e] = a0[e]; xin[4 + e] = a1[e]; } }
            else {
#pragma unroll
                for (int e = 0; e < 8; ++e) xin[e] = 0.f; }
            const f32x4 w0 = *(const f32x4*)(F.conv_w() + j * 1024 + c0), w1 = *(const f32x4*)(F.conv_w() + j * 1024 + c0 + 4);
#pragma unroll
            for (int e = 0; e < 4; ++e) { acc[e] += w0[e] * xin[e]; acc[4 + e] += w1[e] * xin[4 + e]; }
            if (j == 3) {
#pragma unroll
                for (int e = 0; e < 8; ++e) cur[e] = xin[e]; }
        }
        v4u o; o.x = pk2(siluf(acc[0]), siluf(acc[1])); o.y = pk2(siluf(acc[2]), siluf(acc[3])); o.z = pk2(siluf(acc[4]), siluf(acc[5])); o.w = pk2(siluf(acc[6]), siluf(acc[7]));
        *(v4u*)(WSP(bf16, WS_XBC) + (size_t)row * 1024 + c0) = o;
        float* cdst = nullptr;
        if (isp) { if (t >= SEQ - 3) cdst = F.out + O_CVP + ((size_t)b * 3 + (t - (SEQ - 3))) * 1024 + c0; }
        else { if (l >= 1) cdst = F.out + O_CVS + ((size_t)s * 3 + (l - 1)) * 1024 + c0; }
        if (cdst) { *(f32x4*)cdst = (f32x4){cur[0], cur[1], cur[2], cur[3]}; *(f32x4*)(cdst + 4) = (f32x4){cur[4], cur[5], cur[6], cur[7]}; }
    }
    if (lane < 8) { const float x = WSP(float, WS_DTRAW)[(size_t)row * 8 + lane] + F.dt_bias()[lane]; WSP(float, WS_DT)[(size_t)row * 8 + lane] = x > 20.f ? x : log1pf(__expf(x)); }
    {
        float v[6]; float s2 = 0.f;
#pragma unroll
        for (int j = 0; j < 3; ++j) { const unsigned w = *(const unsigned*)(P + 1536 + 2 * lane + 128 * j); v[2 * j] = bflo(w); v[2 * j + 1] = bfhi(w); s2 += v[2 * j] * v[2 * j] + v[2 * j + 1] * v[2 * j + 1]; }
        const float rstd = 1.f / sqrtf(wave_sum(s2) * (1.f / 384.f) + EPS);
#pragma unroll
        for (int j = 0; j < 3; ++j) { const int c = 2 * lane + 128 * j; *(unsigned*)(WSP(bf16, WS_QN) + (size_t)row * 384 + c) = pk2(v[2 * j] * rstd * F.g_q()[c], v[2 * j + 1] * rstd * F.g_q()[c + 1]); }
    }
    {
        const v2u w = *(const v2u*)(P + 1920 + 4 * lane); float v[4] = {bflo(w.x), bfhi(w.x), bflo(w.y), bfhi(w.y)};
        const float s2 = (v[0] * v[0] + v[1] * v[1]) + (v[2] * v[2] + v[3] * v[3]);
        const float rstd = 1.f / sqrtf(wave_sum(s2) * (1.f / 256.f) + EPS);
        const f32x4 g = *(const f32x4*)(F.g_kv() + 4 * lane); f32x4 o;
#pragma unroll
        for (int e = 0; e < 4; ++e) o[e] = v[e] * rstd * g[e];
        float* od = isp ? F.out + O_KVP + (size_t)row * 256 + 4 * lane : F.out + O_KVS + (size_t)rs * 256 + 4 * lane;
        *(f32x4*)od = o;
        v2u q; q.x = pk2(o[0], o[1]); q.y = pk2(o[2], o[3]); *(v2u*)(WSP(bf16, WS_CKV) + (size_t)row * 256 + 4 * lane) = q;
    }
    if (lane < 32) {
        const int i = lane & 15; const float x1 = bf2f(P[2176 + i]), x2 = bf2f(P[2176 + 16 + i]);
        const int pos = isp ? t : SEQ + l; const float c = WSP(float, WS_CS)[((size_t)pos * 16 + i) * 2], sn = WSP(float, WS_CS)[((size_t)pos * 16 + i) * 2 + 1];
        const float val = lane < 16 ? x1 * c - x2 * sn : x1 * sn + x2 * c;
        if (isp) { F.out[O_KRP + (size_t)row * 32 + lane] = val; const bf16 vb = (bf16)f2bf(val);
#pragma unroll
            for (int h = 0; h < 8; ++h) WSP(bf16, WS_KP)[((((size_t)(b * 8 + h)) * 128 + (t >> 6)) * 12 + 8 + (lane >> 3)) * 512 + (t & 63) * 8 + (lane & 7)] = vb; }
        else { F.out[O_KRS + (size_t)rs * 32 + lane] = val; WSP(bf16, WS_KRS)[(size_t)rs * 32 + lane] = (bf16)f2bf(val); }
    }
}

struct P3R { v4u x[2][4]; unsigned q[3]; v2u kv; bf16 k1, k2; float dtr, cs, sn; };
__device__ __forceinline__ void p3_load(Frame& F, int row, const int lane, P3R& R) {
    const bf16* PROJ = WSP(bf16, WS_PROJ); const bf16* P = PROJ + (size_t)row * NPROJ; const int i = lane & 15, t = row & 8191;
#pragma unroll
    for (int half = 0; half < 2; ++half)
#pragma unroll
        for (int j = 0; j < 4; ++j) R.x[half][j] = *(const v4u*)(PROJ + (size_t)(row - 3 + j) * NPROJ + 512 + half * 512 + 8 * lane);
#pragma unroll
    for (int j = 0; j < 3; ++j) R.q[j] = *(const unsigned*)(P + 1536 + 2 * lane + 128 * j);
    R.kv = *(const v2u*)(P + 1920 + 4 * lane); R.k1 = P[2176 + i]; R.k2 = P[2176 + 16 + i];
    R.dtr = WSP(float, WS_DTRAW)[(size_t)row * 8 + (lane & 7)];
    R.cs = WSP(float, WS_CS)[((size_t)t * 16 + i) * 2]; R.sn = WSP(float, WS_CS)[((size_t)t * 16 + i) * 2 + 1];
}
__device__ __forceinline__ void p3_compute(Frame& F, int row, const int lane, const P3R& R) {
    const int b = row >> 13, t = row & 8191;
#pragma unroll
    for (int half = 0; half < 2; ++half) {
        const int c0 = half * 512 + 8 * lane;
        float acc[8];
        { const f32x4 b0 = *(const f32x4*)(F.conv_b() + c0), b1 = *(const f32x4*)(F.conv_b() + c0 + 4);
#pragma unroll
          for (int e = 0; e < 4; ++e) { acc[e] = b0[e]; acc[4 + e] = b1[e]; } }
#pragma unroll
        for (int j = 0; j < 4; ++j) { const v4u w = R.x[half][j];
            const float xin[8] = {bflo(w.x), bfhi(w.x), bflo(w.y), bfhi(w.y), bflo(w.z), bfhi(w.z), bflo(w.w), bfhi(w.w)};
            const f32x4 w0 = *(const f32x4*)(F.conv_w() + j * 1024 + c0), w1 = *(const f32x4*)(F.conv_w() + j * 1024 + c0 + 4);
#pragma unroll
            for (int e = 0; e < 4; ++e) { acc[e] += w0[e] * xin[e]; acc[4 + e] += w1[e] * xin[4 + e]; } }
        v4u o; o.x = cvtpk_s(siluf(acc[0]), siluf(acc[1])); o.y = cvtpk_s(siluf(acc[2]), siluf(acc[3])); o.z = cvtpk_s(siluf(acc[4]), siluf(acc[5])); o.w = cvtpk_s(siluf(acc[6]), siluf(acc[7]));
        *(v4u*)(WSP(bf16, WS_XBC) + (size_t)row * 1024 + c0) = o;
        if (t >= SEQ - 3) { float* cdst = F.out + O_CVP + ((size_t)b * 3 + (t - (SEQ - 3))) * 1024 + c0; const v4u w = R.x[half][3];
            *(f32x4*)cdst = (f32x4){bflo(w.x), bfhi(w.x), bflo(w.y), bfhi(w.y)}; *(f32x4*)(cdst + 4) = (f32x4){bflo(w.z), bfhi(w.z), bflo(w.w), bfhi(w.w)}; }
    }
    if (lane < 8) { const float x = R.dtr + F.dt_bias()[lane]; WSP(float, WS_DT)[(size_t)row * 8 + lane] = x > 20.f ? x : log1pf(__expf(x)); }
    {
        float v[6]; float s2 = 0.f;
#pragma unroll
        for (int j = 0; j < 3; ++j) { v[2 * j] = bflo(R.q[j]); v[2 * j + 1] = bfhi(R.q[j]); s2 += v[2 * j] * v[2 * j] + v[2 * j + 1] * v[2 * j + 1]; }
        const float vk[4] = {bflo(R.kv.x), bfhi(R.kv.x), bflo(R.kv.y), bfhi(R.kv.y)};
        float s2k = (vk[0] * vk[0] + vk[1] * vk[1]) + (vk[2] * vk[2] + vk[3] * vk[3]);
#pragma unroll
        for (int o = 1; o < 64; o <<= 1) { s2 += __shfl_xor(s2, o); s2k += __shfl_xor(s2k, o); }
        const float rstd = 1.f / sqrtf(s2 * (1.f / 384.f) + EPS), rstdk = 1.f / sqrtf(s2k * (1.f / 256.f) + EPS);
#pragma unroll
        for (int j = 0; j < 3; ++j) { const int c = 2 * lane + 128 * j; *(unsigned*)(WSP(bf16, WS_QN) + (size_t)row * 384 + c) = cvtpk_s(v[2 * j] * rstd * F.g_q()[c], v[2 * j + 1] * rstd * F.g_q()[c + 1]); }
        const f32x4 g = *(const f32x4*)(F.g_kv() + 4 * lane); f32x4 o;
#pragma unroll
        for (int e = 0; e < 4; ++e) o[e] = vk[e] * rstdk * g[e];
        *(f32x4*)(F.out + O_KVP + (size_t)row * 256 + 4 * lane) = o;
        v2u q; q.x = cvtpk_s(o[0], o[1]); q.y = cvtpk_s(o[2], o[3]); *(v2u*)(WSP(bf16, WS_CKV) + (size_t)row * 256 + 4 * lane) = q;
    }
    if (lane < 32) {
        const float x1 = bf2f(R.k1), x2 = bf2f(R.k2); const float val = lane < 16 ? x1 * R.cs - x2 * R.sn : x1 * R.sn + x2 * R.cs;
        F.out[O_KRP + (size_t)row * 32 + lane] = val; const bf16 vb = (bf16)f2bf(val);
#pragma unroll
        for (int h = 0; h < 8; ++h) WSP(bf16, WS_KP)[((((size_t)(b * 8 + h)) * 128 + (t >> 6)) * 12 + 8 + (lane >> 3)) * 512 + (t & 63) * 8 + (lane & 7)] = vb;
    }
}
__device__ __forceinline__ void p3_all(Frame& F, int gw, int NGW, const int lane) {
    P3R A, B; int m = gw;
#define P3_BULK(mm) (((mm) & 8191) >= 3)
    if (m < MP && P3_BULK(m)) p3_load(F, m, lane, A);
    while (m < MP) {
        const int m2 = m + NGW, m3 = m2 + NGW;
        if (m2 < MP && P3_BULK(m2)) p3_load(F, m2, lane, B);
        if (P3_BULK(m)) p3_compute(F, m, lane, A); else p3_row(F, m, lane);
        if (m3 < MP && P3_BULK(m3)) p3_load(F, m3, lane, A);
        if (m2 < MP) { if (P3_BULK(m2)) p3_compute(F, m2, lane, B); else p3_row(F, m2, lane); }
        m = m3;
    }
#undef P3_BULK
    for (int ms = MP + gw; ms < MT; ms += NGW) p3_row(F, ms, lane);
}

__device__ __forceinline__ void ssd_sample_unit(Frame& F, int u) {
    const int tid = tid_fresh(); const int s = u >> 3, h = u & 7, g = h >> 2, p = tid >> 3, nq = tid & 7;
    const float a = -__expf(F.a_log()[h]);
    const bf16* XBC = WSP(bf16, WS_XBC); const float* DT = WSP(float, WS_DT); float* Y = WSP(float, WS_YSSD);
    const size_t so = ((size_t)(s * 8 + h) * 64 + p) * 128 + 16 * nq;
    float st[16];
#pragma unroll
    for (int j = 0; j < 4; ++j) { const f32x4 v = *(const f32x4*)(F.sssm() + so + 4 * j); st[4 * j] = v[0]; st[4 * j + 1] = v[1]; st[4 * j + 2] = v[2]; st[4 * j + 3] = v[3]; }
#pragma unroll
    for (int t = 0; t < 4; ++t) {
        const size_t row = (size_t)MP + s * 4 + t; const float dtv = DT[row * 8 + h], xv = bf2f(XBC[row * 1024 + h * 64 + p]);
        const v4u b0 = *(const v4u*)(XBC + row * 1024 + 512 + g * 128 + 16 * nq), b1 = *(const v4u*)(XBC + row * 1024 + 512 + g * 128 + 16 * nq + 8);
        const v4u c0 = *(const v4u*)(XBC + row * 1024 + 768 + g * 128 + 16 * nq), c1 = *(const v4u*)(XBC + row * 1024 + 768 + g * 128 + 16 * nq + 8);
        const unsigned bw[8] = {b0.x, b0.y, b0.z, b0.w, b1.x, b1.y, b1.z, b1.w}, cw[8] = {c0.x, c0.y, c0.z, c0.w, c1.x, c1.y, c1.z, c1.w};
        const float dA = __expf(dtv * a), dx = dtv * xv; float part = 0.f;
#pragma unroll
        for (int j = 0; j < 8; ++j) { st[2 * j] = st[2 * j] * dA + dx * bflo(bw[j]); st[2 * j + 1] = st[2 * j + 1] * dA + dx * bfhi(bw[j]); part += st[2 * j] * bflo(cw[j]) + st[2 * j + 1] * bfhi(cw[j]); }
        part += __shfl_xor(part, 1); part += __shfl_xor(part, 2); part += __shfl_xor(part, 4);
        if (nq == 0) Y[row * 512 + h * 64 + p] = part;
    }
#pragma unroll
    for (int j = 0; j < 4; ++j) *(f32x4*)(F.out + O_SSS + so + 4 * j) = (f32x4){st[4 * j], st[4 * j + 1], st[4 * j + 2], st[4 * j + 3]};
}

__device__ __forceinline__ float rowmax32(const f32x16& p0, const f32x16& p1) {
    float a = __builtin_fmaxf(__builtin_fmaxf(p0[0], p0[1]), p1[0]), b = __builtin_fmaxf(__builtin_fmaxf(p0[2], p0[3]), p1[1]); a = __builtin_fmaxf(__builtin_fmaxf(a, p1[2]), p1[3]);
#pragma unroll
    for (int r = 4; r < 16; r += 4) { a = __builtin_fmaxf(__builtin_fmaxf(a, p0[r]), p0[r + 1]); b = __builtin_fmaxf(__builtin_fmaxf(b, p0[r + 2]), p0[r + 3]); a = __builtin_fmaxf(__builtin_fmaxf(a, p1[r]), p1[r + 1]); b = __builtin_fmaxf(__builtin_fmaxf(b, p1[r + 2]), p1[r + 3]); }
    a = __builtin_fmaxf(a, b);
    { auto rr = __builtin_amdgcn_permlane32_swap(__float_as_uint(a), __float_as_uint(a), false, false); return fmaxf(__uint_as_float(rr[0]), __uint_as_float(rr[1])); }
}
__device__ __forceinline__ void pv_block(f32x16& o, unsigned vb, bf16x8 pa0, bf16x8 pa1, bf16x8 pa2, bf16x8 pa3) {
    s16x4 lo[4], hi[4];
#pragma unroll
    for (int ks = 0; ks < 4; ++ks) {
        asm volatile("ds_read_b64_tr_b16 %0,%1 offset:%c2" : "=&v"(lo[ks]) : "v"(vb), "i"(ks * 1024) : "memory");
        asm volatile("ds_read_b64_tr_b16 %0,%1 offset:%c2" : "=&v"(hi[ks]) : "v"(vb), "i"(ks * 1024 + 512) : "memory"); }
    asm volatile("s_waitcnt lgkmcnt(0)" ::: "memory"); __builtin_amdgcn_sched_barrier(0);
#define PKV(k) (bf16x8){lo[k][0], lo[k][1], lo[k][2], lo[k][3], hi[k][0], hi[k][1], hi[k][2], hi[k][3]}
    o = __builtin_amdgcn_mfma_f32_32x32x16_bf16(pa0, PKV(0), o, 0, 0, 0);
    o = __builtin_amdgcn_mfma_f32_32x32x16_bf16(pa1, PKV(1), o, 0, 0, 0);
    o = __builtin_amdgcn_mfma_f32_32x32x16_bf16(pa2, PKV(2), o, 0, 0, 0);
    o = __builtin_amdgcn_mfma_f32_32x32x16_bf16(pa3, PKV(3), o, 0, 0, 0);
#undef PKV
}
__device__ __forceinline__ void softmax_step(f32x16& p0, f32x16& p1, float& m, float& l, float& alpha, bf16x8& pa0, bf16x8& pa1, bf16x8& pa2, bf16x8& pa3) {
    const float rm = rowmax32(p0, p1); const float mn = fmaxf(m, rm);
    alpha = __builtin_amdgcn_exp2f(m - mn); m = mn;
    typedef float f32x2_ __attribute__((ext_vector_type(2)));
    const f32x2_ mn2 = {mn, mn}; f32x2_ acc2 = {0.f, 0.f};
#pragma unroll
    for (int r = 0; r < 16; r += 2) { f32x2_ d0 = (f32x2_){p0[r], p0[r + 1]} - mn2, d1 = (f32x2_){p1[r], p1[r + 1]} - mn2;
        d0.x = __builtin_amdgcn_exp2f(d0.x); d0.y = __builtin_amdgcn_exp2f(d0.y); d1.x = __builtin_amdgcn_exp2f(d1.x); d1.y = __builtin_amdgcn_exp2f(d1.y);
        acc2 += d0; acc2 += d1; p0[r] = d0.x; p0[r + 1] = d0.y; p1[r] = d1.x; p1[r + 1] = d1.y; }
    l = l * alpha + (acc2.x + acc2.y);
    v4u w0, w1, w2, w3;
    w0.x = cvtpk_s(p0[0], p0[1]); w0.y = cvtpk_s(p0[2], p0[3]); w0.z = cvtpk_s(p0[4], p0[5]); w0.w = cvtpk_s(p0[6], p0[7]);
    w1.x = cvtpk_s(p0[8], p0[9]); w1.y = cvtpk_s(p0[10], p0[11]); w1.z = cvtpk_s(p0[12], p0[13]); w1.w = cvtpk_s(p0[14], p0[15]);
    w2.x = cvtpk_s(p1[0], p1[1]); w2.y = cvtpk_s(p1[2], p1[3]); w2.z = cvtpk_s(p1[4], p1[5]); w2.w = cvtpk_s(p1[6], p1[7]);
    w3.x = cvtpk_s(p1[8], p1[9]); w3.y = cvtpk_s(p1[10], p1[11]); w3.z = cvtpk_s(p1[12], p1[13]); w3.w = cvtpk_s(p1[14], p1[15]);
    pa0 = __builtin_bit_cast(bf16x8, w0); pa1 = __builtin_bit_cast(bf16x8, w1); pa2 = __builtin_bit_cast(bf16x8, w2); pa3 = __builtin_bit_cast(bf16x8, w3);
}

constexpr int AP_K = 0, AP_V = 24576, AP_WS = 40960;
__device__ __forceinline__ void attn_prompt_unit(Frame& F, int bh, int qb) {
    const int tid = tid_fresh(), lane = tid & 63, wid = F.wave, r32 = lane & 31, hi = lane >> 5;
    const int b = bh >> 3, h = bh & 7, q0 = qb * 256, NT = 4 * (qb + 1), qrel = wid * 32 + r32;
    const bf16* Qw = WSP(bf16, WS_QP) + ((size_t)bh * SEQ + q0 + wid * 32 + r32) * 96 + hi * 8;
    bf16x8 qr[6];
#pragma unroll
    for (int d0 = 0; d0 < 6; ++d0) qr[d0] = *(const bf16x8*)(Qw + d0 * 16);
    const v4u* Kg = (const v4u*)(WSP(bf16, WS_KP) + (size_t)bh * 128 * 6144);
    const v4u* Vg = (const v4u*)(WSP(bf16, WS_VP) + (size_t)bh * 128 * 4096);
    LAS unsigned char* L = F.lds;
    LAS float* wsf = (LAS float*)(L + AP_WS) + wid * 64;
    const unsigned vb0 = (unsigned)(size_t)(L + AP_V) + ((lane >> 4) & 1) * 32 + (lane & 3) * 8 + (4 * hi + ((lane & 15) >> 2)) * 64;
    v4u k0r = Kg[tid], k1r = (tid < 256) ? Kg[512 + tid] : (v4u){0u, 0u, 0u, 0u}, v0r = Vg[tid];
    float m = -1e30f, l = 0.f; f32x16 o0 = {}, o1 = {};
    for (int t = 0; t < NT; ++t) {
        const int buf = t & 1;
        LAS v4u* Kb = (LAS v4u*)(L + AP_K + buf * 12288); LAS v4u* Vb = (LAS v4u*)(L + AP_V + buf * 8192);
        Kb[tid] = k0r; if (tid < 256) Kb[512 + tid] = k1r; Vb[tid] = v0r;
        __syncthreads();
        if (t + 1 < NT) { k0r = Kg[(size_t)(t + 1) * 768 + tid]; if (tid < 256) k1r = Kg[(size_t)(t + 1) * 768 + 512 + tid]; v0r = Vg[(size_t)(t + 1) * 512 + tid]; }
        const int jb = t - (NT - 4);
        if (jb >= 0 && wid * 32 + 31 < 64 * jb) continue;
        const LAS unsigned char* kp = L + AP_K + buf * 12288 + hi * 1024 + r32 * 16;
        f32x16 p0 = {}, p1 = {};
#pragma unroll
        for (int d0 = 0; d0 < 6; ++d0) { const bf16x8 a0 = *(const LAS bf16x8*)(kp + d0 * 2048), a1 = *(const LAS bf16x8*)(kp + d0 * 2048 + 512);
            p0 = __builtin_amdgcn_mfma_f32_32x32x16_bf16(a0, qr[d0], p0, 0, 0, 0); p1 = __builtin_amdgcn_mfma_f32_32x32x16_bf16(a1, qr[d0], p1, 0, 0, 0); }
        if (jb >= 0) {
#pragma unroll
            for (int r = 0; r < 16; ++r) { const int kv = 64 * jb + crow(r, hi); if (kv > qrel) p0[r] = -INFINITY; if (kv + 32 > qrel) p1[r] = -INFINITY; } }
        float alpha; bf16x8 pa0, pa1, pa2, pa3;
        softmax_step(p0, p1, m, l, alpha, pa0, pa1, pa2, pa3);
        if (hi == 0) wsf[r32] = alpha;
        LDS_WAIT();
#pragma unroll
        for (int r = 0; r < 16; ++r) { const float f = wsf[crow(r, hi)]; o0[r] *= f; o1[r] *= f; }
        LDS_WAIT();
        const unsigned vb = vb0 + buf * 8192;
        pv_block(o0, vb, pa0, pa1, pa2, pa3);
        pv_block(o1, vb + 4096, pa0, pa1, pa2, pa3);
    }
    l += __shfl_xor(l, 32);
    if (hi == 0) wsf[32 + r32] = 1.f / l;
    LDS_WAIT();
    bf16* Ow = WSP(bf16, WS_OATT) + ((size_t)b * SEQ + q0 + wid * 32) * 512 + h * 64 + r32;
#pragma unroll
    for (int r = 0; r < 16; ++r) { const int qrow = crow(r, hi); const float f = wsf[32 + qrow]; Ow[(size_t)qrow * 512] = (bf16)f2bf(o0[r] * f); Ow[(size_t)qrow * 512 + 32] = (bf16)f2bf(o1[r] * f); }
    LDS_WAIT();
    __syncthreads();
}

constexpr int AD_KCS = 1040, AD_VDS = 4160, AD_QRS = 592;
constexpr int AD_K = 0, AD_V = 36 * AD_KCS  , AD_Q = AD_V + 8 * AD_VDS  , AD_WS = AD_Q + 32 * AD_QRS  , AD_QN = AD_WS + 8 * 256  ;
__device__ __forceinline__ void attn_decode_unit(Frame& F, int s, int split) {
    const int tid = tid_fresh(), lane = tid & 63, wid = F.wave, r32 = lane & 31, hi = lane >> 5;
    LAS unsigned char* L = F.lds;
    LAS float* wsf = (LAS float*)(L + AD_WS) + wid * 64;
    {
        LAS float* qn = (LAS float*)(L + AD_QN);
        for (int i = tid; i < 2048; i += 512) qn[i] = bf2f(WSP(bf16, WS_QSN)[(size_t)s * 2048 + i]);
        __syncthreads();
        const int r = tid & 255, lh = tid >> 8; const bf16* WK = WSP(bf16, WS_WKV);
        for (int h = 0; h < 8; ++h) { float a0 = 0.f, a1 = 0.f;
#pragma unroll 8
            for (int d = 0; d < 64; ++d) { const float w = bf2f(WK[(size_t)(h * 64 + d) * 256 + r]); a0 += w * qn[(2 * lh) * 512 + h * 64 + d]; a1 += w * qn[(2 * lh + 1) * 512 + h * 64 + d]; }
            *(LAS bf16*)(L + AD_Q + ((2 * lh) * 8 + h) * AD_QRS + r * 2) = (bf16)f2bf(a0 * SCL2); *(LAS bf16*)(L + AD_Q + ((2 * lh + 1) * 8 + h) * AD_QRS + r * 2) = (bf16)f2bf(a1 * SCL2); }
        for (int i = tid; i < 1024; i += 512) { const int row = i >> 5, j = i & 31; *(LAS bf16*)(L + AD_Q + row * AD_QRS + (256 + j) * 2) = WSP(bf16, WS_QSR)[((size_t)s * 32 + row) * 32 + j]; }
        __syncthreads();
    }
    const unsigned vb0 = (unsigned)(size_t)(L + AD_V) + wid * AD_VDS + ((lane >> 4) & 1) * 32 + (lane & 3) * 8 + (4 * hi + ((lane & 15) >> 2)) * 64;
    const LAS unsigned char* kp = L + AD_K + hi * AD_KCS + r32 * 16;
    const LAS unsigned char* qp = L + AD_Q + r32 * AD_QRS + hi * 16;
    float m = -1e30f, l = 0.f; f32x16 o = {};
    const int NTL = 64 + (split == 1 ? 1 : 0);
    f32x4 kreg[8], rreg;
#define AD_LOAD(tile) do { const int pg_ = F.ptab()[s * 64 + split * 32 + ((tile) >> 1)]; const size_t rb_ = (size_t)pg_ * 128 + ((tile) & 1) * 64; \
        _Pragma("unroll") for (int j = 0; j < 8; ++j) { const int g_ = j * 512 + tid; kreg[j] = *(const f32x4*)(F.cache_kv() + (rb_ + (g_ >> 6)) * 256 + (g_ & 63) * 4); } \
        rreg = *(const f32x4*)(F.cache_kr() + (rb_ + (tid >> 3)) * 32 + (tid & 7) * 4); } while (0)
    AD_LOAD(0);
    for (int t = 0; t < NTL; ++t) {
        __syncthreads();
        if (t < 64) {
#pragma unroll
            for (int j = 0; j < 8; ++j) { const int g = j * 512 + tid, key = g >> 6, i = g & 63; v2u w; w.x = pk2(kreg[j][0], kreg[j][1]); w.y = pk2(kreg[j][2], kreg[j][3]);
                *(LAS v2u*)(L + AD_K + (i >> 1) * AD_KCS + key * 16 + (i & 1) * 8) = w;
                *(LAS v2u*)(L + AD_V + (i >> 3) * AD_VDS + (key >> 4) * 1024 + (key & 15) * 64 + (i & 7) * 8) = w; }
            { const int key = tid >> 3, i = tid & 7; v2u w; w.x = pk2(rreg[0], rreg[1]); w.y = pk2(rreg[2], rreg[3]); *(LAS v2u*)(L + AD_K + (32 + (i >> 1)) * AD_KCS + key * 16 + (i & 1) * 8) = w; }
        } else {
#pragma unroll
            for (int j = 0; j < 8; ++j) { const int g = j * 512 + tid, key = g >> 6, i = g & 63; v2u w = {0u, 0u}; if (key < 4) w = *(const v2u*)(WSP(bf16, WS_CKV) + ((size_t)MP + s * 4 + key) * 256 + 4 * i);
                *(LAS v2u*)(L + AD_K + (i >> 1) * AD_KCS + key * 16 + (i & 1) * 8) = w;
                *(LAS v2u*)(L + AD_V + (i >> 3) * AD_VDS + (key >> 4) * 1024 + (key & 15) * 64 + (i & 7) * 8) = w; }
            { const int key = tid >> 3, i = tid & 7; v2u w = {0u, 0u}; if (key < 4) w = *(const v2u*)(WSP(bf16, WS_KRS) + ((size_t)s * 4 + key) * 32 + 4 * i); *(LAS v2u*)(L + AD_K + (32 + (i >> 1)) * AD_KCS + key * 16 + (i & 1) * 8) = w; }
        }
        __syncthreads();
        if (t + 1 < 64) AD_LOAD(t + 1);
        f32x16 p0 = {}, p1 = {};
#pragma unroll 6
        for (int d0 = 0; d0 < 18; ++d0) { const bf16x8 a0 = *(const LAS bf16x8*)(kp + d0 * 2 * AD_KCS), a1 = *(const LAS bf16x8*)(kp + d0 * 2 * AD_KCS + 512), bq = *(const LAS bf16x8*)(qp + d0 * 32);
            p0 = __builtin_amdgcn_mfma_f32_32x32x16_bf16(a0, bq, p0, 0, 0, 0); p1 = __builtin_amdgcn_mfma_f32_32x32x16_bf16(a1, bq, p1, 0, 0, 0); }
        if (t == 64) {
#pragma unroll
            for (int r = 0; r < 16; ++r) { if (crow(r, hi) > (r32 >> 3)) p0[r] = -INFINITY; p1[r] = -INFINITY; } }
        float alpha; bf16x8 pa0, pa1, pa2, pa3;
        softmax_step(p0, p1, m, l, alpha, pa0, pa1, pa2, pa3);
        if (hi == 0) wsf[r32] = alpha;
        LDS_WAIT();
#pragma unroll
        for (int r = 0; r < 16; ++r) o[r] *= wsf[crow(r, hi)];
        LDS_WAIT();
        pv_block(o, vb0, pa0, pa1, pa2, pa3);
    }
#undef AD_LOAD
    l += __shfl_xor(l, 32);
    float* OP = WSP(float, WS_OPART) + ((size_t)(s * 2 + split) * 32) * 256 + wid * 32 + r32;
#pragma unroll
    for (int r = 0; r < 16; ++r) OP[(size_t)crow(r, hi) * 256] = o[r];
    if (wid == 0 && hi == 0) { float* ML = WSP(float, WS_ML) + ((size_t)(s * 2 + split) * 32 + r32) * 2; ML[0] = m; ML[1] = l; }
    __syncthreads();
}

__device__ __forceinline__ void p6_row(Frame& F, int row, const int lane) {
    bf16* A = WSP(bf16, WS_AMIX) + (size_t)row * 1024;
    {
        const float* y = WSP(float, WS_YSSD) + (size_t)row * 512; const bf16* z = WSP(bf16, WS_PROJ) + (size_t)row * NPROJ;
        float v[8]; float s2 = 0.f;
#pragma unroll
        for (int j = 0; j < 2; ++j) { f32x4 yy = *(const f32x4*)(y + 4 * lane + 256 * j); const v2u zz = *(const v2u*)(z + 4 * lane + 256 * j);
            const v2u xx = *(const v2u*)(WSP(bf16, WS_XBC) + (size_t)row * 1024 + 4 * lane + 256 * j); const float Dh = F.d_skip()[(4 * lane + 256 * j) >> 6];
            yy[0] += Dh * bflo(xx.x); yy[1] += Dh * bfhi(xx.x); yy[2] += Dh * bflo(xx.y); yy[3] += Dh * bfhi(xx.y);
            v[4 * j] = yy[0] * siluf(bflo(zz.x)); v[4 * j + 1] = yy[1] * siluf(bfhi(zz.x)); v[4 * j + 2] = yy[2] * siluf(bflo(zz.y)); v[4 * j + 3] = yy[3] * siluf(bfhi(zz.y)); }
#pragma unroll
        for (int e = 0; e < 8; ++e) s2 += v[e] * v[e];
        const float rstd = 1.f / sqrtf(wave_sum(s2) * (1.f / 512.f) + EPS);
#pragma unroll
        for (int j = 0; j < 2; ++j) { const f32x4 g = *(const f32x4*)(F.g_ssd() + 4 * lane + 256 * j); v2u w; w.x = pk2(v[4 * j] * rstd * g[0], v[4 * j + 1] * rstd * g[1]); w.y = pk2(v[4 * j + 2] * rstd * g[2], v[4 * j + 3] * rstd * g[3]);
            *(v2u*)(A + 4 * lane + 256 * j) = w; }
    }
    float v[8];
    { const bf16* o = WSP(bf16, WS_OATT) + (size_t)row * 512;
#pragma unroll
      for (int j = 0; j < 2; ++j) { const v2u w = *(const v2u*)(o + 4 * lane + 256 * j); v[4 * j] = bflo(w.x); v[4 * j + 1] = bfhi(w.x); v[4 * j + 2] = bflo(w.y); v[4 * j + 3] = bfhi(w.y); } }
    float s2 = 0.f;
#pragma unroll
    for (int e = 0; e < 8; ++e) s2 += v[e] * v[e];
    const float rstd = 1.f / sqrtf(wave_sum(s2) * (1.f / 512.f) + EPS);
#pragma unroll
    for (int j = 0; j < 2; ++j) { const f32x4 g = *(const f32x4*)(F.g_attn() + 4 * lane + 256 * j); v2u w; w.x = pk2(v[4 * j] * rstd * g[0], v[4 * j + 1] * rstd * g[1]); w.y = pk2(v[4 * j + 2] * rstd * g[2], v[4 * j + 3] * rstd * g[3]);
        *(v2u*)(A + 512 + 4 * lane + 256 * j) = w; }
}

__device__ __forceinline__ void sample_ov_tile(Frame& F, int tile, const int lane) {
    const int r32 = lane & 31, hi = lane >> 5, rb = tile >> 4, h = (tile >> 1) & 7, cb = tile & 1;
    const int rs = 32 * rb + r32, s = rs >> 2, q = (rs & 3) * 8 + h;
    const float* ml0 = WSP(float, WS_ML) + ((size_t)(s * 2 + 0) * 32 + q) * 2; const float* ml1 = WSP(float, WS_ML) + ((size_t)(s * 2 + 1) * 32 + q) * 2;
    const float m0 = ml0[0], l0 = ml0[1], m1 = ml1[0], l1 = ml1[1], M = fmaxf(m0, m1), e0 = __builtin_amdgcn_exp2f(m0 - M), e1 = __builtin_amdgcn_exp2f(m1 - M), inv = 1.f / (e0 * l0 + e1 * l1), w0 = e0 * inv, w1 = e1 * inv;
    const float* P0 = WSP(float, WS_OPART) + ((size_t)(s * 2 + 0) * 32 + q) * 256 + 8 * hi; const float* P1 = WSP(float, WS_OPART) + ((size_t)(s * 2 + 1) * 32 + q) * 256 + 8 * hi;
    const bf16* Bw = WSP(bf16, WS_WKV) + (size_t)(512 + h * 64 + 32 * cb + r32) * 256 + 8 * hi;
    f32x16 acc = {};
#pragma unroll 4
    for (int d0 = 0; d0 < 16; ++d0) {
        const f32x4 a0 = *(const f32x4*)(P0 + 16 * d0), a1 = *(const f32x4*)(P0 + 16 * d0 + 4), b0 = *(const f32x4*)(P1 + 16 * d0), b1 = *(const f32x4*)(P1 + 16 * d0 + 4);
        v4u w; w.x = pk2(a0[0] * w0 + b0[0] * w1, a0[1] * w0 + b0[1] * w1); w.y = pk2(a0[2] * w0 + b0[2] * w1, a0[3] * w0 + b0[3] * w1);
        w.z = pk2(a1[0] * w0 + b1[0] * w1, a1[1] * w0 + b1[1] * w1); w.w = pk2(a1[2] * w0 + b1[2] * w1, a1[3] * w0 + b1[3] * w1);
        const bf16x8 bq = *(const bf16x8*)(Bw + 16 * d0);
        acc = __builtin_amdgcn_mfma_f32_32x32x16_bf16(__builtin_bit_cast(bf16x8, w), bq, acc, 0, 0, 0);
    }
    bf16* O = WSP(bf16, WS_OATT) + ((size_t)MP + 32 * rb) * 512 + h * 64 + 32 * cb + r32;
#pragma unroll
    for (int r = 0; r < 16; ++r) O[(size_t)crow(r, hi) * 512] = (bf16)f2bf(acc[r]);
}

constexpr int SA_BKS = 2064, SA_BVS = 4112, SA_XVS = 4112;
constexpr int SA_BK = 0, SA_BV = 16 * SA_BKS  , SA_XV = SA_BV + 8 * SA_BVS  , SA_TAB = SA_XV + 16 * SA_XVS  ;
static_assert(SA_TAB + 6144 <= PHASE_LDS, "SSD chunk LDS map");
__device__ __forceinline__ bf16x8 tr_frag(unsigned addr) {
    s16x4 lo, hi;
    asm volatile("ds_read_b64_tr_b16 %0,%1" : "=&v"(lo) : "v"(addr) : "memory");
    asm volatile("ds_read_b64_tr_b16 %0,%1 offset:512" : "=&v"(hi) : "v"(addr) : "memory");
    asm volatile("s_waitcnt lgkmcnt(0)" ::: "memory");
    return (bf16x8){lo[0], lo[1], lo[2], lo[3], hi[0], hi[1], hi[2], hi[3]};
}
__device__ __forceinline__ void ssd_chunk_unit(Frame& F, int u) {
    const int tid = tid_fresh(), lane = tid & 63, wid = F.wave, r32 = lane & 31, hi = lane >> 5;
    const int b = u >> 7, c = (u >> 1) & 63, g = u & 1; const size_t row0 = (size_t)b * SEQ + c * 128;
    LAS unsigned char* L = F.lds; const bf16* XBC = WSP(bf16, WS_XBC);
    LAS float* T_acs = (LAS float*)(L + SA_TAB); LAS float* T_dt = T_acs + 512; LAS float* T_te = T_acs + 1024;
    __syncthreads();
#pragma unroll
    for (int k = 0; k < 4; ++k) { const int q = k * 512 + tid, j = q >> 4, c16 = q & 15; const v4u w = *(const v4u*)(XBC + (row0 + j) * 1024 + 512 + g * 128 + 8 * c16);
        *(LAS v4u*)(L + SA_BK + c16 * SA_BKS + j * 16) = w;
        *(LAS v4u*)(L + SA_BV + ((c16 >> 2) * 2 + (j >> 6)) * SA_BVS + ((j & 63) >> 4) * 1024 + (j & 15) * 64 + (c16 & 3) * 16) = w; }
#pragma unroll
    for (int k = 0; k < 8; ++k) { const int q = k * 512 + tid, j = q >> 5, c32 = q & 31; const v4u w = *(const v4u*)(XBC + (row0 + j) * 1024 + g * 256 + 8 * c32);
        *(LAS v4u*)(L + SA_XV + (((c32 >> 3) * 2 + ((c32 >> 2) & 1)) * 2 + (j >> 6)) * SA_XVS + ((j & 63) >> 4) * 1024 + (j & 15) * 64 + (c32 & 3) * 16) = w; }
    if (wid < 4) {
        const int hh = wid, h = g * 4 + hh; const float a = -__expf(F.a_log()[h]); const float* DT = WSP(float, WS_DT);
        const float d0 = DT[(row0 + 2 * lane) * 8 + h], d1 = DT[(row0 + 2 * lane + 1) * 8 + h];
        const float v0 = d0 * a, v1 = d1 * a, s = v0 + v1; float incl = s;
#pragma unroll
        for (int o = 1; o < 64; o <<= 1) { const float t = __shfl_up(incl, o); if (lane >= o) incl += t; }
        const float a0 = incl - s + v0, a1 = incl, tot = __shfl(incl, 63);
        T_acs[hh * 128 + 2 * lane] = a0; T_acs[hh * 128 + 2 * lane + 1] = a1; T_dt[hh * 128 + 2 * lane] = d0; T_dt[hh * 128 + 2 * lane + 1] = d1;
        T_te[hh * 128 + 2 * lane] = __expf(tot - a0) * d0; T_te[hh * 128 + 2 * lane + 1] = __expf(tot - a1) * d1;
        WSP(float, WS_EACS)[(row0 + 2 * lane) * 8 + h] = __expf(a0); WSP(float, WS_EACS)[(row0 + 2 * lane + 1) * 8 + h] = __expf(a1);
        if (lane == 63) WSP(float, WS_CD)[((size_t)b * 64 + c) * 8 + h] = __expf(incl);
    }
    __syncthreads();
    const int hh = wid >> 1, h = g * 4 + hh;
    const unsigned lanepart = ((lane >> 4) & 1) * 32 + (lane & 3) * 8 + (4 * hi + ((lane & 15) >> 2)) * 64;
    const unsigned lbase = (unsigned)(size_t)L;
#pragma unroll 1
    for (int ibi = 0; ibi < 2; ++ibi) {
        const int ib = (wid & 1) ? (ibi == 0 ? 1 : 2) : (ibi == 0 ? 0 : 3);
        const int i = 32 * ib + r32;
        bf16x8 cq[8];
#pragma unroll
        for (int d0 = 0; d0 < 8; ++d0) cq[d0] = *(const bf16x8*)(XBC + (row0 + i) * 1024 + 768 + g * 128 + 16 * d0 + 8 * hi);
        const float ai = T_acs[hh * 128 + i];
        f32x16 o0 = {}, o1 = {};
        for (int jt = 0; jt <= (ib >> 1); ++jt) {
            const LAS unsigned char* kp = L + SA_BK + hi * SA_BKS + (64 * jt + r32) * 16;
            f32x16 p0 = {}, p1 = {};
#pragma unroll
            for (int d0 = 0; d0 < 8; ++d0) { const bf16x8 a0 = *(const LAS bf16x8*)(kp + d0 * 2 * SA_BKS), a1 = *(const LAS bf16x8*)(kp + d0 * 2 * SA_BKS + 512);
                p0 = __builtin_amdgcn_mfma_f32_32x32x16_bf16(a0, cq[d0], p0, 0, 0, 0); p1 = __builtin_amdgcn_mfma_f32_32x32x16_bf16(a1, cq[d0], p1, 0, 0, 0); }
#pragma unroll
            for (int r = 0; r < 16; ++r) { const int j = 64 * jt + crow(r, hi), j2 = j + 32;
                p0[r] *= (j <= i) ? __expf(ai - T_acs[hh * 128 + j]) * T_dt[hh * 128 + j] : 0.f;
                p1[r] *= (j2 <= i) ? __expf(ai - T_acs[hh * 128 + j2]) * T_dt[hh * 128 + j2] : 0.f; }
            v4u w0, w1, w2, w3;
            w0.x = cvtpk_s(p0[0], p0[1]); w0.y = cvtpk_s(p0[2], p0[3]); w0.z = cvtpk_s(p0[4], p0[5]); w0.w = cvtpk_s(p0[6], p0[7]);
            w1.x = cvtpk_s(p0[8], p0[9]); w1.y = cvtpk_s(p0[10], p0[11]); w1.z = cvtpk_s(p0[12], p0[13]); w1.w = cvtpk_s(p0[14], p0[15]);
            w2.x = cvtpk_s(p1[0], p1[1]); w2.y = cvtpk_s(p1[2], p1[3]); w2.z = cvtpk_s(p1[4], p1[5]); w2.w = cvtpk_s(p1[6], p1[7]);
            w3.x = cvtpk_s(p1[8], p1[9]); w3.y = cvtpk_s(p1[10], p1[11]); w3.z = cvtpk_s(p1[12], p1[13]); w3.w = cvtpk_s(p1[14], p1[15]);
            const bf16x8 pa0 = __builtin_bit_cast(bf16x8, w0), pa1 = __builtin_bit_cast(bf16x8, w1), pa2 = __builtin_bit_cast(bf16x8, w2), pa3 = __builtin_bit_cast(bf16x8, w3);
            const unsigned vb = lbase + SA_XV + ((hh * 2 + 0) * 2 + jt) * SA_XVS + lanepart;
            pv_block(o0, vb, pa0, pa1, pa2, pa3);
            pv_block(o1, vb + 2 * SA_XVS, pa0, pa1, pa2, pa3);
        }
        float* Y = WSP(float, WS_YSSD) + (row0 + 32 * ib) * 512 + h * 64 + r32;
#pragma unroll
        for (int r = 0; r < 16; ++r) { Y[(size_t)crow(r, hi) * 512] = o0[r]; Y[(size_t)crow(r, hi) * 512 + 32] = o1[r]; }
    }
    {
        const int pb = wid & 1;
        f32x16 acc[4] = {};
#pragma unroll 2
        for (int ks = 0; ks < 8; ++ks) { const int jt = ks >> 2, rg = ks & 3, jb = 64 * jt + 16 * rg;
            const bf16x8 xa = tr_frag(lbase + SA_XV + ((hh * 2 + pb) * 2 + jt) * SA_XVS + rg * 1024 + lanepart);
            v4u w; const v4u xw = __builtin_bit_cast(v4u, xa);
            { const f32x4 t0 = *(const LAS f32x4*)(T_te + hh * 128 + jb + 4 * hi), t1 = *(const LAS f32x4*)(T_te + hh * 128 + jb + 8 + 4 * hi);
              w.x = cvtpk_s(bflo(xw.x) * t0[0], bfhi(xw.x) * t0[1]); w.y = cvtpk_s(bflo(xw.y) * t0[2], bfhi(xw.y) * t0[3]);
              w.z = cvtpk_s(bflo(xw.z) * t1[0], bfhi(xw.z) * t1[1]); w.w = cvtpk_s(bflo(xw.w) * t1[2], bfhi(xw.w) * t1[3]); }
            const bf16x8 af = __builtin_bit_cast(bf16x8, w);
#pragma unroll
            for (int nb = 0; nb < 4; ++nb) { const bf16x8 bfr = tr_frag(lbase + SA_BV + (nb * 2 + jt) * SA_BVS + rg * 1024 + lanepart);
                acc[nb] = __builtin_amdgcn_mfma_f32_32x32x16_bf16(af, bfr, acc[nb], 0, 0, 0); }
        }
        float* S = WSP(float, WS_SCH) + ((((size_t)b * 64 + c) * 8 + h) * 64 + 32 * pb) * 128 + r32;
#pragma unroll
        for (int nb = 0; nb < 4; ++nb)
#pragma unroll
            for (int r = 0; r < 16; ++r) S[(size_t)crow(r, hi) * 128 + 32 * nb] = acc[nb][r];
    }
}
__device__ __forceinline__ void ssd_scan(Frame& F) {
    const int tid = tid_fresh();
    const float* SCH = WSP(float, WS_SCH); const float* CD = WSP(float, WS_CD); bf16* HP = WSP(bf16, WS_HP);
    for (int e = F.vcu * 512 + tid; e < 131072; e += F.G * 512) {
        const int b = e >> 16, h = (e >> 13) & 7, pn = e & 8191;
        float H = 0.f;
        for (int c0 = 0; c0 < 64; c0 += 8) {
            float sv[8], dv[8];
#pragma unroll
            for (int k = 0; k < 8; ++k) { const size_t ci = ((size_t)b * 64 + c0 + k) * 8 + h; sv[k] = SCH[ci * 8192 + pn]; dv[k] = CD[ci]; }
#pragma unroll
            for (int k = 0; k < 8; ++k) { const size_t ci = ((size_t)b * 64 + c0 + k) * 8 + h; HP[ci * 8192 + pn] = (bf16)f2bf(H); H = dv[k] * H + sv[k]; }
        }
        F.out[O_SSP + ((size_t)(b * 8 + h)) * 8192 + pn] = H;
    }
}
__device__ __forceinline__ void ssd_off_unit(Frame& F, int u) {
    const int lane = tid_fresh() & 63, wid = F.wave, r32 = lane & 31, hi = lane >> 5;
    const int b = u >> 7, c = (u >> 1) & 63, g = u & 1; const size_t row0 = (size_t)b * SEQ + c * 128;
    if (c == 0) return;
    const bf16* XBC = WSP(bf16, WS_XBC); const int hh = wid >> 1, h = g * 4 + hh;
    const bf16* HPh = WSP(bf16, WS_HP) + (((size_t)b * 64 + c) * 8 + h) * 8192;
    const float* EA = WSP(float, WS_EACS);
#pragma unroll 1
    for (int ibi = 0; ibi < 2; ++ibi) {
        const int ib = (wid & 1) * 2 + ibi, i = 32 * ib + r32;
        bf16x8 ca[8];
#pragma unroll
        for (int d0 = 0; d0 < 8; ++d0) ca[d0] = *(const bf16x8*)(XBC + (row0 + i) * 1024 + 768 + g * 128 + 16 * d0 + 8 * hi);
        float ea[16];
#pragma unroll
        for (int r = 0; r < 16; ++r) ea[r] = EA[(row0 + 32 * ib + crow(r, hi)) * 8 + h];
#pragma unroll
        for (int pb = 0; pb < 2; ++pb) {
            f32x16 acc = {};
#pragma unroll
            for (int d0 = 0; d0 < 8; ++d0) { const bf16x8 bq = *(const bf16x8*)(HPh + (size_t)(32 * pb + r32) * 128 + 16 * d0 + 8 * hi); acc = __builtin_amdgcn_mfma_f32_32x32x16_bf16(ca[d0], bq, acc, 0, 0, 0); }
            float* Y = WSP(float, WS_YSSD) + (row0 + 32 * ib) * 512 + h * 64 + 32 * pb + r32;
#pragma unroll
            for (int r = 0; r < 16; ++r) Y[(size_t)crow(r, hi) * 512] += ea[r] * acc[r];
        }
    }
}

struct SEpiUp { bf16* U;
    __device__ __forceinline__ void operator()(int rs, int col, float v) const { const float a = v > 0.f ? v : 0.f; U[(size_t)(MP + rs) * 4096 + col] = (bf16)f2bf(a * a); } };
struct SEpiPart { float* P; int N;
    __device__ __forceinline__ void operator()(int rs, int col, float v) const { P[(size_t)rs * N + col] = v; } };
constexpr int SG_AS = 128 * 16 + 16, SG_BS = 64 * 16 + 16, SG_BUF = 8 * SG_AS + 8 * SG_BS;
template <int KS, class EPI> __device__ __forceinline__ void sgemm_sample(Frame& F, const bf16* A, const bf16* Bt, int N, int K, const EPI& epi0, float* part) {
    const int tid = tid_fresh(), lane = tid & 63, r32 = lane & 31, hi = lane >> 5, wid = F.wave, wm = wid & 3, wn = wid >> 2;
    LAS unsigned char* L = F.lds;
    const int ntn = N >> 6, nitems = 4 * ntn * KS, kchunk = K / KS, nch = kchunk >> 6;
    for (int it = F.vcu; it < nitems; it += F.G) {
        const int ks = it % KS, tile = it / KS, tm = tile & 3, tn = tile >> 2;
        const bf16* Ag0 = A + (size_t)(128 * tm + (tid >> 3)) * K + ks * kchunk + 8 * (tid & 7); const bf16* Ag1 = Ag0 + (size_t)64 * K;
        const bf16* Bg = Bt + (size_t)(64 * tn + (tid >> 3)) * K + ks * kchunk + 8 * (tid & 7);
        const int la0 = (tid & 7) * SG_AS + (tid >> 3) * 16, la1 = la0 + 64 * 16, lb = 8 * SG_AS + (tid & 7) * SG_BS + (tid >> 3) * 16;
        v4u ra0 = *(const v4u*)Ag0, ra1 = *(const v4u*)Ag1, rb = *(const v4u*)Bg;
        f32x16 acc = {};
        __syncthreads();
        for (int c = 0; c < nch; ++c) {
            LAS unsigned char* buf = L + (c & 1) * SG_BUF;
            *(LAS v4u*)(buf + la0) = ra0; *(LAS v4u*)(buf + la1) = ra1; *(LAS v4u*)(buf + lb) = rb;
            __syncthreads();
            if (c + 1 < nch) { ra0 = *(const v4u*)(Ag0 + 64 * (c + 1)); ra1 = *(const v4u*)(Ag1 + 64 * (c + 1)); rb = *(const v4u*)(Bg + 64 * (c + 1)); }
#pragma unroll
            for (int k4 = 0; k4 < 4; ++k4) { const bf16x8 a = *(const LAS bf16x8*)(buf + (2 * k4 + hi) * SG_AS + (32 * wm + r32) * 16), bq = *(const LAS bf16x8*)(buf + 8 * SG_AS + (2 * k4 + hi) * SG_BS + (32 * wn + r32) * 16);
                acc = __builtin_amdgcn_mfma_f32_32x32x16_bf16(a, bq, acc, 0, 0, 0); }
        }
        if (KS == 1) {
#pragma unroll
            for (int r = 0; r < 16; ++r) epi0(128 * tm + 32 * wm + crow(r, hi), 64 * tn + 32 * wn + r32, acc[r]);
        } else { const SEpiPart ep{part + (size_t)ks * 512 * N, N};
#pragma unroll
            for (int r = 0; r < 16; ++r) ep(128 * tm + 32 * wm + crow(r, hi), 64 * tn + 32 * wn + r32, acc[r]); }
    }
    __syncthreads();
}

constexpr int MG_AK = 0, MG_AV = 24576, MG_AWS = 40960, MG_IMG = 43008, MG_ROPE = 32768, MG_RCS = 1040, MG_IMGSZ = MG_ROPE + 4 * MG_RCS  , MG_Q = MG_IMG + 2 * MG_IMGSZ  ,
              MG_P = MG_Q + 32 * AD_QRS  , MG_PMAX = MG_P + 4096, MG_ALPHA = MG_PMAX + 256, MG_MBUF = MG_ALPHA + 128, MG_PGS = MG_MBUF + 256, MG_FLAG = MG_PGS + 128, MG_NEWK = MG_FLAG + 16, MG_END = MG_NEWK + 4 * 576;
static_assert(MG_END <= PHASE_LDS && MG_IMGSZ % 16 == 0 && MG_Q % 16 == 0 && MG_P % 16 == 0, "merged attention LDS map");
__device__ __forceinline__ unsigned dimg_off(unsigned row, unsigned ch) { const unsigned f = ((row & 3u) << 2) | ((row >> 2) & 3u); return 512u * row + 16u * ((ch & 16u) | ((ch ^ f) & 15u)); }
struct DecRegs { f32x4 k[4]; f32x4 r; };
__device__ __forceinline__ void dec_issue(LAS unsigned char* L, const float* ck, const float* cr, int x, int tid, DecRegs& R) {
    asm volatile("" : "+v"(tid));
    const int pg = ((const LAS int*)(L + MG_PGS))[x >> 2]; const size_t rb = (size_t)pg * 128 + (x & 3) * 32;
#pragma unroll
    for (int q = 0; q < 4; ++q) { const int g = q * 512 + tid; const float* a = ck + (rb + (g >> 6)) * 256 + (g & 63) * 4; asm volatile("global_load_dwordx4 %0, %1, off nt" : "=&v"(R.k[q]) : "v"(a) : "memory"); }
    { const float* a = cr + (rb + ((tid & 255) >> 3)) * 32 + (tid & 7) * 4; asm volatile("global_load_dwordx4 %0, %1, off nt" : "=&v"(R.r) : "v"(a) : "memory"); }
}
__device__ __forceinline__ void dec_write(const LAS unsigned char* nk, LAS unsigned char* img, int x, int tid, const DecRegs& R) {
    asm volatile("" : "+v"(tid));
    const int k0 = 32 * (x & 1);
    if (x < 128) {
#pragma unroll
        for (int q = 0; q < 4; ++q) { const int g = q * 512 + tid, key = k0 + (g >> 6), i = g & 63; v2u w; w.x = cvtpk_s(R.k[q][0], R.k[q][1]); w.y = cvtpk_s(R.k[q][2], R.k[q][3]);
            *(LAS v2u*)(img + dimg_off(key, i >> 1) + (i & 1) * 8) = w; }
        if (tid < 256) { const int key = k0 + (tid >> 3), i = tid & 7; v2u w; w.x = cvtpk_s(R.r[0], R.r[1]); w.y = cvtpk_s(R.r[2], R.r[3]); *(LAS v2u*)(img + MG_ROPE + (i >> 1) * MG_RCS + key * 16 + (i & 1) * 8) = w; }
    } else {
#pragma unroll
        for (int q = 0; q < 4; ++q) { const int g = q * 512 + tid, key = k0 + (g >> 6), i = g & 63; v2u w = {0u, 0u}; if (key < 4) w = *(const LAS v2u*)(nk + key * 576 + 8 * i);
            *(LAS v2u*)(img + dimg_off(key, i >> 1) + (i & 1) * 8) = w; }
        if (tid < 256) { const int key = k0 + (tid >> 3), i = tid & 7; v2u w = {0u, 0u}; if (key < 4) w = *(const LAS v2u*)(nk + key * 576 + 512 + 8 * i); *(LAS v2u*)(img + MG_ROPE + (i >> 1) * MG_RCS + key * 16 + (i & 1) * 8) = w; }
    }
}
__device__ __forceinline__ void dec_qk_softmax(LAS unsigned char* L, const LAS unsigned char* img, int lane, int hf, int j, bool newkeys) {
    asm volatile("" : "+v"(lane));
    const int r32 = lane & 31, hi = lane >> 5;
    const LAS unsigned char* qp = L + MG_Q + r32 * AD_QRS + hi * 16;
    const unsigned fk = ((r32 & 3u) << 2) | ((r32 >> 2) & 3u);
    const LAS unsigned char* krow = img + 512 * (32 * hf + r32);
    f32x16 p0 = {};
#pragma unroll 4
    for (int d0 = 0; d0 < 16; ++d0) { const unsigned ch = 2 * d0 + hi, co = 16u * ((ch & 16u) | ((ch ^ fk) & 15u));
        const bf16x8 a0 = *(const LAS bf16x8*)(krow + co), bq = *(const LAS bf16x8*)(qp + d0 * 32);
        p0 = __builtin_amdgcn_mfma_f32_32x32x16_bf16(a0, bq, p0, 0, 0, 0); }
#pragma unroll
    for (int d0 = 16; d0 < 18; ++d0) { const bf16x8 a0 = *(const LAS bf16x8*)(img + MG_ROPE + (2 * (d0 - 16) + hi) * MG_RCS + (32 * hf + r32) * 16), bq = *(const LAS bf16x8*)(qp + d0 * 32);
        p0 = __builtin_amdgcn_mfma_f32_32x32x16_bf16(a0, bq, p0, 0, 0, 0); }
    if (newkeys) {
#pragma unroll
        for (int r = 0; r < 16; ++r) if (hf != 0 || crow(r, hi) > (r32 >> 3)) p0[r] = -INFINITY; }
    float rm = __builtin_fmaxf(__builtin_fmaxf(p0[0], p0[1]), p0[2]);
#pragma unroll
    for (int r = 3; r < 15; r += 2) rm = __builtin_fmaxf(__builtin_fmaxf(rm, p0[r]), p0[r + 1]);
    rm = __builtin_fmaxf(rm, p0[15]);
    { auto rr = __builtin_amdgcn_permlane32_swap(__float_as_uint(rm), __float_as_uint(rm), false, false); rm = fmaxf(__uint_as_float(rr[0]), __uint_as_float(rr[1])); }
    LAS float* pmx = (LAS float*)(L + MG_PMAX); volatile LAS unsigned* flg = (volatile LAS unsigned*)(L + MG_FLAG); LAS float* mb = (LAS float*)(L + MG_MBUF);
    if (hi == 0) pmx[hf * 32 + r32] = rm;
    LDS_WAIT();
    if (lane == 0) flg[hf] = (unsigned)(j + 1);
    while (flg[1 - hf] != (unsigned)(j + 1)) __builtin_amdgcn_s_sleep(1);
    asm volatile("" ::: "memory");
    const float mo = mb[(j & 1) * 32 + r32], mn = fmaxf(mo, fmaxf(rm, pmx[(1 - hf) * 32 + r32]));
    if (hf == 0 && hi == 0) { ((LAS float*)(L + MG_ALPHA))[r32] = __builtin_amdgcn_exp2f(mo - mn); mb[((j + 1) & 1) * 32 + r32] = mn; }
#pragma unroll
    for (int r = 0; r < 16; ++r) p0[r] = __builtin_amdgcn_exp2f(p0[r] - mn);
    v4u w0, w1;
    w0.x = cvtpk_s(p0[0], p0[1]); w0.y = cvtpk_s(p0[2], p0[3]); w0.z = cvtpk_s(p0[4], p0[5]); w0.w = cvtpk_s(p0[6], p0[7]);
    w1.x = cvtpk_s(p0[8], p0[9]); w1.y = cvtpk_s(p0[10], p0[11]); w1.z = cvtpk_s(p0[12], p0[13]); w1.w = cvtpk_s(p0[14], p0[15]);
    *(LAS v4u*)(L + MG_P + (2 * hf) * 1024 + lane * 16) = w0; *(LAS v4u*)(L + MG_P + (2 * hf + 1) * 1024 + lane * 16) = w1;
}
__device__ __forceinline__ void dec_pv(LAS unsigned char* L, const LAS unsigned char* img, int lane, int wid, float& l, f32x16& o) {
    asm volatile("" : "+v"(lane));
    const int r32 = lane & 31, hi = lane >> 5;
    const LAS float* al = (const LAS float*)(L + MG_ALPHA);
    v4u pw[4];
#pragma unroll
    for (int ks = 0; ks < 4; ++ks) pw[ks] = *(const LAS v4u*)(L + MG_P + ks * 1024 + lane * 16);
    const unsigned blk = (lane >> 4) & 1, q = (lane & 15) >> 2, p = lane & 3;
    const unsigned ch = 4 * wid + 2 * blk + (p >> 1);
    const unsigned a_t0 = (unsigned)(size_t)img + dimg_off(4 * hi + q, ch) + 8 * (p & 1), a_t1 = (unsigned)(size_t)img + dimg_off(4 * hi + 8 + q, ch) + 8 * (p & 1);
    s16x4 lo[4], hh[4];
#pragma unroll
    for (int ks = 0; ks < 4; ++ks) {
        asm volatile("ds_read_b64_tr_b16 %0,%1 offset:%c2" : "=&v"(lo[ks]) : "v"(a_t0), "i"(ks * 8192) : "memory");
        asm volatile("ds_read_b64_tr_b16 %0,%1 offset:%c2" : "=&v"(hh[ks]) : "v"(a_t1), "i"(ks * 8192) : "memory"); }
    const float aq = al[r32];
#pragma unroll
    for (int r = 0; r < 16; ++r) o[r] *= al[crow(r, hi)];
    float sum = 0.f;
#pragma unroll
    for (int ks = 0; ks < 4; ++ks) sum += (bflo(pw[ks].x) + bfhi(pw[ks].x)) + (bflo(pw[ks].y) + bfhi(pw[ks].y)) + (bflo(pw[ks].z) + bfhi(pw[ks].z)) + (bflo(pw[ks].w) + bfhi(pw[ks].w));
    sum += __shfl_xor(sum, 32);
    l = l * aq + sum;
    asm volatile("s_waitcnt lgkmcnt(0)" ::: "memory"); __builtin_amdgcn_sched_barrier(0);
#define PKV(k) (bf16x8){lo[k][0], lo[k][1], lo[k][2], lo[k][3], hh[k][0], hh[k][1], hh[k][2], hh[k][3]}
    o = __builtin_amdgcn_mfma_f32_32x32x16_bf16(__builtin_bit_cast(bf16x8, pw[0]), PKV(0), o, 0, 0, 0);
    o = __builtin_amdgcn_mfma_f32_32x32x16_bf16(__builtin_bit_cast(bf16x8, pw[1]), PKV(1), o, 0, 0, 0);
    o = __builtin_amdgcn_mfma_f32_32x32x16_bf16(__builtin_bit_cast(bf16x8, pw[2]), PKV(2), o, 0, 0, 0);
    o = __builtin_amdgcn_mfma_f32_32x32x16_bf16(__builtin_bit_cast(bf16x8, pw[3]), PKV(3), o, 0, 0, 0);
#undef PKV
}
__device__ __forceinline__ void glds16(const void* gsrc, unsigned lds_dst) { unsigned keep;
    asm volatile("s_mov_b32 %0, m0\n\ts_mov_b32 m0, %2\n\ts_nop 0\n\tglobal_load_lds_dwordx4 %1, off\n\ts_mov_b32 m0, %0" : "=&s"(keep) : "v"(gsrc), "s"(lds_dst) : "memory"); }
__device__ __forceinline__ void att_tile(LAS unsigned char* L, int buf, int jb, int lane, int wid, const bf16x8 (&qr)[6], float& m, float& l, f32x16& o0, f32x16& o1) {
    asm volatile("" : "+v"(lane));
    const int r32 = lane & 31, hi = lane >> 5, qrel = wid * 32 + r32;
    if (jb >= 0 && wid * 32 + 31 < 64 * jb) return;
    LAS float* wsf = (LAS float*)(L + MG_AWS) + wid * 64;
    const LAS unsigned char* kp = L + MG_AK + buf * 12288 + hi * 1024 + r32 * 16;
    f32x16 p0 = {}, p1 = {};
#pragma unroll
    for (int d0 = 0; d0 < 6; ++d0) { const bf16x8 a0 = *(const LAS bf16x8*)(kp + d0 * 2048), a1 = *(const LAS bf16x8*)(kp + d0 * 2048 + 512);
        p0 = __builtin_amdgcn_mfma_f32_32x32x16_bf16(a0, qr[d0], p0, 0, 0, 0); p1 = __builtin_amdgcn_mfma_f32_32x32x16_bf16(a1, qr[d0], p1, 0, 0, 0); }
    if (jb >= 0) {
#pragma unroll
        for (int r = 0; r < 16; ++r) { const int kv = 64 * jb + crow(r, hi); if (kv > qrel) p0[r] = -INFINITY; if (kv + 32 > qrel) p1[r] = -INFINITY; } }
    float alpha; bf16x8 pa0, pa1, pa2, pa3;
    softmax_step(p0, p1, m, l, alpha, pa0, pa1, pa2, pa3);
    if (__any(alpha != 1.f)) {
        if (hi == 0) wsf[r32] = alpha;
        LDS_WAIT();
#pragma unroll
        for (int r = 0; r < 16; ++r) { const float f = wsf[crow(r, hi)]; o0[r] *= f; o1[r] *= f; }
        LDS_WAIT();
    }
    const unsigned vb = (unsigned)(size_t)(L + MG_AV) + buf * 8192 + ((lane >> 4) & 1) * 32 + (lane & 3) * 8 + (4 * hi + ((lane & 15) >> 2)) * 64;
    pv_block(o0, vb, pa0, pa1, pa2, pa3);
    pv_block(o1, vb + 4096, pa0, pa1, pa2, pa3);
}
#define DEC_PRE(g, RR) do { if ((MODE & 2) && !(MODE & 16) && (g) < 2 * NST) dec_write(L + MG_NEWK, L + MG_IMG + (((g) >> 1) & 1) * MG_IMGSZ, (g), tid, RR); } while (0)
#define DEC_POST(g, RR) do { const int j_ = (g) >> 1; \
        if (!(MODE & 4)) {} else if ((g) & 1) { if (j_ < NST) { const int hf_ = wid == ((2 * j_) & 7) ? 0 : (wid == ((2 * j_ + 1) & 7) ? 1 : -1); if (hf_ >= 0) dec_qk_softmax(L, L + MG_IMG + (j_ & 1) * MG_IMGSZ, lane, hf_, j_, j_ == 64); } } \
        else if (j_ >= 1 && j_ - 1 < NST) dec_pv(L, L + MG_IMG + ((j_ - 1) & 1) * MG_IMGSZ, lane, wid, ld, od); } while (0)
template <int MODE> __device__ __forceinline__ void p5_merged_round(Frame& F, int v) {
    const int tid = tid_fresh(), lane = tid & 63, wid = F.wave, r32 = lane & 31, hi = lane >> 5;
    LAS unsigned char* L = F.lds;
    const int s = v >> 1, split = v & 1, NST = 64 + (split == 1 ? 1 : 0);
    __syncthreads();
    {
        LAS float* qn = (LAS float*)L;
        for (int i = tid; i < 2048; i += 512) qn[i] = bf2f(WSP(bf16, WS_QSN)[(size_t)s * 2048 + i]);
        __syncthreads();
        const int r = tid & 255, lh = tid >> 8; const bf16* WK = WSP(bf16, WS_WKV);
        for (int h = 0; h < 8; ++h) { float a0 = 0.f, a1 = 0.f;
#pragma unroll 8
            for (int d = 0; d < 64; ++d) { const float w = bf2f(WK[(size_t)(h * 64 + d) * 256 + r]); a0 += w * qn[(2 * lh) * 512 + h * 64 + d]; a1 += w * qn[(2 * lh + 1) * 512 + h * 64 + d]; }
            *(LAS bf16*)(L + MG_Q + ((2 * lh) * 8 + h) * AD_QRS + r * 2) = (bf16)f2bf(a0 * SCL2); *(LAS bf16*)(L + MG_Q + ((2 * lh + 1) * 8 + h) * AD_QRS + r * 2) = (bf16)f2bf(a1 * SCL2); }
        for (int i = tid; i < 1024; i += 512) { const int row = i >> 5, j = i & 31; *(LAS bf16*)(L + MG_Q + row * AD_QRS + (256 + j) * 2) = WSP(bf16, WS_QSR)[((size_t)s * 32 + row) * 32 + j]; }
        if (tid < 288) { const int key = tid / 72, c = tid % 72;
            const v2u w = c < 64 ? *(const v2u*)(WSP(bf16, WS_CKV) + ((size_t)MP + s * 4 + key) * 256 + 4 * c) : *(const v2u*)(WSP(bf16, WS_KRS) + ((size_t)s * 4 + key) * 32 + 4 * (c - 64));
            *(LAS v2u*)(L + MG_NEWK + key * 576 + 8 * c) = w; }
        if (tid < 4) ((LAS unsigned*)(L + MG_FLAG))[tid] = 0u;
        if (tid < 32) { ((LAS float*)(L + MG_MBUF))[tid] = -1e30f; ((LAS float*)(L + MG_MBUF))[32 + tid] = -1e30f; ((LAS int*)(L + MG_PGS))[tid] = F.ptab()[s * 64 + split * 32 + tid]; }
        __syncthreads();
    }
    DecRegs RA, RB;
    const float* ck_ = F.cache_kv(); const float* cr_ = F.cache_kr();
    if (MODE & 2) { dec_issue(L, ck_, cr_, 0, tid, RA); dec_issue(L, ck_, cr_, 1, tid, RB); } else { RA.r = (f32x4){0.f, 0.f, 0.f, 0.f}; for (int q = 0; q < 4; ++q) RA.k[q] = RA.r; RB = RA; }
    float ld = 0.f; f32x16 od = {};
    int g = 0;
#pragma unroll 1
    for (int uu = 0; uu < 2; ++uu) {
        const int bh = v >> 4, qb = uu == 0 ? (v & 15) : 31 - (v & 15);
        const int b = bh >> 3, h = bh & 7, q0 = qb * 256, NT = 4 * (qb + 1), qrel = wid * 32 + r32;
        const bf16* Qw = WSP(bf16, WS_QP) + ((size_t)bh * SEQ + q0 + wid * 32 + r32) * 96 + hi * 8;
        bf16x8 qr[6];
#pragma unroll
        for (int d0 = 0; d0 < 6; ++d0) qr[d0] = *(const bf16x8*)(Qw + d0 * 16);
        asm volatile("" : "+v"(qr[0]), "+v"(qr[1]), "+v"(qr[2]), "+v"(qr[3]), "+v"(qr[4]), "+v"(qr[5]));
        const v4u* Kg = (const v4u*)(WSP(bf16, WS_KP) + (size_t)bh * 128 * 6144);
        const v4u* Vg = (const v4u*)(WSP(bf16, WS_VP) + (size_t)bh * 128 * 4096);
        LAS float* wsf = (LAS float*)(L + MG_AWS) + wid * 64;
#define ATT_DMA(tt, bb) do { glds16(Kg + (size_t)(tt) * 768 + wid * 64 + lane, (unsigned)__builtin_amdgcn_readfirstlane((int)(lbase_ + MG_AK + (bb) * 12288 + wid * 1024))); \
        glds16(Kg + (size_t)(tt) * 768 + (8 + (wid & 3)) * 64 + lane, (unsigned)__builtin_amdgcn_readfirstlane((int)(lbase_ + MG_AK + (bb) * 12288 + (8 + (wid & 3)) * 1024)));     \
        glds16(Vg + (size_t)(tt) * 512 + wid * 64 + lane, (unsigned)__builtin_amdgcn_readfirstlane((int)(lbase_ + MG_AV + (bb) * 8192 + wid * 1024))); } while (0)
        const unsigned lbase_ = (unsigned)(size_t)L;
        ATT_DMA(0, 0);
        float m = -1e30f, l = 0.f; f32x16 o0 = {}, o1 = {};
#pragma unroll 1
#define MG_STEP(tt, RR) do { \
            if ((MODE & 2) && (tt) >= 2 && g + 1 < 128) asm volatile("s_waitcnt vmcnt(8)" ::: "memory");     \
            else asm volatile("s_waitcnt vmcnt(0)" ::: "memory"); \
            asm volatile("" : "+v"(RR.k[0]), "+v"(RR.k[1]), "+v"(RR.k[2]), "+v"(RR.k[3]), "+v"(RR.r)); \
            DEC_PRE(g, RR); \
            if ((MODE & 2) && (tt) > 0 && g + 1 < 128) asm volatile("s_waitcnt vmcnt(5) lgkmcnt(0)\n\ts_barrier" ::: "memory"); \
            else asm volatile("s_waitcnt vmcnt(0) lgkmcnt(0)\n\ts_barrier" ::: "memory"); \
            if ((tt) + 1 < NT) ATT_DMA((tt) + 1, ((tt) + 1) & 1); \
            asm volatile("" ::: "memory"); \
            if ((MODE & 2) && g + 2 < 128) dec_issue(L, ck_, cr_, g + 2, tid, RR);     \
            asm volatile("" ::: "memory"); \
            if (MODE & 1) att_tile(L, (tt) & 1, (tt) - (NT - 4), lane, wid, qr, m, l, o0, o1); \
            DEC_POST(g, RR); ++g; } while (0)
        for (int t = 0; t < NT; t += 2) { MG_STEP(t, RA); MG_STEP(t + 1, RB); }
#undef MG_STEP
        l += __shfl_xor(l, 32);
        if (hi == 0) wsf[32 + r32] = 1.f / l;
        LDS_WAIT();
        bf16* Ow = WSP(bf16, (MODE & 8) ? WS_U : WS_OATT) + ((size_t)b * SEQ + q0 + wid * 32) * 512 + h * 64 + r32;
#pragma unroll
        for (int r = 0; r < 16; ++r) { const int qrow = crow(r, hi); const float f = wsf[32 + qrow]; Ow[(size_t)qrow * 512] = (bf16)f2bf(o0[r] * f); Ow[(size_t)qrow * 512 + 32] = (bf16)f2bf(o1[r] * f); }
        LDS_WAIT();
#undef ATT_DMA
    }
#pragma unroll 1
    for (; g <= 2 * NST; ) {
        asm volatile("s_waitcnt vmcnt(0)" ::: "memory"); asm volatile("" : "+v"(RA.k[0]), "+v"(RA.k[1]), "+v"(RA.k[2]), "+v"(RA.k[3]), "+v"(RA.r));
        DEC_PRE(g, RA); __syncthreads(); if ((MODE & 2) && g + 2 < 128) dec_issue(L, ck_, cr_, g + 2, tid, RA); DEC_POST(g, RA); ++g;
        asm volatile("s_waitcnt vmcnt(0)" ::: "memory"); asm volatile("" : "+v"(RB.k[0]), "+v"(RB.k[1]), "+v"(RB.k[2]), "+v"(RB.k[3]), "+v"(RB.r));
        DEC_PRE(g, RB); __syncthreads(); if ((MODE & 2) && g + 2 < 128) dec_issue(L, ck_, cr_, g + 2, tid, RB); DEC_POST(g, RB); ++g;
    }
    float* OP = WSP(float, (MODE & 8) ? WS_X2 : WS_OPART) + ((size_t)(s * 2 + split) * 32) * 256 + wid * 32 + r32;
#pragma unroll
    for (int r = 0; r < 16; ++r) OP[(size_t)crow(r, hi) * 256] = od[r];
    if (wid == 0 && hi == 0) { float* ML = WSP(float, (MODE & 8) ? WS_X2 + 16 * MiB : WS_ML) + ((size_t)(s * 2 + split) * 32 + r32) * 2; ML[0] = ((const LAS float*)(L + MG_MBUF))[(NST & 1) * 32 + r32]; ML[1] = ld; }
    __syncthreads();
}


#ifndef PROBE
#define PROBE (-1)
#endif
#define GWDEF const int gw = F.vcu * NWAVES + F.wave, NGW = F.G * NWAVES
__device__ __forceinline__ void ph0(Frame& F) { p0_prologue(F); }
struct RowsP1 { const float* xp; const float* xs; const float* ada; bf16* H;
    __device__ __forceinline__ const float* x(int m) const { return m < MP ? xp + (size_t)m * DM : xs + (size_t)(m - MP) * DM; }
    __device__ __forceinline__ const float* sc(int m) const { return ada + (size_t)arow_of(m) * 6144 + 1024; }
    __device__ __forceinline__ const float* sh(int m) const { return ada + (size_t)arow_of(m) * 6144; }
    __device__ __forceinline__ void* o(int m) const { return H + (size_t)m * 1024; } };
__device__ __forceinline__ void ph1(Frame& F) { GWDEF; const int lane = tid_fresh() & 63; const RowsP1 R{F.xp(), F.xs(), WSP(float, WS_ADA), WSP(bf16, WS_H1)}; const float* g = F.g_mix();
    for (int m = gw; m < MT; m += 4 * NGW) { if (m + 3 * NGW < MT) norm_mod_rows4<true>(R, g, m, NGW, lane); else for (int mm = m; mm < MT; mm += NGW) norm_mod_row<true>(R.x(mm), g, R.sc(mm), R.sh(mm), R.o(mm), lane); } }
__device__ __forceinline__ void ph2(Frame& F) { pg8::Gemm g{WSP(bf16, WS_H1), WSP(bf16, WS_WIN), MT, NPROJ, 1024}; pg8::StaticOrder S; S.init(MT, NPROJ, F.G, (int)blockIdx.x);
    pg8::EpiProj E{WSP(bf16, WS_PROJ), WSP(float, WS_DTRAW)};
    pg8::gemm_phase<pg8::EpiProj, pg8::StaticOrder, true, true>(F.lds, g, S, E); }
__device__ __forceinline__ void ph3(Frame& F) { GWDEF; const int lane = tid_fresh() & 63; p3_all(F, gw, NGW, lane); }
__device__ __forceinline__ void ph4_gemms(Frame& F) {
    { int Kk = 256; asm volatile("" : "+s"(Kk)); pg8::Gemm g{WSP(bf16, WS_CKV), WSP(bf16, WS_WKV), MP, 1024, Kk}; pg8::StaticOrder S; S.init(MP, 1024, F.G, (int)blockIdx.x);
      pg8::EpiKV E{WSP(bf16, WS_KP), WSP(bf16, WS_VP)};
      pg8::gemm_phase<pg8::EpiKV, pg8::StaticOrder, true, true>(F.lds, g, S, E); }
    __syncthreads();
    { int Kq = 384; asm volatile("" : "+s"(Kq)); pg8::Gemm g{WSP(bf16, WS_QN), WSP(bf16, WS_WUQ), MT, 768, Kq}; pg8::StaticOrder S; S.init(MT, 768, F.G, (int)blockIdx.x);
      pg8::EpiQ E{WSP(bf16, WS_QP), WSP(bf16, WS_QSN), WSP(bf16, WS_QSR), WSP(float, WS_CS), SCL2};
      pg8::gemm_phase<pg8::EpiQ, pg8::StaticOrder, true, true>(F.lds, g, S, E); } }
__device__ __forceinline__ void ph4_ssd(Frame& F) { for (int u = F.vcu; u < 256; u += F.G) ssd_chunk_unit(F, u); }
__device__ __forceinline__ void ph4(Frame& F) { ph4_gemms(F); if (PROBE == 25) ph4_gemms(F); ph4_ssd(F); if (PROBE == 26) ph4_ssd(F); }
__device__ __forceinline__ void ph5_a(Frame& F) { ssd_scan(F); for (int u = F.vcu; u < 1024; u += F.G) ssd_sample_unit(F, u); __syncthreads(); }
__device__ __forceinline__ void ph5_dec(Frame& F) { for (int u = F.vcu; u < 256; u += F.G) attn_decode_unit(F, u >> 1, u & 1); }
__device__ __forceinline__ void ph5_att(Frame& F) { for (int v = F.vcu; v < 256; v += F.G) { attn_prompt_unit(F, v >> 4, v & 15); attn_prompt_unit(F, v >> 4, 31 - (v & 15)); } }
__device__ __forceinline__ void ph5_m(Frame& F) { for (int v = F.vcu; v < 256; v += F.G) p5_merged_round<7>(F, v); }
#if PROBE >= 100
__device__ __forceinline__ void ph5_var(Frame& F) { for (int v = F.vcu; v < 256; v += F.G) p5_merged_round<(PROBE - 100) | 8>(F, v); }
#else
__device__ __forceinline__ void ph5_var(Frame& F) {}
#endif
#ifndef MERGED
#define MERGED 1
#endif
__device__ __forceinline__ void ph5(Frame& F) { ph5_a(F); if (PROBE == 20) ph5_a(F);
    if (MERGED) { ph5_m(F); if (PROBE == 23) ph5_m(F); if (PROBE >= 100) ph5_var(F); }
    else { ph5_dec(F); if (PROBE == 21) ph5_dec(F); ph5_att(F); if (PROBE == 22) ph5_att(F); } }
__device__ __forceinline__ void ph6(Frame& F) { { GWDEF; const int lane = tid_fresh() & 63; for (int t = gw; t < 256; t += NGW) sample_ov_tile(F, t, lane); }
    for (int u = F.vcu; u < 256; u += F.G) ssd_off_unit(F, u); }
__device__ __forceinline__ void ph7(Frame& F) { GWDEF; const int lane = tid_fresh() & 63; for (int m = gw; m < MT; m += NGW) p6_row(F, m, lane); }
__device__ __forceinline__ void ph8(Frame& F) { pg8::Gemm g{WSP(bf16, WS_AMIX), WSP(bf16, WS_WOUT), MP, 1024, 1024}; pg8::StaticOrder S; S.init(MP, 1024, F.G, (int)blockIdx.x);
    pg8::EpiRes E{F.xp(), F.xs(), WSP(float, WS_X1), WSP(float, WS_ADA), 2048};
    pg8::gemm_phase<pg8::EpiRes, pg8::StaticOrder, true, true>(F.lds, g, S, E);
    __syncthreads();
    SEpiUp SE{nullptr};
    sgemm_sample<4, SEpiUp>(F, WSP(bf16, WS_AMIX) + (size_t)MP * 1024, WSP(bf16, WS_WOUT), 1024, 1024, SE, WSP(float, WS_PART)); }
struct RowsP9 { const float* X1; const float* ada; bf16* H;
    __device__ __forceinline__ const float* x(int m) const { return X1 + (size_t)m * 1024; }
    __device__ __forceinline__ const float* sc(int m) const { return ada + (size_t)arow_of(m) * 6144 + 4096; }
    __device__ __forceinline__ const float* sh(int m) const { return ada + (size_t)arow_of(m) * 6144 + 3072; }
    __device__ __forceinline__ void* o(int m) const { return H + (size_t)m * 1024; } };
__device__ __forceinline__ void ph9(Frame& F) { GWDEF; const int lane = tid_fresh() & 63; const RowsP9 R{WSP(float, WS_X1), WSP(float, WS_ADA), WSP(bf16, WS_H1)}; const float* g = F.g_mlp();
    for (int rs = gw; rs < MS; rs += NGW) { const int m = MP + rs; const float* a = WSP(float, WS_ADA) + (size_t)arow_of(m) * 6144;
        reduce_norm_row<true>(F.xs() + (size_t)rs * 1024, a + 2048, WSP(float, WS_PART) + (size_t)rs * 1024, (size_t)512 * 1024, WSP(float, WS_X1) + (size_t)m * 1024, g, a + 4096, a + 3072, R.o(m), lane); }
    for (int m = gw; m < MP; m += 4 * NGW) { if (m + 3 * NGW < MP) norm_mod_rows4<true>(R, g, m, NGW, lane); else for (int mm = m; mm < MP; mm += NGW) norm_mod_row<true>(R.x(mm), g, R.sc(mm), R.sh(mm), R.o(mm), lane); } }
__device__ __forceinline__ void ph10(Frame& F) { pg8::Gemm g{WSP(bf16, WS_H1), WSP(bf16, WS_WUP), MP, DFF, 1024}; pg8::StaticOrder S; S.init(MP, DFF, F.G, (int)blockIdx.x);
    pg8::EpiUp E{WSP(bf16, WS_U)};
    pg8::gemm_phase<pg8::EpiUp, pg8::StaticOrder, true, true>(F.lds, g, S, E);
    __syncthreads();
    SEpiUp SE{WSP(bf16, WS_U)};
    sgemm_sample<1, SEpiUp>(F, WSP(bf16, WS_H1) + (size_t)MP * 1024, WSP(bf16, WS_WUP), DFF, 1024, SE, nullptr); }
__device__ __forceinline__ void ph11(Frame& F) { pg8::Gemm g{WSP(bf16, WS_U), WSP(bf16, WS_WDOWN), MP, 1024, DFF}; pg8::StaticOrder S; S.init(MP, 1024, F.G, (int)blockIdx.x);
    pg8::EpiRes E{WSP(float, WS_X1), WSP(float, WS_X1) + (size_t)MP * 1024, WSP(float, WS_X2), WSP(float, WS_ADA), 5120};
    pg8::gemm_phase<pg8::EpiRes, pg8::StaticOrder, true, true>(F.lds, g, S, E);
    __syncthreads();
    SEpiUp SE{nullptr};
    sgemm_sample<4, SEpiUp>(F, WSP(bf16, WS_U) + (size_t)MP * 4096, WSP(bf16, WS_WDOWN), 1024, DFF, SE, WSP(float, WS_PART)); }
struct RowsP12 { const float* X2; const float* adaf; float* out;
    __device__ __forceinline__ const float* x(int m) const { return X2 + (size_t)m * 1024; }
    __device__ __forceinline__ const float* sc(int m) const { return adaf + (size_t)arow_of(m) * 2048 + 1024; }
    __device__ __forceinline__ const float* sh(int m) const { return adaf + (size_t)arow_of(m) * 2048; }
    __device__ __forceinline__ void* o(int m) const { return m < MP ? out + O_YP + (size_t)m * 1024 : out + O_YS + (size_t)(m - MP) * 1024; } };
__device__ __forceinline__ void ph12(Frame& F) { GWDEF; const int lane = tid_fresh() & 63; const RowsP12 R{WSP(float, WS_X2), WSP(float, WS_ADAF), F.out}; const float* g = F.g_fin();
    for (int rs = gw; rs < MS; rs += NGW) { const int m = MP + rs; const float* a = WSP(float, WS_ADA) + (size_t)arow_of(m) * 6144; const float* af = WSP(float, WS_ADAF) + (size_t)arow_of(m) * 2048;
        reduce_norm_row<false>(WSP(float, WS_X1) + (size_t)m * 1024, a + 5120, WSP(float, WS_PART) + (size_t)rs * 1024, (size_t)512 * 1024, nullptr, g, af + 1024, af, R.o(m), lane); }
    for (int m = gw; m < MP; m += 4 * NGW) { if (m + 3 * NGW < MP) norm_mod_rows4<false>(R, g, m, NGW, lane); else for (int mm = m; mm < MP; mm += NGW) norm_mod_row<false>(R.x(mm), g, R.sc(mm), R.sh(mm), R.o(mm), lane); } }

__global__ void __launch_bounds__(NWAVES * 64, 2) hymba_fwd(Args args) {
    extern __shared__ __attribute__((aligned(16))) unsigned char lds[];
    Frame F;
    F.lds = (LAS unsigned char*)lds;
    F.MISC = (volatile LAS unsigned*)(F.lds + MISC_OFF);
    F.wave = __builtin_amdgcn_readfirstlane((int)threadIdx.x >> 6);
    F.G = gridDim.x; { const int bx = blockIdx.x; F.vcu = (F.G % 8 == 0) ? (bx % 8) * (F.G / 8) + bx / 8 : bx; }
    F.ws = args.ws; F.out = args.out; F.ctl = (unsigned*)(args.ws + WS_CTL);
    F.ap = &args;
    for (int u = threadIdx.x; u < (LDS_BYTES - LDSCTL_OFF) / 4; u += NWAVES * 64) ((LAS unsigned*)(F.lds + LDSCTL_OFF))[u] = 0u;
    __syncthreads();
    XcdBarrier bar; bar.bar = F.ctl + CW_BAR; bar.x = 0; bar.st = nullptr;
#if !MK_PER_PHASE
    bar = xcd_barrier_post(F.ctl + CW_BAR, F.MISC + 8);
#endif
    const int lo = args.ph_lo, hi = args.ph_hi;
#define IN(k) (lo <= (k) && (k) < hi)
#if MK_PER_PHASE
#define SEAM(k) do { } while (0)
#else
#define SEAM(k) do { if (IN(k) && IN((k) + 1)) xcd_barrier(bar); } while (0)
#endif
#ifndef PROBE
#define PROBE (-1)
#endif
#define RUN(k, call) do { if (IN(k)) { call; if (PROBE == (k)) { xcd_barrier(bar); call; } } } while (0)
    RUN(0, ph0(F));  SEAM(0);
    RUN(1, ph1(F));  SEAM(1);
    RUN(2, ph2(F));  SEAM(2);
    RUN(3, ph3(F));  SEAM(3);
    RUN(4, ph4(F));  SEAM(4);
    RUN(5, ph5(F));  SEAM(5);
    RUN(6, ph6(F));  SEAM(6);
    RUN(7, ph7(F));  SEAM(7);
    RUN(8, ph8(F));  SEAM(8);
    RUN(9, ph9(F));  SEAM(9);
    RUN(10, ph10(F)); SEAM(10);
    RUN(11, ph11(F)); SEAM(11);
    RUN(12, ph12(F));
#undef RUN
#undef IN
#undef SEAM
}

extern "C" void kernel_launch(void* const* d_in, const int* in_sizes, int n_in, void* d_out, int out_size, void* d_ws, size_t ws_size, hipStream_t stream) {
    static int grid = 0;
    if (grid == 0) {
        if (n_in != 32 || (size_t)out_size != O_END || ws_size < WS_END) { fprintf(stderr, "kernel_launch: unexpected shapes (n_in %d, out %d, ws %zu); nothing launched\n", n_in, out_size, ws_size); grid = -1; return; }
        int dev = 0, cus = 0, per_cu = 0;
        if (hipGetDevice(&dev) != hipSuccess || hipDeviceGetAttribute(&cus, hipDeviceAttributeMultiprocessorCount, dev) != hipSuccess) { fprintf(stderr, "kernel_launch: device query failed\n"); grid = -1; return; }
        if (hipFuncSetAttribute((const void*)hymba_fwd, hipFuncAttributeMaxDynamicSharedMemorySize, LDS_BYTES) != hipSuccess) { fprintf(stderr, "kernel_launch: hipFuncSetAttribute failed\n"); grid = -1; return; }
        if (hipOccupancyMaxActiveBlocksPerMultiprocessor(&per_cu, (const void*)hymba_fwd, NWAVES * 64, LDS_BYTES) != hipSuccess || per_cu < 1) fprintf(stderr, "kernel_launch: note: occupancy query reports %d workgroups per CU\n", per_cu);
        (void)hipGetLastError();
        grid = cus;
    }
    if (grid < 0) return;
    if (hipMemsetAsync((char*)d_ws + WS_CTL, 0, CTL_ZERO_BYTES, stream) != hipSuccess) { fprintf(stderr, "kernel_launch: memset failed\n"); return; }
    Args a{};
    for (int i = 0; i < 32; ++i) a.in[i] = d_in[i];
    a.out = (float*)d_out; a.ws = (unsigned char*)d_ws;
#if MK_PER_PHASE
    for (int p = 0; p < NPHASE; ++p) { a.ph_lo = p; a.ph_hi = p + 1; hipLaunchKernelGGL(hymba_fwd, dim3(grid), dim3(NWAVES * 64), LDS_BYTES, stream, a); }
#else
    a.ph_lo = 0; a.ph_hi = NPHASE;
    hipLaunchKernelGGL(hymba_fwd, dim3(grid), dim3(NWAVES * 64), LDS_BYTES, stream, a);
#endif
    const hipError_t le = hipPeekAtLastError();
    if (le != hipSuccess) fprintf(stderr, "kernel_launch: launch failed: %s\n", hipGetErrorName(le));
}
```
